# Optimizing an MI355X kernel written in HIP

```python
import jax, jax.numpy as jnp
from jax import lax
import numpy as np

D_MODEL = 1024
BATCH = 2
SEQ = 16384
DEPTH = 4
DEC_BATCH = 8
DEC_SEQ = 64
PAST_LEN = 2048

CHUNK = 64
D_FF = 2816
A_HEADS = 4
A_HEAD = 128
A_WIDTH = A_HEADS * A_HEAD
GMLP_CHUNK = 128
B_GROUPS = 4
B_GROUP = 128
B_WIDTH = B_GROUPS * B_GROUP
POOL_WINDOWS = (2, 4, 8, 16)
POOL_BUF = 15
C_HEADS = 4
C_HEAD_K = 128
C_HEAD_V = 128
C_WIDTH = C_HEADS * C_HEAD_V
HGRN_BLOCK = CHUNK

N_BRANCH = 3
MIX_WIDTH = A_WIDTH + B_WIDTH + C_WIDTH
IN_COLS = 2 * A_WIDTH + B_WIDTH + 4 * C_WIDTH + N_BRANCH * D_MODEL
SPLIT_POINTS = (A_WIDTH, 2 * A_WIDTH, 2 * A_WIDTH + B_WIDTH,
                2 * A_WIDTH + B_WIDTH + C_WIDTH, 2 * A_WIDTH + B_WIDTH + 2 * C_WIDTH,
                2 * A_WIDTH + B_WIDTH + 3 * C_WIDTH, 2 * A_WIDTH + B_WIDTH + 4 * C_WIDTH)
EPS = 1e-6
F_FLOOR = 1e-30

kernel_name = 'hybrid_gmlp_pool_hgrn2_streaming_step'


def rms_norm(x, g):
    xf = x.astype(jnp.float32)
    y = xf * lax.rsqrt(jnp.mean(xf * xf, axis=-1, keepdims=True) + EPS)
    return (y * g.astype(jnp.float32)).astype(x.dtype)


def swiglu(x, w_gu, w_down):
    g, u = jnp.split(x @ w_gu, 2, axis=-1)
    return (jax.nn.silu(g) * u) @ w_down


def chunk_gmlp(u, v, w_s, b_s):
    bsz, t, _ = v.shape
    L = min(t, GMLP_CHUNK)
    n = t // L
    vb = v.reshape(bsz, n, L, A_HEADS, A_HEAD)
    w = jnp.tril(w_s[:, :L, :L])
    mixed = jnp.einsum('hts,bnshc->bnthc', w, vb) + b_s[:, :L].T[:, :, None]
    return u * mixed.reshape(bsz, t, A_WIDTH)


def multi_scale_pool(xb, prev, n_prev_valid, w_pool, scale):
    bsz, t, _ = xb.shape
    xp = jnp.concatenate([prev.astype(xb.dtype), xb], axis=1)
    cs = jnp.pad(jnp.cumsum(xp.astype(jnp.float32), axis=1), ((0, 0), (1, 0), (0, 0)))
    avail = jnp.arange(t) + 1 + n_prev_valid
    outs = []
    for g, w in enumerate(POOL_WINDOWS):
        sl = slice(g * B_GROUP, (g + 1) * B_GROUP)
        s = cs[:, POOL_BUF + 1:POOL_BUF + 1 + t, sl] - cs[:, POOL_BUF + 1 - w:POOL_BUF + 1 - w + t, sl]
        cnt = jnp.minimum(avail, w).astype(jnp.float32)
        outs.append(s / cnt[None, :, None] - xb[:, :, sl].astype(jnp.float32))
    pooled = jnp.stack(outs, axis=2)
    y = jnp.einsum('btgc,gcd->btgd', pooled, w_pool.astype(jnp.float32)).reshape(bsz, t, B_WIDTH)
    y = y * scale.astype(jnp.float32)
    return y.astype(xb.dtype), xp[:, -POOL_BUF:]


def hgrn_block(S0, q, k, v, logf):
    L = q.shape[1]
    b = jnp.cumsum(logf, axis=1)
    o_inter = jnp.einsum('blhk,bhkv->blhv', q * jnp.exp(b), S0)
    causal = jnp.tril(jnp.ones((L, L), dtype=bool))[None, :, :, None, None]
    diff = b[:, :, None] - b[:, None, :]
    decay = jnp.where(causal, jnp.exp(jnp.where(causal, diff, 0.0)), 0.0)
    scores = jnp.einsum('bthk,bshk,btshk->bhts', q, k, decay)
    o = o_inter + jnp.einsum('bhts,bshv->bthv', scores, v)
    b_last = b[:, -1]
    S = jnp.exp(b_last)[..., None] * S0 + jnp.einsum('bshk,bshv->bhkv', k * jnp.exp(b_last[:, None] - b), v)
    return S, o


def hgrn2(xq, xf, xi, xg, lb, S0, out_gain):
    bsz, t, _ = xq.shape
    f32 = jnp.float32
    q = jax.nn.silu(xq.astype(f32)) * (C_HEAD_K ** -0.5)
    z = xf.astype(f32)
    lb = lb.astype(f32)
    f = lb + (1.0 - lb) * jax.nn.sigmoid(z)
    logf = jnp.log(jnp.maximum(f, F_FLOOR))
    k = (1.0 - lb) * jax.nn.sigmoid(-z)
    v = xi.astype(f32)
    L = min(t, HGRN_BLOCK)
    n = t // L

    def to_blocks(a, d):
        return a.reshape(bsz, n, L, C_HEADS, d).transpose(1, 0, 2, 3, 4)

    S, o = lax.scan(lambda s, xs: hgrn_block(s, *xs), S0.astype(f32),
                    (to_blocks(q, C_HEAD_K), to_blocks(k, C_HEAD_K), to_blocks(v, C_HEAD_V), to_blocks(logf, C_HEAD_K)))
    o = o.transpose(1, 0, 2, 3, 4).reshape(bsz, t, C_HEADS, C_HEAD_V)
    o = rms_norm(o, out_gain) * jax.nn.silu(xg.astype(f32).reshape(bsz, t, C_HEADS, C_HEAD_V))
    return o.reshape(bsz, t, C_WIDTH).astype(xq.dtype), S


def trunk_layer(x, pool_prev, pool_valid, s_prev, lb, gains, w1_gu, w1_dn, w_in, v_gain, w_s, b_s,
                w_pool, pool_scale, c_gain, w_branch, w_out, w2_gu, w2_dn):
    bsz, t, _ = x.shape
    x = x + 0.5 * rms_norm(swiglu(rms_norm(x, gains[0]), w1_gu, w1_dn), gains[1])
    h = rms_norm(x, gains[2])
    xu, xv, xb, xq, xf, xi, xg, gates = jnp.split(h @ w_in, SPLIT_POINTS, axis=-1)
    u = jax.nn.gelu(xu)
    v = rms_norm(jax.nn.gelu(xv), v_gain)
    o_a = chunk_gmlp(u, v, w_s, b_s)
    o_b, pool_new = multi_scale_pool(xb, pool_prev, pool_valid, w_pool, pool_scale)
    o_c, s_new = hgrn2(xq, xf, xi, xg, lb, s_prev, c_gain)
    y_a = o_a @ w_branch[:A_WIDTH]
    y_b = o_b @ w_branch[A_WIDTH:A_WIDTH + B_WIDTH]
    y_c = o_c @ w_branch[A_WIDTH + B_WIDTH:]
    g = jax.nn.sigmoid(gates.astype(jnp.float32)).astype(x.dtype).reshape(bsz, t, N_BRANCH, D_MODEL)
    merged = g[:, :, 0] * y_a + g[:, :, 1] * y_b + g[:, :, 2] * y_c
    x = x + rms_norm(merged @ w_out, gains[3])
    x = x + 0.5 * rms_norm(swiglu(rms_norm(x, gains[4]), w2_gu, w2_dn), gains[5])
    return x, pool_new, s_new, v


def setup_inputs(seed: int = 0) -> dict:
    key = jax.random.key(seed)
    ks = jax.random.split(key, 20)

    def nrm(k, shape, scale):
        return jax.random.normal(k, shape, jnp.float32) * scale

    return {
        'x_prompt': nrm(ks[0], (BATCH, SEQ, D_MODEL), 1.0),
        'x_sample': nrm(ks[1], (DEC_BATCH, DEC_SEQ, D_MODEL), 1.0),
        'state_pool': nrm(ks[2], (DEPTH, DEC_BATCH, POOL_BUF, B_WIDTH), 1.0),
        'state_hgrn': nrm(ks[3], (DEPTH, DEC_BATCH, C_HEADS, C_HEAD_K, C_HEAD_V), 0.5),
        'norm_gains': 1.0 + nrm(ks[4], (DEPTH, 6, D_MODEL), 0.02),
        'w_ffn1_gu': nrm(ks[5], (DEPTH, D_MODEL, 2 * D_FF), D_MODEL ** -0.5),
        'w_ffn1_down': nrm(ks[6], (DEPTH, D_FF, D_MODEL), D_FF ** -0.5),
        'w_in': nrm(ks[7], (DEPTH, D_MODEL, IN_COLS), D_MODEL ** -0.5),
        'gmlp_v_gain': 1.0 + nrm(ks[8], (DEPTH, A_WIDTH), 0.02),
        'gmlp_w_s': nrm(ks[9], (DEPTH, A_HEADS, GMLP_CHUNK, GMLP_CHUNK), GMLP_CHUNK ** -0.5),
        'gmlp_b_s': 1.0 + nrm(ks[10], (DEPTH, A_HEADS, GMLP_CHUNK), 0.02),
        'pool_w': nrm(ks[11], (DEPTH, B_GROUPS, B_GROUP, B_GROUP), B_GROUP ** -0.5),
        'pool_scale': 1.0 + nrm(ks[12], (DEPTH, B_WIDTH), 0.1),
        'hgrn_lower_bounds': nrm(ks[13], (DEPTH, C_WIDTH), 0.5),
        'hgrn_out_gain': 1.0 + nrm(ks[14], (DEPTH, C_HEAD_V), 0.02),
        'w_branch': nrm(ks[15], (DEPTH, MIX_WIDTH, D_MODEL), A_WIDTH ** -0.5),
        'w_out': nrm(ks[16], (DEPTH, D_MODEL, D_MODEL), D_MODEL ** -0.5),
        'w_ffn2_gu': nrm(ks[17], (DEPTH, D_MODEL, 2 * D_FF), D_MODEL ** -0.5),
        'w_ffn2_down': nrm(ks[18], (DEPTH, D_FF, D_MODEL), D_FF ** -0.5),
    }


def reference(x_prompt, x_sample, state_pool, state_hgrn, norm_gains, w_ffn1_gu, w_ffn1_down, w_in,
              gmlp_v_gain, gmlp_w_s, gmlp_b_s, pool_w, pool_scale, hgrn_lower_bounds, hgrn_out_gain,
              w_branch, w_out, w_ffn2_gu, w_ffn2_down):
    lb_soft = jax.nn.softmax(hgrn_lower_bounds.astype(jnp.float32), axis=0)
    lb_all = jnp.cumsum(lb_soft, axis=0) - lb_soft[0]
    bp = x_prompt.shape[0]
    zero_pool = jnp.zeros((bp, POOL_BUF, B_WIDTH), x_prompt.dtype)
    zero_state = jnp.zeros((bp, C_HEADS, C_HEAD_K, C_HEAD_V), jnp.float32)
    xp, xs = x_prompt, x_sample
    pool_p, pool_s, hg_p, hg_s, v_s = [], [], [], [], []
    for l in range(DEPTH):
        weights = (lb_all[l], norm_gains[l], w_ffn1_gu[l], w_ffn1_down[l], w_in[l], gmlp_v_gain[l],
                   gmlp_w_s[l], gmlp_b_s[l], pool_w[l], pool_scale[l], hgrn_out_gain[l], w_branch[l],
                   w_out[l], w_ffn2_gu[l], w_ffn2_down[l])
        xp, pp, sp, _ = trunk_layer(xp, zero_pool, 0, zero_state, *weights)
        xs, ps, ss, vs = trunk_layer(xs, state_pool[l], POOL_BUF, state_hgrn[l], *weights)
        pool_p.append(pp)
        pool_s.append(ps)
        hg_p.append(sp.astype(state_hgrn.dtype))
        hg_s.append(ss.astype(state_hgrn.dtype))
        v_s.append(vs)
    pool_prompt = jnp.stack(pool_p, axis=0)
    pool_sample = jnp.stack(pool_s, axis=0)
    hgrn_prompt = jnp.stack(hg_p, axis=0)
    hgrn_sample = jnp.stack(hg_s, axis=0)
    gmlp_v_sample = jnp.stack(v_s, axis=0)
    return (xp, xs, pool_prompt, pool_sample, hgrn_prompt, hgrn_sample, gmlp_v_sample)
```

```cpp
#include <hip/hip_runtime.h>
#include <hip/hip_cooperative_groups.h>
#include <cstdio>
namespace cg = cooperative_groups;

#define LAS __attribute__((address_space(3)))
typedef unsigned short u16;
typedef short bf16x8 __attribute__((ext_vector_type(8)));
typedef float f32x4 __attribute__((ext_vector_type(4)));
typedef unsigned u32x4 __attribute__((ext_vector_type(4)));
typedef unsigned u32x2 __attribute__((ext_vector_type(2)));
typedef _Float16 h16x2 __attribute__((ext_vector_type(2)));

#ifndef PHM
#define PHM 0xffff
#endif
#ifndef MULTI_LAUNCH
#define MULTI_LAUNCH 0
#endif

constexpr int MROWS = 33280, MP = 32768, DM = 1024, DFF = 2816, NGU = 5632, NIN = 6656, DEPTH = 4;
constexpr int NCH64 = MROWS / 64;
constexpr float EPS = 1e-6f;
constexpr size_t O_POOLP = 34078720, O_POOLS = 34140160, O_HGP = 34385920, O_HGS = 34910208, O_VS = 37007360;
constexpr size_t COLB = (size_t)MROWS * 512 * 2;
constexpr size_t RA = 0;
constexpr size_t RB = RA + (size_t)MROWS * 1024 * 2;
constexpr size_t RC = RB + 7 * COLB;
constexpr size_t RWF = RC + (size_t)MROWS * 3072 * 2;
constexpr size_t RWF_DN = RWF + (size_t)NGU * 1024 * 2;
constexpr size_t RWM = RWF_DN + (size_t)1024 * DFF * 2;
constexpr size_t RWM_BR = RWM + (size_t)NIN * 1024 * 2;
constexpr size_t RWM_OUT = RWM_BR + (size_t)1024 * 1536 * 2;
constexpr size_t RWM_POOL = RWM_OUT + (size_t)1024 * 1024 * 2;
constexpr size_t RSM = RWM_POOL + (size_t)4 * 128 * 128 * 2;
constexpr size_t WS_END = RSM + (size_t)NCH64 * 4 * 128 * 4;
constexpr int LDS_BYTES = 131072 + 2048;

struct Params { const float* in[19]; float* out; unsigned char* ws; int ph_lo, ph_hi; };
struct Ctx {
    LAS const unsigned* pl;
    __device__ __forceinline__ unsigned long long q(int k) const { const unsigned lo = __builtin_amdgcn_readfirstlane(pl[2 * k]), hi = __builtin_amdgcn_readfirstlane(pl[2 * k + 1]); return ((unsigned long long)hi << 32) | lo; }
    __device__ __forceinline__ const float* in(int k) const { return (const float*)q(k); }
    __device__ __forceinline__ float* out() const { return (float*)q(19); }
    __device__ __forceinline__ unsigned char* ws() const { return (unsigned char*)q(20); }
};

__device__ __forceinline__ float bf2f(unsigned b) { return __uint_as_float(b << 16); }
__device__ __forceinline__ float bflo(unsigned w) { return __uint_as_float(w << 16); }
__device__ __forceinline__ float bfhi(unsigned w) { return __uint_as_float(w & 0xffff0000u); }
__device__ __forceinline__ u16 f2bf(float f) { unsigned u = __float_as_uint(f); u += 0x7FFFu + ((u >> 16) & 1u); return (u16)(u >> 16); }
__device__ __forceinline__ unsigned cvt_pk_bf16(float lo, float hi) { unsigned r; asm volatile("v_cvt_pk_bf16_f32 %0, %1, %2" : "=v"(r) : "v"(lo), "v"(hi)); return r; }
__device__ __forceinline__ float fsig(float x) { return __builtin_amdgcn_rcpf(1.0f + __expf(-x)); }
__device__ __forceinline__ float fsilu(float x) { return x * fsig(x); }
__device__ __forceinline__ float fgelu(float x) { return x * fsig(1.5957691216f * (x + 0.044715f * x * x * x)); }
__device__ __forceinline__ float wave_sum(float v) {
#pragma unroll
    for (int o = 32; o >= 1; o >>= 1) v += __shfl_xor(v, o);
    return v;
}

__device__ __forceinline__ int otid() { int t = threadIdx.x; asm volatile("" : "+v"(t)); return t; }
template <class T> __device__ __forceinline__ T osgpr(T x) { asm volatile("" : "+s"(x)); return x; }

namespace pg8 {
constexpr int BM = 256, BK = 64, HALF = 128, HTB = HALF * BK * 2, STAGE_BYTES = 8 * HTB, NXCD = 8, WGM = 8;
__device__ __forceinline__ int lds_byte(int r, int c) { const int st = (r >> 4) * 2 + (c >> 5), rr = r & 15, cc = c & 31, ob = rr * 64 + cc * 2; return st * 1024 + (ob ^ (((ob >> 9) & 1) << 5)); }
__device__ __forceinline__ void stage_rc(int b, int& R, int& C) { const int st = b / 1024, sb = b % 1024, swz = sb ^ (((sb >> 9) & 1) << 5); R = (st >> 1) * 16 + swz / 64; C = (st & 1) * 32 + (swz % 64) / 2; }
__device__ __forceinline__ int perm32(int rho) { const int n = rho >> 4, i = rho & 15; return 8 * (i >> 2) + 4 * n + (i & 3); }

struct Unit { const char* a; const char* b; int pm, pn, aux; };

struct TileOrder {
    int nM, nN, nwg, G, c;
    __device__ void init(int nM_, int nN_, int G_, int c_) { nM = nM_; nN = nN_; nwg = nM * nN; G = G_; c = c_; }
    __device__ bool tile(int i, int& pm, int& pn) const {
        const long L = (long)i * G + c; if (L >= nwg) return false;
        int wgid = (int)L; { const int q = nwg / NXCD, r = nwg % NXCD, xcd = wgid % NXCD, off = wgid / NXCD; wgid = (xcd < r ? xcd * (q + 1) : r * (q + 1) + (xcd - r) * q) + off; }
        const int nig = WGM * nN, gid = wgid / nig, fm = gid * WGM, gsz = (nM - fm) < WGM ? (nM - fm) : WGM;
        pm = fm + ((wgid % nig) % gsz); pn = (wgid % nig) / gsz; return true;
    }
};
struct SchedPlain {
    TileOrder o; const char* A; const char* B; size_t at, bt;
    __device__ bool next(int i, Unit& u) const { int pm, pn; if (!o.tile(i, pm, pn)) return false; u.a = A + (size_t)pm * at; u.b = B + (size_t)pn * bt; u.pm = pm; u.pn = pn; u.aux = 0; return true; }
};
struct SchedBranch {
    TileOrder o; const char* A0; const char* B;
    __device__ bool next(int i, Unit& u) const {
        const int t = i / 3, br = i - 3 * t; int pm, pn; if (!o.tile(t, pm, pn)) return false;
        const size_t aoff = br == 0 ? (size_t)0 : (br == 1 ? COLB : 3 * COLB);
        u.a = A0 + aoff + (size_t)pm * (256 * 512 * 2); u.b = B + ((size_t)pn * 256 * 1536 + (size_t)br * 512) * 2; u.pm = pm; u.pn = pn; u.aux = br; return true;
    }
};

template <class Epi, class Sched>
__device__ __forceinline__ void gemm_phase(LAS unsigned char* lds, const int K, const int lda, const int ldb, const Sched& S, const Epi& E) {
    const int tid = otid(), wid = __builtin_amdgcn_readfirstlane(tid >> 6), lane = tid & 63, wr = wid >> 2, wc = wid & 3, fr = lane & 15, fq = lane >> 4;
    const int nt = K / BK;
    unsigned voffA[2], voffB[2];
#pragma unroll
    for (int i = 0; i < 2; ++i) { int R, C; stage_rc(tid * 16 + i * 8192, R, C); const int Rb = Epi::PERM ? ((R & ~31) + perm32(R & 31)) : R;
        voffA[i] = (unsigned)(R * lda + C) * 2u; voffB[i] = (unsigned)(Rb * ldb + C) * 2u; }
    const size_t kstep = (size_t)(BK * 2);
    const size_t hstepA = (size_t)HALF * lda * 2, hstepB = (size_t)HALF * ldb * 2;
    const unsigned ldsw = (unsigned)wid * 1024u;
    const int aoff = lds_byte(wr * 64 + fr, fq * 8), boff = lds_byte(wc * 32 + fr, fq * 8);
#define PG8_SA(b, h) (((b) * 2 + (h)) * HTB)
#define PG8_SB(b, h) ((4 + (b) * 2 + (h)) * HTB)
#define PG8_STAGE(bufoff, gbase, voff) do { _Pragma("unroll") for (int _i = 0; _i < 2; ++_i) \
        __builtin_amdgcn_global_load_lds((const unsigned*)((const char*)(gbase) + (voff)[_i]), (LAS unsigned*)(lds + (bufoff) + ldsw + _i * 8192), 16, 0, 0); } while (0)
#define PG8_LDA(dst, b, h) do { _Pragma("unroll") for (int m = 0; m < 4; ++m) _Pragma("unroll") for (int k = 0; k < 2; ++k) dst[m][k] = *(const LAS bf16x8*)(lds + PG8_SA(b, h) + aoff + m * 2048 + k * 1024); } while (0)
#define PG8_LDB(dst, b, h) do { _Pragma("unroll") for (int n = 0; n < 2; ++n) _Pragma("unroll") for (int k = 0; k < 2; ++k) dst[n][k] = *(const LAS bf16x8*)(lds + PG8_SB(b, h) + boff + n * 2048 + k * 1024); } while (0)
#define PG8_MMA(ai, bj, At, Bt) do { __builtin_amdgcn_s_setprio(1); _Pragma("unroll") for (int m = 0; m < 4; ++m) _Pragma("unroll") for (int n = 0; n < 2; ++n) _Pragma("unroll") for (int k = 0; k < 2; ++k) \
        acc[ai][bj][m][n] = __builtin_amdgcn_mfma_f32_16x16x32_bf16(Bt[n][k], At[m][k], acc[ai][bj][m][n], 0, 0, 0); __builtin_amdgcn_s_setprio(0); } while (0)
#define PG8_WAIT_V(n) asm volatile("s_waitcnt vmcnt(" #n ")" ::: "memory")
#define PG8_WAIT_L(n) asm volatile("s_waitcnt lgkmcnt(" #n ")" ::: "memory")
#define PG8_BAR __builtin_amdgcn_s_barrier()
#define PG8_SCHED __builtin_amdgcn_sched_barrier(0)
    Unit cur, nxt; int ui = 0;
    if (!S.next(0, cur)) return;
    f32x4 acc[2][2][4][2];
#pragma unroll
    for (int a = 0; a < 2; ++a)
#pragma unroll
        for (int b = 0; b < 2; ++b)
#pragma unroll
            for (int m = 0; m < 4; ++m)
#pragma unroll
                for (int n = 0; n < 2; ++n) acc[a][b][m][n] = (f32x4){0.f, 0.f, 0.f, 0.f};
    bf16x8 At[4][2], B0[2][2], B1[2][2];
    const char* cA = cur.a; const char* cB = cur.b;
    PG8_STAGE(PG8_SB(0, 0), cB, voffB); PG8_STAGE(PG8_SA(0, 0), cA, voffA); PG8_STAGE(PG8_SB(0, 1), cB + hstepB, voffB); PG8_STAGE(PG8_SA(0, 1), cA + hstepA, voffA);
    if (wr == 1) PG8_BAR;
    PG8_WAIT_V(4); PG8_BAR;
    PG8_STAGE(PG8_SB(1, 0), cB + kstep, voffB); PG8_STAGE(PG8_SA(1, 0), cA + kstep, voffA); PG8_STAGE(PG8_SB(1, 1), cB + hstepB + kstep, voffB);
    PG8_WAIT_V(6); PG8_BAR;
    for (;;) {
        const bool has_next = S.next(ui + 1, nxt);
        const char* nA = has_next ? nxt.a : cA; const char* nB = has_next ? nxt.b : cB;
        for (int t = 0; t < nt; t += 2) {
            const bool last = (t == nt - 2);
            const char* a1 = cA + (size_t)(t + 1) * kstep;
            const char* a2 = last ? nA : cA + (size_t)(t + 2) * kstep; const char* b2 = last ? nB : cB + (size_t)(t + 2) * kstep;
            const char* a3 = a2 + kstep; const char* b3 = b2 + kstep;
            PG8_LDB(B0, 0, 0); PG8_SCHED; PG8_LDA(At, 0, 0); PG8_STAGE(PG8_SA(1, 1), a1 + hstepA, voffA);
            PG8_WAIT_L(8); PG8_BAR; PG8_WAIT_L(0); PG8_MMA(0, 0, At, B0); PG8_BAR; PG8_SCHED;
            PG8_LDB(B1, 0, 1); PG8_STAGE(PG8_SB(0, 0), b2, voffB);
            PG8_BAR; PG8_WAIT_L(0); PG8_MMA(0, 1, At, B1); PG8_BAR;
            PG8_LDA(At, 0, 1); PG8_STAGE(PG8_SA(0, 0), a2, voffA);
            PG8_BAR; PG8_WAIT_L(0); PG8_MMA(1, 0, At, B0); PG8_BAR; PG8_SCHED;
            PG8_STAGE(PG8_SB(0, 1), b2 + hstepB, voffB);
            PG8_WAIT_V(6); PG8_BAR; PG8_MMA(1, 1, At, B1); PG8_BAR;
            PG8_LDB(B0, 1, 0); PG8_SCHED; PG8_LDA(At, 1, 0); PG8_STAGE(PG8_SA(0, 1), a2 + hstepA, voffA);
            PG8_WAIT_L(8); PG8_BAR; PG8_WAIT_L(0); PG8_MMA(0, 0, At, B0); PG8_BAR; PG8_SCHED;
            PG8_LDB(B1, 1, 1); PG8_STAGE(PG8_SB(1, 0), b3, voffB);
            PG8_BAR; PG8_WAIT_L(0); PG8_MMA(0, 1, At, B1); PG8_BAR;
            PG8_LDA(At, 1, 1); PG8_STAGE(PG8_SA(1, 0), a3, voffA);
            PG8_BAR; PG8_WAIT_L(0); PG8_MMA(1, 0, At, B0); PG8_BAR; PG8_SCHED;
            PG8_STAGE(PG8_SB(1, 1), b3 + hstepB, voffB);
            PG8_WAIT_V(6); PG8_BAR; PG8_MMA(1, 1, At, B1); PG8_BAR;
        }
        E(acc, cur, wr, wc, fr, fq);
        if (!has_next) break;
#pragma unroll
        for (int a = 0; a < 2; ++a)
#pragma unroll
            for (int b = 0; b < 2; ++b)
#pragma unroll
                for (int m = 0; m < 4; ++m)
#pragma unroll
                    for (int n = 0; n < 2; ++n) acc[a][b][m][n] = (f32x4){0.f, 0.f, 0.f, 0.f};
        cur = nxt; cA = nA; cB = nB; ++ui;
    }
    PG8_WAIT_V(0);
    if (wr == 0) PG8_BAR;
    PG8_BAR;
#undef PG8_SA
#undef PG8_SB
#undef PG8_STAGE
#undef PG8_LDA
#undef PG8_LDB
#undef PG8_MMA
#undef PG8_WAIT_V
#undef PG8_WAIT_L
#undef PG8_BAR
#undef PG8_SCHED
}

struct EpiF32 {
    static constexpr bool PERM = false;
    float* C; int ldc;
    __device__ __forceinline__ void operator()(const f32x4 (&acc)[2][2][4][2], const Unit& u, int wr, int wc, int fr, int fq) const {
        const int row0 = u.pm * BM + wr * 64 + fr, col0 = u.pn * BM + wc * 32 + 4 * fq;
#pragma unroll
        for (int ai = 0; ai < 2; ++ai)
#pragma unroll
            for (int m = 0; m < 4; ++m) { float* rowp = C + (size_t)(row0 + ai * HALF + m * 16) * ldc + col0;
#pragma unroll
                for (int bj = 0; bj < 2; ++bj)
#pragma unroll
                    for (int n = 0; n < 2; ++n) *(f32x4*)(rowp + bj * HALF + n * 16) = acc[ai][bj][m][n]; }
    }
};
struct EpiGU {
    static constexpr bool PERM = true;
    u16* H;
    __device__ __forceinline__ void operator()(const f32x4 (&acc)[2][2][4][2], const Unit& u, int wr, int wc, int fr, int fq) const {
        const int row0 = u.pm * BM + wr * 64 + fr, col0 = u.pn * 128 + wc * 32 + 8 * fq;
#pragma unroll
        for (int ai = 0; ai < 2; ++ai)
#pragma unroll
            for (int m = 0; m < 4; ++m) { u16* rowp = H + (size_t)(row0 + ai * HALF + m * 16) * DFF + col0;
                const f32x4 g0 = acc[ai][0][m][0], g1 = acc[ai][0][m][1], u0 = acc[ai][1][m][0], u1 = acc[ai][1][m][1];
                u32x4 w; w.x = cvt_pk_bf16(fsilu(g0[0]) * u0[0], fsilu(g0[1]) * u0[1]); w.y = cvt_pk_bf16(fsilu(g0[2]) * u0[2], fsilu(g0[3]) * u0[3]);
                w.z = cvt_pk_bf16(fsilu(g1[0]) * u1[0], fsilu(g1[1]) * u1[1]); w.w = cvt_pk_bf16(fsilu(g1[2]) * u1[2], fsilu(g1[3]) * u1[3]);
                *(u32x4*)rowp = w; }
    }
};
__device__ __forceinline__ float act_in(float x, int mode) {
    switch (mode) {
        case 0: case 1: return fgelu(x);
        case 3: return fsilu(x) * 0.08838834764831845f;
        case 6: return fsilu(x);
        case 7: return fsig(x);
        default: return x;
    }
}
struct EpiIN {
    static constexpr bool PERM = true;
    u16* cols; u16* G;
    __device__ __forceinline__ void operator()(const f32x4 (&acc)[2][2][4][2], const Unit& u, int wr, int wc, int fr, int fq) const {
        const int pn = u.pn; const int mode = pn < 14 ? (pn >> 1) : 7;
        u16* base = pn < 14 ? cols + (size_t)(pn >> 1) * ((size_t)MROWS * 512) : G;
        const int ldc = pn < 14 ? 512 : 3072; const int colt = pn < 14 ? (pn & 1) * 256 : (pn - 14) * 256;
        const int row0 = u.pm * BM + wr * 64 + fr, col0 = colt + wc * 32 + 8 * fq;
#pragma unroll
        for (int ai = 0; ai < 2; ++ai)
#pragma unroll
            for (int m = 0; m < 4; ++m) { u16* rowp = base + (size_t)(row0 + ai * HALF + m * 16) * ldc + col0;
#pragma unroll
                for (int bj = 0; bj < 2; ++bj) { const f32x4 v0 = acc[ai][bj][m][0], v1 = acc[ai][bj][m][1]; u32x4 w;
                    if (mode == 4) {
                        w.x = __builtin_bit_cast(unsigned, (h16x2){(_Float16)v0[0], (_Float16)v0[1]}); w.y = __builtin_bit_cast(unsigned, (h16x2){(_Float16)v0[2], (_Float16)v0[3]});
                        w.z = __builtin_bit_cast(unsigned, (h16x2){(_Float16)v1[0], (_Float16)v1[1]}); w.w = __builtin_bit_cast(unsigned, (h16x2){(_Float16)v1[2], (_Float16)v1[3]});
                    } else {
                        w.x = cvt_pk_bf16(act_in(v0[0], mode), act_in(v0[1], mode)); w.y = cvt_pk_bf16(act_in(v0[2], mode), act_in(v0[3], mode));
                        w.z = cvt_pk_bf16(act_in(v1[0], mode), act_in(v1[1], mode)); w.w = cvt_pk_bf16(act_in(v1[2], mode), act_in(v1[3], mode));
                    }
                    *(u32x4*)(rowp + bj * HALF) = w; } }
    }
};
struct EpiBranch {
    static constexpr bool PERM = true;
    const u16* G; u16* O;
    __device__ __forceinline__ void operator()(const f32x4 (&acc)[2][2][4][2], const Unit& u, int wr, int wc, int fr, int fq) const {
        const int br = u.aux;
        const int row0 = u.pm * BM + wr * 64 + fr, col0 = u.pn * BM + wc * 32 + 8 * fq;
#pragma unroll
        for (int ai = 0; ai < 2; ++ai)
#pragma unroll
            for (int m = 0; m < 4; ++m) { const size_t r = (size_t)(row0 + ai * HALF + m * 16);
#pragma unroll
                for (int bj = 0; bj < 2; ++bj) {
                    const u32x4 gw = *(const u32x4*)(G + r * 3072 + br * 1024 + col0 + bj * HALF);
                    u16* op = O + r * 1024 + col0 + bj * HALF;
                    const f32x4 v0 = acc[ai][bj][m][0], v1 = acc[ai][bj][m][1];
                    float o0 = v0[0] * bflo(gw.x), o1 = v0[1] * bfhi(gw.x), o2 = v0[2] * bflo(gw.y), o3 = v0[3] * bfhi(gw.y);
                    float o4 = v1[0] * bflo(gw.z), o5 = v1[1] * bfhi(gw.z), o6 = v1[2] * bflo(gw.w), o7 = v1[3] * bfhi(gw.w);
                    if (br != 0) { const u32x4 pw = *(const u32x4*)op;
                        o0 += bflo(pw.x); o1 += bfhi(pw.x); o2 += bflo(pw.y); o3 += bfhi(pw.y); o4 += bflo(pw.z); o5 += bfhi(pw.z); o6 += bflo(pw.w); o7 += bfhi(pw.w); }
                    u32x4 w; w.x = cvt_pk_bf16(o0, o1); w.y = cvt_pk_bf16(o2, o3); w.z = cvt_pk_bf16(o4, o5); w.w = cvt_pk_bf16(o6, o7);
                    *(u32x4*)op = w; } }
    }
};
}

__device__ void rownorm_phase(const Ctx& p, bool first, float coef, const float* gpost, const float* gpre, bool write_xn) {
    float* X = p.out(); const float* Y = (const float*)(p.ws() + RC); u16* XN = (u16*)(p.ws() + RA);
    const int tid_ = otid(); const int lane = tid_ & 63, wid = tid_ >> 6;
    float4 gp[4], gq[4];
#pragma unroll
    for (int j = 0; j < 4; ++j) { gq[j] = *(const float4*)(gpre + lane * 4 + 256 * j); gp[j] = first ? gq[j] : *(const float4*)(gpost + lane * 4 + 256 * j); }
    for (int row = blockIdx.x * 8 + wid; row < MROWS; row += gridDim.x * 8) {
        const float* src = first ? (row < MP ? p.in(0) + (size_t)row * DM : p.in(1) + (size_t)(row - MP) * DM) : X + (size_t)row * DM;
        float4 x[4];
#pragma unroll
        for (int j = 0; j < 4; ++j) x[j] = *(const float4*)(src + lane * 4 + 256 * j);
        if (!first) {
            float4 y[4]; float ss = 0.f;
#pragma unroll
            for (int j = 0; j < 4; ++j) { y[j] = *(const float4*)(Y + (size_t)row * DM + lane * 4 + 256 * j); ss += y[j].x * y[j].x + y[j].y * y[j].y + y[j].z * y[j].z + y[j].w * y[j].w; }
            ss = wave_sum(ss);
            const float r = coef * rsqrtf(ss * (1.0f / DM) + EPS);
#pragma unroll
            for (int j = 0; j < 4; ++j) { x[j].x += r * y[j].x * gp[j].x; x[j].y += r * y[j].y * gp[j].y; x[j].z += r * y[j].z * gp[j].z; x[j].w += r * y[j].w * gp[j].w; }
        }
#pragma unroll
        for (int j = 0; j < 4; ++j) *(float4*)(X + (size_t)row * DM + lane * 4 + 256 * j) = x[j];
        if (write_xn) {
            float ss = 0.f;
#pragma unroll
            for (int j = 0; j < 4; ++j) ss += x[j].x * x[j].x + x[j].y * x[j].y + x[j].z * x[j].z + x[j].w * x[j].w;
            ss = wave_sum(ss);
            const float r = rsqrtf(ss * (1.0f / DM) + EPS);
#pragma unroll
            for (int j = 0; j < 4; ++j) { u32x2 w; w.x = cvt_pk_bf16(x[j].x * r * gq[j].x, x[j].y * r * gq[j].y); w.y = cvt_pk_bf16(x[j].z * r * gq[j].z, x[j].w * r * gq[j].w);
                *(u32x2*)(XN + (size_t)row * DM + lane * 4 + 256 * j) = w; }
        }
    }
}

__device__ void convert_mat(LAS unsigned char* lds, const float* src, int ld, u16* dst, int K, int N, bool gu_map) {
    LAS float* tile = (LAS float*)lds;
    const int tid = otid(), nkt = K >> 6, ntiles = nkt * (N >> 6);
    for (int t = blockIdx.x; t < ntiles; t += gridDim.x) {
        const int kt = t % nkt, ntile = t / nkt, nd0 = ntile * 64;
        int sc0 = nd0;
        if (gu_map) { const int pb = nd0 >> 8, h = (nd0 >> 7) & 1, j = nd0 & 127; sc0 = h * DFF + 128 * pb + j; }
        const int kk = tid >> 4, c4 = (tid & 15) * 4;
#pragma unroll
        for (int q = 0; q < 2; ++q) { const float4 v = *(const float4*)(src + (size_t)(kt * 64 + kk + 32 * q) * ld + sc0 + c4);
            LAS float* tp = tile + (kk + 32 * q) * 65 + c4; tp[0] = v.x; tp[1] = v.y; tp[2] = v.z; tp[3] = v.w; }
        __syncthreads();
        const int n = tid >> 3, ks = (tid & 7) * 8;
        float e[8];
#pragma unroll
        for (int i = 0; i < 8; ++i) e[i] = tile[(ks + i) * 65 + n];
        u32x4 w; w.x = cvt_pk_bf16(e[0], e[1]); w.y = cvt_pk_bf16(e[2], e[3]); w.z = cvt_pk_bf16(e[4], e[5]); w.w = cvt_pk_bf16(e[6], e[7]);
        *(u32x4*)(dst + (size_t)(nd0 + n) * K + kt * 64 + ks) = w;
        __syncthreads();
    }
}
__device__ void convert_ffn(const Ctx& p, LAS unsigned char* lds, const float* wgu, const float* wdn) {
    convert_mat(lds, wgu, NGU, (u16*)(p.ws() + RWF), 1024, NGU, true);
    convert_mat(lds, wdn, 1024, (u16*)(p.ws() + RWF_DN), DFF, 1024, false);
}
__device__ void convert_mix(const Ctx& p, LAS unsigned char* lds, int l) {
    convert_mat(lds, p.in(7) + (size_t)l * 1024 * NIN, NIN, (u16*)(p.ws() + RWM), 1024, NIN, false);
    convert_mat(lds, p.in(15) + (size_t)l * 1536 * 1024, 1024, (u16*)(p.ws() + RWM_BR), 1536, 1024, false);
    convert_mat(lds, p.in(16) + (size_t)l * 1024 * 1024, 1024, (u16*)(p.ws() + RWM_OUT), 1024, 1024, false);
    for (int g = 0; g < 4; ++g) convert_mat(lds, p.in(11) + ((size_t)l * 4 + g) * 16384, 128, (u16*)(p.ws() + RWM_POOL) + g * 16384, 128, 128, false);
}

#define MFMA16(a, b, c) __builtin_amdgcn_mfma_f32_16x16x32_bf16((a), (b), (c), 0, 0, 0)
__device__ __forceinline__ bf16x8 ldsfrag(const LAS u16* base, int row, int ld, int k) { return *(const LAS bf16x8*)(base + row * ld + k); }

__device__ void gmlp_unit(const Ctx& p, LAS unsigned char* lds, int l, int unit) {
    const int tid = otid(), wid = tid >> 6, lane = tid & 63, fr = lane & 15, fq = lane >> 4;
    int row0, L, h, bs = -1;
    if (unit < 1024) { row0 = (unit >> 2) * 128; h = unit & 3; L = 128; } else { const int s = unit - 1024; bs = s >> 2; h = s & 3; row0 = MP + bs * 64; L = 64; }
    u16* U = (u16*)(p.ws() + RB); const u16* V = (const u16*)(p.ws() + RB + COLB);
    LAS float* rs = (LAS float*)lds; LAS u16* Vt = (LAS u16*)(lds + 1024); LAS u16* Wl = (LAS u16*)(lds + 35840);
    constexpr int LD = 136;
    {
        const int row = tid >> 2, part = tid & 3; float ss = 0.f;
        if (row < L) {
#pragma unroll
            for (int i = 0; i < 16; ++i) { const u32x4 w = *(const u32x4*)(V + (size_t)(row0 + row) * 512 + part * 128 + i * 8);
                float a; a = bflo(w.x); ss += a * a; a = bfhi(w.x); ss += a * a; a = bflo(w.y); ss += a * a; a = bfhi(w.y); ss += a * a;
                a = bflo(w.z); ss += a * a; a = bfhi(w.z); ss += a * a; a = bflo(w.w); ss += a * a; a = bfhi(w.w); ss += a * a; }
        }
        ss += __shfl_xor(ss, 1); ss += __shfl_xor(ss, 2);
        if (part == 0 && row < L) rs[row] = rsqrtf(ss * (1.0f / 512.0f) + EPS);
    }
    __syncthreads();
    {
        const int s = tid & 127, cg4 = tid >> 7;
        if (s < L) {
            const float r = rs[s]; const float* vg = p.in(8) + l * 512 + h * 128 + cg4 * 32;
            float* vout = bs >= 0 ? p.out() + O_VS + ((size_t)(l * 8 + bs) * 64 + s) * 512 + h * 128 + cg4 * 32 : nullptr;
#pragma unroll
            for (int i = 0; i < 4; ++i) { const u32x4 w = *(const u32x4*)(V + (size_t)(row0 + s) * 512 + h * 128 + cg4 * 32 + i * 8);
                float e[8] = {bflo(w.x), bfhi(w.x), bflo(w.y), bfhi(w.y), bflo(w.z), bfhi(w.z), bflo(w.w), bfhi(w.w)};
#pragma unroll
                for (int j = 0; j < 8; ++j) { const float vv = e[j] * r * vg[i * 8 + j]; Vt[(cg4 * 32 + i * 8 + j) * LD + s] = f2bf(vv); if (vout) vout[i * 8 + j] = vv; } }
        }
    }
    {
        const int t = tid >> 2, sq = (tid & 3) * 32;
        if (t < L) { const float* wp = p.in(9) + ((size_t)(l * 4 + h) * 128 + t) * 128 + sq;
#pragma unroll
            for (int i = 0; i < 4; ++i) { const float4 a = *(const float4*)(wp + i * 8), b = *(const float4*)(wp + i * 8 + 4); const int s0 = sq + i * 8;
                u32x4 w; w.x = cvt_pk_bf16(s0 + 0 <= t ? a.x : 0.f, s0 + 1 <= t ? a.y : 0.f); w.y = cvt_pk_bf16(s0 + 2 <= t ? a.z : 0.f, s0 + 3 <= t ? a.w : 0.f);
                w.z = cvt_pk_bf16(s0 + 4 <= t ? b.x : 0.f, s0 + 5 <= t ? b.y : 0.f); w.w = cvt_pk_bf16(s0 + 6 <= t ? b.z : 0.f, s0 + 7 <= t ? b.w : 0.f);
                *(LAS u32x4*)(Wl + t * LD + s0) = w; } }
    }
    __syncthreads();
    if (wid * 16 < L) {
        f32x4 acc[8];
#pragma unroll
        for (int n = 0; n < 8; ++n) acc[n] = (f32x4){0.f, 0.f, 0.f, 0.f};
        const int kmax = (wid * 16 + 15) / 32 + 1;
        for (int ks = 0; ks < kmax; ++ks) { const bf16x8 a = ldsfrag(Wl, wid * 16 + fr, LD, ks * 32 + fq * 8);
#pragma unroll
            for (int n = 0; n < 8; ++n) acc[n] = MFMA16(a, ldsfrag(Vt, n * 16 + fr, LD, ks * 32 + fq * 8), acc[n]); }
        const float* bsp = p.in(10) + (l * 4 + h) * 128;
#pragma unroll
        for (int j = 0; j < 4; ++j) { const int t = wid * 16 + fq * 4 + j; const float bias = bsp[t];
#pragma unroll
            for (int n = 0; n < 8; ++n) { u16* up = U + (size_t)(row0 + t) * 512 + h * 128 + n * 16 + fr; *up = f2bf(bf2f(*up) * (acc[n][j] + bias)); } }
    }
    __syncthreads();
}

__device__ __forceinline__ float hgrn_lb(const float* lbp, int l, int c) {
    const float x0 = lbp[c], x1 = lbp[512 + c], x2 = lbp[1024 + c], x3 = lbp[1536 + c];
    const float m = fmaxf(fmaxf(x0, x1), fmaxf(x2, x3));
    const float e0 = __expf(x0 - m), e1 = __expf(x1 - m), e2 = __expf(x2 - m), e3 = __expf(x3 - m);
    float num = 0.f; if (l >= 1) num += e1; if (l >= 2) num += e2; if (l >= 3) num += e3;
    return num / (e0 + e1 + e2 + e3);
}
__device__ __forceinline__ int chunk_row0(int cq) { return cq < 512 ? cq * 64 : MP + (cq - 512) * 64; }

__device__ void hgrn_a_unit(const Ctx& p, LAS unsigned char* lds, int l, int unit) {
    const int tid = otid(), wid = tid >> 6, lane = tid & 63, fr = lane & 15, fq = lane >> 4;
    const int cq = unit >> 2, h = unit & 3, row0 = chunk_row0(cq);
    const u16* F = (const u16*)(p.ws() + RB + 4 * COLB); const u16* I = (const u16*)(p.ws() + RB + 5 * COLB);
    u16* St = (u16*)(p.ws() + RA) + (size_t)unit * 16384; float* dcy = (float*)(p.ws() + RSM) + (size_t)unit * 128;
    LAS float* segtot = (LAS float*)lds; LAS u16* Kt = (LAS u16*)(lds + 4096); LAS u16* Vt = (LAS u16*)(lds + 22528);
    constexpr int LD = 72;
    const int k = tid & 127, seg = tid >> 7;
    const float lb = hgrn_lb(p.in(13), l, h * 128 + k);
    float lf[16], kk[16]; float run = 0.f;
#pragma unroll
    for (int i = 0; i < 16; ++i) { const u16 zb = F[(size_t)(row0 + seg * 16 + i) * 512 + h * 128 + k]; const float z = (float)__builtin_bit_cast(_Float16, zb);
        const float sg = fsig(z); const float f = lb + (1.0f - lb) * sg; kk[i] = 1.0f - f; run += __logf(fmaxf(f, 1e-30f)); lf[i] = run; }
    segtot[seg * 128 + k] = run;
    { const int s = tid & 63, cg = tid >> 6;
#pragma unroll
        for (int i = 0; i < 2; ++i) { const u32x4 w = *(const u32x4*)(I + (size_t)(row0 + s) * 512 + h * 128 + cg * 16 + i * 8); LAS u16* vp = Vt + (cg * 16 + i * 8) * LD + s;
            vp[0] = (u16)(w.x & 0xffff); vp[LD] = (u16)(w.x >> 16); vp[2 * LD] = (u16)(w.y & 0xffff); vp[3 * LD] = (u16)(w.y >> 16);
            vp[4 * LD] = (u16)(w.z & 0xffff); vp[5 * LD] = (u16)(w.z >> 16); vp[6 * LD] = (u16)(w.w & 0xffff); vp[7 * LD] = (u16)(w.w >> 16); } }
    __syncthreads();
    { const float t0 = segtot[k], t1 = segtot[128 + k], t2 = segtot[256 + k], t3 = segtot[384 + k];
        const float off = seg == 0 ? 0.f : (seg == 1 ? t0 : (seg == 2 ? t0 + t1 : t0 + t1 + t2)); const float blast = t0 + t1 + t2 + t3;
#pragma unroll
        for (int i = 0; i < 16; ++i) Kt[k * LD + seg * 16 + i] = f2bf(kk[i] * __expf(blast - (off + lf[i])));
        if (seg == 0) dcy[k] = __expf(blast); }
    __syncthreads();
    { f32x4 acc[8];
#pragma unroll
        for (int n = 0; n < 8; ++n) acc[n] = (f32x4){0.f, 0.f, 0.f, 0.f};
#pragma unroll
        for (int ks = 0; ks < 2; ++ks) { const bf16x8 a = ldsfrag(Kt, wid * 16 + fr, LD, ks * 32 + fq * 8);
#pragma unroll
            for (int n = 0; n < 8; ++n) acc[n] = MFMA16(a, ldsfrag(Vt, n * 16 + fr, LD, ks * 32 + fq * 8), acc[n]); }
#pragma unroll
        for (int n = 0; n < 8; ++n) { u32x2 w; w.x = cvt_pk_bf16(acc[n][0], acc[n][1]); w.y = cvt_pk_bf16(acc[n][2], acc[n][3]);
            *(u32x2*)(St + (size_t)(n * 16 + fr) * 128 + wid * 16 + fq * 4) = w; } }
    __syncthreads();
}

__device__ void hgrn_scan_phase(const Ctx& p, int l) {
    u16* SR = (u16*)(p.ws() + RA); const float* dcy = (const float*)(p.ws() + RSM);
    const int gtid = blockIdx.x * blockDim.x + otid(), gsz = gridDim.x * blockDim.x;
    for (int e = gtid; e < 8 * 16384; e += gsz) {
        const int seq = e >> 14, el = e & 16383, b = seq >> 2, h = seq & 3, k = el & 127, v = el >> 7;
        u16* sp = SR + ((size_t)(b * 256) * 4 + h) * 16384 + el; const float* dp = dcy + ((size_t)(b * 256) * 4 + h) * 128 + k;
        float st = 0.f;
        for (int n0 = 0; n0 < 256; n0 += 16) {
            float uu[16], dd[16];
#pragma unroll
            for (int j = 0; j < 16; ++j) { uu[j] = bf2f(sp[(size_t)(n0 + j) * 65536]); dd[j] = dp[(size_t)(n0 + j) * 512]; }
#pragma unroll
            for (int j = 0; j < 16; ++j) { sp[(size_t)(n0 + j) * 65536] = f2bf(st); st = dd[j] * st + uu[j]; }
        }
        p.out()[O_HGP + ((size_t)(l * 2 + b) * 4 + h) * 16384 + k * 128 + v] = st;
    }
    for (int e = gtid; e < 32 * 16384; e += gsz) {
        const int bh = e >> 14, el = e & 16383, k = el & 127, v = el >> 7;
        u16* sp = SR + ((size_t)(512 * 4) + bh) * 16384 + el;
        const float s0 = p.in(3)[((size_t)l * 32 + bh) * 16384 + k * 128 + v];
        const float uu = bf2f(*sp), dd = dcy[((size_t)(512 * 4) + bh) * 128 + k];
        *sp = f2bf(s0);
        p.out()[O_HGS + ((size_t)l * 32 + bh) * 16384 + k * 128 + v] = dd * s0 + uu;
    }
}

__device__ void hgrn_c_unit(const Ctx& p, LAS unsigned char* lds, int l, int unit) {
    const int tid = otid(), wid = tid >> 6, lane = tid & 63, fr = lane & 15, fq = lane >> 4;
    const int cq = unit >> 2, h = unit & 3, row0 = chunk_row0(cq);
    u16* Q = (u16*)(p.ws() + RB + 3 * COLB); const u16* F = (const u16*)(p.ws() + RB + 4 * COLB); const u16* I = (const u16*)(p.ws() + RB + 5 * COLB); const u16* GG = (const u16*)(p.ws() + RB + 6 * COLB);
    const u16* St = (const u16*)(p.ws() + RA) + (size_t)unit * 16384;
    LAS float* segtot = (LAS float*)lds; LAS float* red = (LAS float*)(lds + 2560);
    LAS u16* Qi = (LAS u16*)(lds + 4096); LAS u16* Qh = (LAS u16*)(lds + 21504); LAS u16* Kh = (LAS u16*)(lds + 38912);
    LAS u16* Vt = (LAS u16*)(lds + 56320); LAS u16* Sl = (LAS u16*)(lds + 74752); LAS u16* P = (LAS u16*)(lds + 109568);
    constexpr int LDK = 136, LDS_ = 72;
    const int k = tid & 127, seg = tid >> 7;
    const float lb = hgrn_lb(p.in(13), l, h * 128 + k);
    float lf[16], kk[16]; float run = 0.f;
#pragma unroll
    for (int i = 0; i < 16; ++i) { const u16 zb = F[(size_t)(row0 + seg * 16 + i) * 512 + h * 128 + k]; const float z = (float)__builtin_bit_cast(_Float16, zb);
        const float sg = fsig(z); const float f = lb + (1.0f - lb) * sg; kk[i] = 1.0f - f; run += __logf(fmaxf(f, 1e-30f)); lf[i] = run; }
    segtot[seg * 128 + k] = run;
    { const int s = tid & 63, cg = tid >> 6;
#pragma unroll
        for (int i = 0; i < 2; ++i) { const u32x4 w = *(const u32x4*)(I + (size_t)(row0 + s) * 512 + h * 128 + cg * 16 + i * 8); LAS u16* vp = Vt + (cg * 16 + i * 8) * LDS_ + s;
            vp[0] = (u16)(w.x & 0xffff); vp[LDS_] = (u16)(w.x >> 16); vp[2 * LDS_] = (u16)(w.y & 0xffff); vp[3 * LDS_] = (u16)(w.y >> 16);
            vp[4 * LDS_] = (u16)(w.z & 0xffff); vp[5 * LDS_] = (u16)(w.z >> 16); vp[6 * LDS_] = (u16)(w.w & 0xffff); vp[7 * LDS_] = (u16)(w.w >> 16); } }
#pragma unroll
    for (int i = 0; i < 4; ++i) { const int c = tid + i * 512, r = c >> 4, cc = (c & 15) * 8;
        *(LAS u32x4*)(Sl + r * LDK + cc) = *(const u32x4*)(St + r * 128 + cc); }
    __syncthreads();
    { const float t0 = segtot[k], t1 = segtot[128 + k], t2 = segtot[256 + k];
        const float off = seg == 0 ? 0.f : (seg == 1 ? t0 : (seg == 2 ? t0 + t1 : t0 + t1 + t2)); const float bref = t0 + t1;
#pragma unroll
        for (int i = 0; i < 16; ++i) { const int s = seg * 16 + i; const float b = off + lf[i]; const float q = bf2f(Q[(size_t)(row0 + s) * 512 + h * 128 + k]);
            Qi[s * LDK + k] = f2bf(q * __expf(b)); Qh[s * LDK + k] = f2bf(q * __expf(b - bref)); Kh[s * LDK + k] = f2bf(kk[i] * __expf(bref - b)); } }
    __syncthreads();
    {
        const int tt = wid >> 1;
#pragma unroll
        for (int q2 = 0; q2 < 2; ++q2) { const int stl = (wid & 1) * 2 + q2; f32x4 acc = (f32x4){0.f, 0.f, 0.f, 0.f};
            if (stl <= tt) {
#pragma unroll
                for (int ks = 0; ks < 4; ++ks) acc = MFMA16(ldsfrag(Qh, tt * 16 + fr, LDK, ks * 32 + fq * 8), ldsfrag(Kh, stl * 16 + fr, LDK, ks * 32 + fq * 8), acc); }
#pragma unroll
            for (int j = 0; j < 4; ++j) { const int t = tt * 16 + fq * 4 + j, s = stl * 16 + fr; P[t * LDS_ + s] = (stl <= tt && s <= t) ? f2bf(acc[j]) : (u16)0; } }
    }
    __syncthreads();
    { const int tt = wid & 3, nh = wid >> 2; f32x4 acc[4];
#pragma unroll
        for (int n = 0; n < 4; ++n) acc[n] = (f32x4){0.f, 0.f, 0.f, 0.f};
#pragma unroll
        for (int ks = 0; ks < 4; ++ks) { const bf16x8 a = ldsfrag(Qi, tt * 16 + fr, LDK, ks * 32 + fq * 8);
#pragma unroll
            for (int n = 0; n < 4; ++n) acc[n] = MFMA16(a, ldsfrag(Sl, (nh * 4 + n) * 16 + fr, LDK, ks * 32 + fq * 8), acc[n]); }
#pragma unroll
        for (int ks = 0; ks < 2; ++ks) { const bf16x8 a = ldsfrag(P, tt * 16 + fr, LDS_, ks * 32 + fq * 8);
#pragma unroll
            for (int n = 0; n < 4; ++n) acc[n] = MFMA16(a, ldsfrag(Vt, (nh * 4 + n) * 16 + fr, LDS_, ks * 32 + fq * 8), acc[n]); }
        float ssq[4];
#pragma unroll
        for (int j = 0; j < 4; ++j) { float s = 0.f;
#pragma unroll
            for (int n = 0; n < 4; ++n) s += acc[n][j] * acc[n][j];
            s += __shfl_xor(s, 1); s += __shfl_xor(s, 2); s += __shfl_xor(s, 4); s += __shfl_xor(s, 8); ssq[j] = s; }
        if (fr == 0) {
#pragma unroll
            for (int j = 0; j < 4; ++j) red[nh * 64 + tt * 16 + fq * 4 + j] = ssq[j]; }
        __syncthreads();
        const float* og = p.in(14) + l * 128;
#pragma unroll
        for (int j = 0; j < 4; ++j) { const int t = tt * 16 + fq * 4 + j; const float r = rsqrtf((red[t] + red[64 + t]) * (1.0f / 128.0f) + EPS);
#pragma unroll
            for (int n = 0; n < 4; ++n) { const int v = (nh * 4 + n) * 16 + fr; const size_t idx = (size_t)(row0 + t) * 512 + h * 128 + v;
                Q[idx] = f2bf(acc[n][j] * r * og[v] * bf2f(GG[idx])); } }
    }
    __syncthreads();
}

__device__ void pool_unit(const Ctx& p, LAS unsigned char* lds, int l, int unit) {
    const int tid = otid(), wid = tid >> 6, lane = tid & 63, fr = lane & 15, fq = lane >> 4;
    const int cq = unit >> 2, g = unit & 3, row0 = chunk_row0(cq);
    const bool samp = cq >= 512; const int bs = cq - 512; const int t0 = samp ? 0 : (cq & 255) * 64;
    const u16* XB = (const u16*)(p.ws() + RB + 2 * COLB); u16* OB = (u16*)(p.ws() + RB + COLB);
    const u16* Wpt = (const u16*)(p.ws() + RWM_POOL) + g * 16384;
    LAS float* Xs = (LAS float*)lds; LAS u16* Wp = (LAS u16*)(lds + 40448); LAS u16* Pp = (LAS u16*)(lds + 75264);
    constexpr int LD = 136;
    for (int c = tid; c < 79 * 16; c += 512) { const int j = c >> 4, cc = (c & 15) * 8; const int tk = t0 - 15 + j;
        LAS float* xp = Xs + j * 128 + cc;
        if (tk >= 0) { const u32x4 w = *(const u32x4*)(XB + (size_t)(row0 - 15 + j) * 512 + g * 128 + cc);
            xp[0] = bflo(w.x); xp[1] = bfhi(w.x); xp[2] = bflo(w.y); xp[3] = bfhi(w.y); xp[4] = bflo(w.z); xp[5] = bfhi(w.z); xp[6] = bflo(w.w); xp[7] = bfhi(w.w); }
        else if (samp) { const float* sp = p.in(2) + ((size_t)(l * 8 + bs) * 15 + j) * 512 + g * 128 + cc;
#pragma unroll
            for (int i = 0; i < 8; ++i) xp[i] = sp[i]; }
        else {
#pragma unroll
            for (int i = 0; i < 8; ++i) xp[i] = 0.f; } }
#pragma unroll
    for (int i = 0; i < 4; ++i) { const int c = tid + i * 512, r = c >> 4, cc = (c & 15) * 8; *(LAS u32x4*)(Wp + r * LD + cc) = *(const u32x4*)(Wpt + r * 128 + cc); }
    __syncthreads();
    { const int c = tid & 127, tq = tid >> 7; const int w = 2 << g; const int nvalid = samp ? 15 : 0;
        float s = 0.f;
        for (int j = 1; j < w; ++j) s += Xs[(15 + tq * 16 - j) * 128 + c];
        for (int i = 0; i < 16; ++i) { const int t = tq * 16 + i; const float x = Xs[(15 + t) * 128 + c]; s += x;
            const int avail = t0 + t + 1 + nvalid; const float cnt = (float)(avail < w ? avail : w);
            Pp[t * LD + c] = f2bf(s / cnt - x); s -= Xs[(15 + t - (w - 1)) * 128 + c]; } }
    if (samp || t0 == 16320) { float* po = samp ? p.out() + O_POOLS + ((size_t)(l * 8 + bs) * 15) * 512 : p.out() + O_POOLP + ((size_t)(l * 2 + (cq >> 8)) * 15) * 512;
        for (int c = tid; c < 15 * 128; c += 512) { const int j = c >> 7, cc = c & 127; po[(size_t)j * 512 + g * 128 + cc] = Xs[(15 + 49 + j) * 128 + cc]; } }
    __syncthreads();
    { const int tt = wid & 3, nh = wid >> 2; f32x4 acc[4];
#pragma unroll
        for (int n = 0; n < 4; ++n) acc[n] = (f32x4){0.f, 0.f, 0.f, 0.f};
#pragma unroll
        for (int ks = 0; ks < 4; ++ks) { const bf16x8 a = ldsfrag(Pp, tt * 16 + fr, LD, ks * 32 + fq * 8);
#pragma unroll
            for (int n = 0; n < 4; ++n) acc[n] = MFMA16(a, ldsfrag(Wp, (nh * 4 + n) * 16 + fr, LD, ks * 32 + fq * 8), acc[n]); }
        const float* sc = p.in(12) + l * 512 + g * 128;
#pragma unroll
        for (int n = 0; n < 4; ++n) { const int d = (nh * 4 + n) * 16 + fr; const float scd = sc[d];
#pragma unroll
            for (int j = 0; j < 4; ++j) { const int t = tt * 16 + fq * 4 + j; OB[(size_t)(row0 + t) * 512 + g * 128 + d] = f2bf(acc[n][j] * scd); } }
    }
    __syncthreads();
}

__global__ void __launch_bounds__(512, 2) fwd_mega(Params kp) {
    extern __shared__ __attribute__((aligned(16))) unsigned char lds_raw[];
    LAS unsigned char* lds = (LAS unsigned char*)lds_raw;
    cg::grid_group grid = cg::this_grid();
    { LAS unsigned* pw = (LAS unsigned*)(lds + 131072); const unsigned* src = (const unsigned*)&kp; if (threadIdx.x < sizeof(Params) / 4) pw[threadIdx.x] = src[threadIdx.x]; }
    __syncthreads();
    Ctx p; p.pl = (LAS const unsigned*)(lds + 131072);
    const int ph_lo = __builtin_amdgcn_readfirstlane(p.pl[42]), ph_hi = __builtin_amdgcn_readfirstlane(p.pl[43]);
    for (int ph = ph_lo; ph < ph_hi; ++ph) {
        if (ph > ph_lo) grid.sync();
        const int G = gridDim.x, c = blockIdx.x;
        if (ph == 0) {
            rownorm_phase(p, true, 0.f, nullptr, p.in(4), true);
            convert_ffn(p, lds, p.in(5), p.in(6));
            continue;
        }
        const int l = (ph - 1) / 13, s = (ph - 1) % 13 + 1;
        unsigned char* ws = p.ws();
        switch (s) {
        case 1: case 11: if (PHM & 1) {
            pg8::SchedPlain S; S.o.init(MROWS / 256, NGU / 256, G, c); S.A = (const char*)(ws + RA); S.B = (const char*)(ws + RWF); S.at = (size_t)256 * 1024 * 2; S.bt = (size_t)256 * 1024 * 2;
            pg8::EpiGU E{(u16*)(ws + RB)};
            pg8::gemm_phase(lds, 1024, 1024, 1024, S, E);
        } break;
        case 2: case 12: if (PHM & 2) {
            pg8::SchedPlain S; S.o.init(MROWS / 256, 4, G, c); S.A = (const char*)(ws + RB); S.B = (const char*)(ws + RWF_DN); S.at = (size_t)256 * DFF * 2; S.bt = (size_t)256 * DFF * 2;
            pg8::EpiF32 E{(float*)(ws + RC), 1024};
            pg8::gemm_phase(lds, DFF, DFF, DFF, S, E);
        } break;
        case 3: if (PHM & 4) { const float* gains = p.in(4) + (size_t)l * 6 * 1024; rownorm_phase(p, false, 0.5f, gains + 1024, gains + 2048, true); convert_mix(p, lds, l); } break;
        case 4: if (PHM & 8) {
            pg8::SchedPlain S; S.o.init(MROWS / 256, NIN / 256, G, c); S.A = (const char*)(ws + RA); S.B = (const char*)(ws + RWM); S.at = (size_t)256 * 1024 * 2; S.bt = (size_t)256 * 1024 * 2;
            pg8::EpiIN E{(u16*)(ws + RB), (u16*)(ws + RC)};
            pg8::gemm_phase(lds, 1024, 1024, 1024, S, E);
        } break;
        case 5: for (int it = c; it < 1056 + 2080; it += G) { if (it < 1056) { if (PHM & 16) gmlp_unit(p, lds, l, it); } else { if (PHM & 32) hgrn_a_unit(p, lds, l, it - 1056); } } break;
        case 6: if (PHM & 64) hgrn_scan_phase(p, l); break;
        case 7: for (int it = c; it < 4160; it += G) { if (it < 2080) { if (PHM & 128) hgrn_c_unit(p, lds, l, it); } else { if (PHM & 256) pool_unit(p, lds, l, it - 2080); } } break;
        case 8: if (PHM & 512) {
            pg8::SchedBranch S; S.o.init(MROWS / 256, 4, G, c); S.A0 = (const char*)(ws + RB); S.B = (const char*)(ws + RWM_BR);
            pg8::EpiBranch E{(const u16*)(ws + RC), (u16*)(ws + RA)};
            pg8::gemm_phase(lds, 512, 512, 1536, S, E);
        } break;
        case 9: if (PHM & 1024) {
            pg8::SchedPlain S; S.o.init(MROWS / 256, 4, G, c); S.A = (const char*)(ws + RA); S.B = (const char*)(ws + RWM_OUT); S.at = (size_t)256 * 1024 * 2; S.bt = (size_t)256 * 1024 * 2;
            pg8::EpiF32 E{(float*)(ws + RC), 1024};
            pg8::gemm_phase(lds, 1024, 1024, 1024, S, E);
        } break;
        case 10: { const float* gains = p.in(4) + (size_t)l * 6 * 1024; rownorm_phase(p, false, 1.0f, gains + 3 * 1024, gains + 4 * 1024, true); convert_ffn(p, lds, p.in(17) + (size_t)l * 1024 * NGU, p.in(18) + (size_t)l * DFF * 1024); } break;
        case 13: { const float* gains = p.in(4) + (size_t)l * 6 * 1024; rownorm_phase(p, false, 0.5f, gains + 5 * 1024, gains + (l < DEPTH - 1 ? 6 * 1024 : 0), l < DEPTH - 1);
                 if (l < DEPTH - 1) convert_ffn(p, lds, p.in(5) + (size_t)(l + 1) * 1024 * NGU, p.in(6) + (size_t)(l + 1) * DFF * 1024); } break;
        }
    }
}

constexpr int N_PHASES = 1 + 13 * DEPTH;

extern "C" void kernel_launch(void* const* d_in, const int* in_sizes, int n_in, void* d_out, int out_size, void* d_ws, size_t ws_size, hipStream_t stream) {
    static int grid = 0;
    if (grid == 0) {
        if (n_in != 19 || ws_size < WS_END) { fprintf(stderr, "kernel_launch: need 19 inputs and %zu bytes of workspace (got %d, %zu)\n", (size_t)WS_END, n_in, ws_size); grid = -1; return; }
        int dev = 0, cus = 0, per_cu = 0;
        hipGetDevice(&dev); hipDeviceGetAttribute(&cus, hipDeviceAttributeMultiprocessorCount, dev);
        hipFuncSetAttribute((const void*)fwd_mega, hipFuncAttributeMaxDynamicSharedMemorySize, LDS_BYTES);
        hipOccupancyMaxActiveBlocksPerMultiprocessor(&per_cu, (const void*)fwd_mega, 512, LDS_BYTES);
        if (per_cu < 1) { fprintf(stderr, "kernel_launch: occupancy query says %d blocks per CU\n", per_cu); per_cu = 1; }
        (void)hipGetLastError();
        grid = cus * per_cu;
    }
    if (grid < 0) return;
    Params p{};
    for (int i = 0; i < 19; ++i) p.in[i] = (const float*)d_in[i];
    p.out = (float*)d_out; p.ws = (unsigned char*)d_ws;
#if MULTI_LAUNCH
    for (int ph = 0; ph < N_PHASES; ++ph) { p.ph_lo = ph; p.ph_hi = ph + 1; hipLaunchKernelGGL(fwd_mega, dim3(grid), dim3(512), LDS_BYTES, stream, p); }
#else
    p.ph_lo = 0; p.ph_hi = N_PHASES;
    void* args[] = {&p};
    hipError_t e = hipLaunchCooperativeKernel((const void*)fwd_mega, dim3(grid), dim3(512), args, LDS_BYTES, stream);
    if (e != hipSuccess) fprintf(stderr, "cooperative launch failed: %s (grid %d)\n", hipGetErrorString(e), grid);
#endif
}
```

```cpp
#include <hip/hip_runtime.h>
#include <hip/hip_cooperative_groups.h>
#include <cstdio>
namespace cg = cooperative_groups;

#define LAS __attribute__((address_space(3)))
typedef unsigned short u16;
typedef short bf16x8 __attribute__((ext_vector_type(8)));
typedef float f32x4 __attribute__((ext_vector_type(4)));
typedef unsigned u32x4 __attribute__((ext_vector_type(4)));
typedef unsigned u32x2 __attribute__((ext_vector_type(2)));
typedef _Float16 h16x2 __attribute__((ext_vector_type(2)));

#ifndef PHM
#define PHM 0xffff
#endif
#ifndef DUP
#define DUP 0x0
#endif
#define REP(bit) for (int rep_ = 0; rep_ <= ((DUP >> (bit)) & 1); ++rep_)
#ifndef MULTI_LAUNCH
#define MULTI_LAUNCH 0
#endif

constexpr int MROWS = 33280, MP = 32768, DM = 1024, DFF = 2816, NGU = 5632, NIN = 6656, DEPTH = 4;
constexpr int NCH64 = MROWS / 64;
constexpr float EPS = 1e-6f;
constexpr size_t O_POOLP = 34078720, O_POOLS = 34140160, O_HGP = 34385920, O_HGS = 34910208, O_VS = 37007360;
constexpr size_t COLB = (size_t)MROWS * 512 * 2;
constexpr size_t RA = 0;
constexpr size_t RB = RA + (size_t)MROWS * 1024 * 2;
constexpr size_t RC = RB + 7 * COLB;
constexpr size_t RWF = RC + (size_t)MROWS * 3072 * 2;
constexpr size_t RWF_DN = RWF + (size_t)NGU * 1024 * 2;
constexpr size_t RWM = RWF_DN + (size_t)1024 * DFF * 2;
constexpr size_t RWM_BR = RWM + (size_t)NIN * 1024 * 2;
constexpr size_t RWM_OUT = RWM_BR + (size_t)1024 * 1536 * 2;
constexpr size_t RWM_POOL = RWM_OUT + (size_t)1024 * 1024 * 2;
constexpr size_t RSM = RWM_POOL + (size_t)4 * 128 * 128 * 2;
constexpr size_t RBAR = RSM + (size_t)NCH64 * 4 * 128 * 4;
constexpr size_t WS_END = RBAR + 3456 * 4;
constexpr int LDS_BYTES = 131072 + 2048;

struct Params { const float* in[19]; float* out; unsigned char* ws; int ph_lo, ph_hi; };
struct Ctx {
    LAS const unsigned* pl;
    __device__ __forceinline__ unsigned long long q(int k) const { const unsigned lo = __builtin_amdgcn_readfirstlane(pl[2 * k]), hi = __builtin_amdgcn_readfirstlane(pl[2 * k + 1]); return ((unsigned long long)hi << 32) | lo; }
    __device__ __forceinline__ const float* in(int k) const { return (const float*)q(k); }
    __device__ __forceinline__ float* out() const { return (float*)q(19); }
    __device__ __forceinline__ unsigned char* ws() const { return (unsigned char*)q(20); }
};

__device__ __forceinline__ float bf2f(unsigned b) { return __uint_as_float(b << 16); }
__device__ __forceinline__ float bflo(unsigned w) { return __uint_as_float(w << 16); }
__device__ __forceinline__ float bfhi(unsigned w) { return __uint_as_float(w & 0xffff0000u); }
__device__ __forceinline__ u16 f2bf(float f) { unsigned u = __float_as_uint(f); u += 0x7FFFu + ((u >> 16) & 1u); return (u16)(u >> 16); }
__device__ __forceinline__ unsigned cvt_pk_bf16(float lo, float hi) { unsigned r; asm volatile("v_cvt_pk_bf16_f32 %0, %1, %2" : "=v"(r) : "v"(lo), "v"(hi)); return r; }
__device__ __forceinline__ float fsig(float x) { return __builtin_amdgcn_rcpf(1.0f + __expf(-x)); }
__device__ __forceinline__ float fsilu(float x) { return x * fsig(x); }
__device__ __forceinline__ float fgelu(float x) { return x * fsig(1.5957691216f * (x + 0.044715f * x * x * x)); }
__device__ __forceinline__ float wave_sum(float v) {
#pragma unroll
    for (int o = 32; o >= 1; o >>= 1) v += __shfl_xor(v, o);
    return v;
}

__device__ __forceinline__ int otid() { int t = threadIdx.x; asm volatile("" : "+v"(t)); return t; }
template <class T> __device__ __forceinline__ T osgpr(T x) { asm volatile("" : "+s"(x)); return x; }

namespace pg8 {
constexpr int BM = 256, BK = 64, HALF = 128, HTB = HALF * BK * 2, STAGE_BYTES = 8 * HTB, NXCD = 8, WGM = 8;
__device__ __forceinline__ int lds_byte(int r, int c) { const int st = (r >> 4) * 2 + (c >> 5), rr = r & 15, cc = c & 31, ob = rr * 64 + cc * 2; return st * 1024 + (ob ^ (((ob >> 9) & 1) << 5)); }
__device__ __forceinline__ void stage_rc(int b, int& R, int& C) { const int st = b / 1024, sb = b % 1024, swz = sb ^ (((sb >> 9) & 1) << 5); R = (st >> 1) * 16 + swz / 64; C = (st & 1) * 32 + (swz % 64) / 2; }
__device__ __forceinline__ int perm32(int rho) { const int n = rho >> 4, i = rho & 15; return 8 * (i >> 2) + 4 * n + (i & 3); }

struct Unit { const char* a; const char* b; int pm, pn, aux; };

struct TileOrder {
    int nM, nN, nwg, G, c;
    __device__ void init(int nM_, int nN_, int G_, int c_) { nM = nM_; nN = nN_; nwg = nM * nN; G = G_; c = c_; }
    __device__ bool tile(int i, int& pm, int& pn) const {
        const long L = (long)i * G + c; if (L >= nwg) return false;
        int wgid = (int)L; { const int q = nwg / NXCD, r = nwg % NXCD, xcd = wgid % NXCD, off = wgid / NXCD; wgid = (xcd < r ? xcd * (q + 1) : r * (q + 1) + (xcd - r) * q) + off; }
        const int nig = WGM * nN, gid = wgid / nig, fm = gid * WGM, gsz = (nM - fm) < WGM ? (nM - fm) : WGM;
        pm = fm + ((wgid % nig) % gsz); pn = (wgid % nig) / gsz; return true;
    }
};
struct SchedPlain {
    TileOrder o; const char* A; const char* B; size_t at, bt;
    __device__ bool next(int i, Unit& u) const { int pm, pn; if (!o.tile(i, pm, pn)) return false; u.a = A + (size_t)pm * at; u.b = B + (size_t)pn * bt; u.pm = pm; u.pn = pn; u.aux = 0; return true; }
};
struct SchedBranch {
    TileOrder o; const char* A0; const char* B;
    __device__ bool next(int i, Unit& u) const {
        const int t = i / 3, br = i - 3 * t; int pm, pn; if (!o.tile(t, pm, pn)) return false;
        const size_t aoff = br == 0 ? (size_t)0 : (br == 1 ? COLB : 3 * COLB);
        u.a = A0 + aoff + (size_t)pm * (256 * 512 * 2); u.b = B + ((size_t)pn * 256 * 1536 + (size_t)br * 512) * 2; u.pm = pm; u.pn = pn; u.aux = br; return true;
    }
};

template <class Epi, class Sched>
__device__ __forceinline__ void gemm_phase(LAS unsigned char* lds, const int K, const int lda, const int ldb, const Sched& S, const Epi& E) {
    const int tid = otid(), wid = __builtin_amdgcn_readfirstlane(tid >> 6), lane = tid & 63, wr = wid >> 2, wc = wid & 3, fr = lane & 15, fq = lane >> 4;
    const int nt = K / BK;
    unsigned voffA[2], voffB[2];
#pragma unroll
    for (int i = 0; i < 2; ++i) { int R, C; stage_rc(tid * 16 + i * 8192, R, C); const int Rb = Epi::PERM ? ((R & ~31) + perm32(R & 31)) : R;
        voffA[i] = (unsigned)(R * lda + C) * 2u; voffB[i] = (unsigned)(Rb * ldb + C) * 2u; }
    const size_t kstep = (size_t)(BK * 2);
    const size_t hstepA = (size_t)HALF * lda * 2, hstepB = (size_t)HALF * ldb * 2;
    const unsigned ldsw = (unsigned)wid * 1024u;
    const int aoff = lds_byte(wr * 64 + fr, fq * 8), boff = lds_byte(wc * 32 + fr, fq * 8);
#define PG8_SA(b, h) (((b) * 2 + (h)) * HTB)
#define PG8_SB(b, h) ((4 + (b) * 2 + (h)) * HTB)
#define PG8_STAGE(bufoff, gbase, voff) do { _Pragma("unroll") for (int _i = 0; _i < 2; ++_i) \
        __builtin_amdgcn_global_load_lds((const unsigned*)((const char*)(gbase) + (voff)[_i]), (LAS unsigned*)(lds + (bufoff) + ldsw + _i * 8192), 16, 0, 0); } while (0)
#define PG8_LDA(dst, b, h) do { _Pragma("unroll") for (int m = 0; m < 4; ++m) _Pragma("unroll") for (int k = 0; k < 2; ++k) dst[m][k] = *(const LAS bf16x8*)(lds + PG8_SA(b, h) + aoff + m * 2048 + k * 1024); } while (0)
#define PG8_LDB(dst, b, h) do { _Pragma("unroll") for (int n = 0; n < 2; ++n) _Pragma("unroll") for (int k = 0; k < 2; ++k) dst[n][k] = *(const LAS bf16x8*)(lds + PG8_SB(b, h) + boff + n * 2048 + k * 1024); } while (0)
#define PG8_MMA(ai, bj, At, Bt) do { __builtin_amdgcn_s_setprio(1); _Pragma("unroll") for (int m = 0; m < 4; ++m) _Pragma("unroll") for (int n = 0; n < 2; ++n) _Pragma("unroll") for (int k = 0; k < 2; ++k) \
        acc[ai][bj][m][n] = __builtin_amdgcn_mfma_f32_16x16x32_bf16(Bt[n][k], At[m][k], acc[ai][bj][m][n], 0, 0, 0); __builtin_amdgcn_s_setprio(0); } while (0)
#define PG8_WAIT_V(n) asm volatile("s_waitcnt vmcnt(" #n ")" ::: "memory")
#define PG8_WAIT_L(n) asm volatile("s_waitcnt lgkmcnt(" #n ")" ::: "memory")
#define PG8_BAR __builtin_amdgcn_s_barrier()
#define PG8_SCHED __builtin_amdgcn_sched_barrier(0)
    Unit cur, nxt; int ui = 0;
    if (!S.next(0, cur)) return;
    f32x4 acc[2][2][4][2];
#pragma unroll
    for (int a = 0; a < 2; ++a)
#pragma unroll
        for (int b = 0; b < 2; ++b)
#pragma unroll
            for (int m = 0; m < 4; ++m)
#pragma unroll
                for (int n = 0; n < 2; ++n) acc[a][b][m][n] = (f32x4){0.f, 0.f, 0.f, 0.f};
    bf16x8 At[4][2], B0[2][2], B1[2][2];
    const char* cA = cur.a; const char* cB = cur.b;
    PG8_STAGE(PG8_SB(0, 0), cB, voffB); PG8_STAGE(PG8_SA(0, 0), cA, voffA); PG8_STAGE(PG8_SB(0, 1), cB + hstepB, voffB); PG8_STAGE(PG8_SA(0, 1), cA + hstepA, voffA);
    if (wr == 1) PG8_BAR;
    PG8_WAIT_V(4); PG8_BAR;
    PG8_STAGE(PG8_SB(1, 0), cB + kstep, voffB); PG8_STAGE(PG8_SA(1, 0), cA + kstep, voffA); PG8_STAGE(PG8_SB(1, 1), cB + hstepB + kstep, voffB);
    PG8_WAIT_V(6); PG8_BAR;
    for (;;) {
        const bool has_next = S.next(ui + 1, nxt);
        const char* nA = has_next ? nxt.a : cA; const char* nB = has_next ? nxt.b : cB;
        for (int t = 0; t < nt; t += 2) {
            const bool last = (t == nt - 2);
            const char* a1 = cA + (size_t)(t + 1) * kstep;
            const char* a2 = last ? nA : cA + (size_t)(t + 2) * kstep; const char* b2 = last ? nB : cB + (size_t)(t + 2) * kstep;
            const char* a3 = a2 + kstep; const char* b3 = b2 + kstep;
            PG8_LDB(B0, 0, 0); PG8_SCHED; PG8_LDA(At, 0, 0); PG8_STAGE(PG8_SA(1, 1), a1 + hstepA, voffA);
            PG8_WAIT_L(8); PG8_BAR; PG8_WAIT_L(0); PG8_MMA(0, 0, At, B0); PG8_BAR; PG8_SCHED;
            PG8_LDB(B1, 0, 1); PG8_STAGE(PG8_SB(0, 0), b2, voffB);
            PG8_BAR; PG8_WAIT_L(0); PG8_MMA(0, 1, At, B1); PG8_BAR;
            PG8_LDA(At, 0, 1); PG8_STAGE(PG8_SA(0, 0), a2, voffA);
            PG8_BAR; PG8_WAIT_L(0); PG8_MMA(1, 0, At, B0); PG8_BAR; PG8_SCHED;
            PG8_STAGE(PG8_SB(0, 1), b2 + hstepB, voffB);
            PG8_WAIT_V(6); PG8_BAR; PG8_MMA(1, 1, At, B1); PG8_BAR;
            PG8_LDB(B0, 1, 0); PG8_SCHED; PG8_LDA(At, 1, 0); PG8_STAGE(PG8_SA(0, 1), a2 + hstepA, voffA);
            PG8_WAIT_L(8); PG8_BAR; PG8_WAIT_L(0); PG8_MMA(0, 0, At, B0); PG8_BAR; PG8_SCHED;
            PG8_LDB(B1, 1, 1); PG8_STAGE(PG8_SB(1, 0), b3, voffB);
            PG8_BAR; PG8_WAIT_L(0); PG8_MMA(0, 1, At, B1); PG8_BAR;
            PG8_LDA(At, 1, 1); PG8_STAGE(PG8_SA(1, 0), a3, voffA);
            PG8_BAR; PG8_WAIT_L(0); PG8_MMA(1, 0, At, B0); PG8_BAR; PG8_SCHED;
            PG8_STAGE(PG8_SB(1, 1), b3 + hstepB, voffB);
            PG8_WAIT_V(6); PG8_BAR; PG8_MMA(1, 1, At, B1); PG8_BAR;
        }
        E(acc, cur, wr, wc, fr, fq);
        if (!has_next) break;
#pragma unroll
        for (int a = 0; a < 2; ++a)
#pragma unroll
            for (int b = 0; b < 2; ++b)
#pragma unroll
                for (int m = 0; m < 4; ++m)
#pragma unroll
                    for (int n = 0; n < 2; ++n) acc[a][b][m][n] = (f32x4){0.f, 0.f, 0.f, 0.f};
        cur = nxt; cA = nA; cB = nB; ++ui;
    }
    PG8_WAIT_V(0);
    if (wr == 0) PG8_BAR;
    PG8_BAR;
#undef PG8_SA
#undef PG8_SB
#undef PG8_STAGE
#undef PG8_LDA
#undef PG8_LDB
#undef PG8_MMA
#undef PG8_WAIT_V
#undef PG8_WAIT_L
#undef PG8_BAR
#undef PG8_SCHED
}

struct EpiF32 {
    static constexpr bool PERM = false;
    float* C; int ldc;
    __device__ __forceinline__ void operator()(const f32x4 (&acc)[2][2][4][2], const Unit& u, int wr, int wc, int fr, int fq) const {
        const int row0 = u.pm * BM + wr * 64 + fr, col0 = u.pn * BM + wc * 32 + 4 * fq;
#pragma unroll
        for (int ai = 0; ai < 2; ++ai)
#pragma unroll
            for (int m = 0; m < 4; ++m) { float* rowp = C + (size_t)(row0 + ai * HALF + m * 16) * ldc + col0;
#pragma unroll
                for (int bj = 0; bj < 2; ++bj)
#pragma unroll
                    for (int n = 0; n < 2; ++n) *(f32x4*)(rowp + bj * HALF + n * 16) = acc[ai][bj][m][n]; }
    }
};
struct EpiGU {
    static constexpr bool PERM = true;
    u16* H;
    __device__ __forceinline__ void operator()(const f32x4 (&acc)[2][2][4][2], const Unit& u, int wr, int wc, int fr, int fq) const {
        const int row0 = u.pm * BM + wr * 64 + fr, col0 = u.pn * 128 + wc * 32 + 8 * fq;
#pragma unroll
        for (int ai = 0; ai < 2; ++ai)
#pragma unroll
            for (int m = 0; m < 4; ++m) { u16* rowp = H + (size_t)(row0 + ai * HALF + m * 16) * DFF + col0;
                const f32x4 g0 = acc[ai][0][m][0], g1 = acc[ai][0][m][1], u0 = acc[ai][1][m][0], u1 = acc[ai][1][m][1];
                u32x4 w; w.x = cvt_pk_bf16(fsilu(g0[0]) * u0[0], fsilu(g0[1]) * u0[1]); w.y = cvt_pk_bf16(fsilu(g0[2]) * u0[2], fsilu(g0[3]) * u0[3]);
                w.z = cvt_pk_bf16(fsilu(g1[0]) * u1[0], fsilu(g1[1]) * u1[1]); w.w = cvt_pk_bf16(fsilu(g1[2]) * u1[2], fsilu(g1[3]) * u1[3]);
                *(u32x4*)rowp = w; }
    }
};
__device__ __forceinline__ float act_in(float x, int mode) {
    switch (mode) {
        case 0: case 1: return fgelu(x);
        case 3: return fsilu(x) * 0.08838834764831845f;
        case 6: return fsilu(x);
        case 7: return fsig(x);
        default: return x;
    }
}
struct EpiIN {
    static constexpr bool PERM = true;
    u16* cols; u16* G;
    __device__ __forceinline__ void operator()(const f32x4 (&acc)[2][2][4][2], const Unit& u, int wr, int wc, int fr, int fq) const {
        const int pn = u.pn; const int mode = pn < 14 ? (pn >> 1) : 7;
        u16* base = pn < 14 ? cols + (size_t)(pn >> 1) * ((size_t)MROWS * 512) : G;
        const int ldc = pn < 14 ? 512 : 3072; const int colt = pn < 14 ? (pn & 1) * 256 : (pn - 14) * 256;
        const int row0 = u.pm * BM + wr * 64 + fr, col0 = colt + wc * 32 + 8 * fq;
#pragma unroll
        for (int ai = 0; ai < 2; ++ai)
#pragma unroll
            for (int m = 0; m < 4; ++m) { u16* rowp = base + (size_t)(row0 + ai * HALF + m * 16) * ldc + col0;
#pragma unroll
                for (int bj = 0; bj < 2; ++bj) { const f32x4 v0 = acc[ai][bj][m][0], v1 = acc[ai][bj][m][1]; u32x4 w;
                    if (mode == 4) {
                        w.x = __builtin_bit_cast(unsigned, (h16x2){(_Float16)v0[0], (_Float16)v0[1]}); w.y = __builtin_bit_cast(unsigned, (h16x2){(_Float16)v0[2], (_Float16)v0[3]});
                        w.z = __builtin_bit_cast(unsigned, (h16x2){(_Float16)v1[0], (_Float16)v1[1]}); w.w = __builtin_bit_cast(unsigned, (h16x2){(_Float16)v1[2], (_Float16)v1[3]});
                    } else {
                        w.x = cvt_pk_bf16(act_in(v0[0], mode), act_in(v0[1], mode)); w.y = cvt_pk_bf16(act_in(v0[2], mode), act_in(v0[3], mode));
                        w.z = cvt_pk_bf16(act_in(v1[0], mode), act_in(v1[1], mode)); w.w = cvt_pk_bf16(act_in(v1[2], mode), act_in(v1[3], mode));
                    }
                    *(u32x4*)(rowp + bj * HALF) = w; } }
    }
};
struct EpiBranch {
    static constexpr bool PERM = true;
    const u16* G; u16* O;
    __device__ __forceinline__ void operator()(const f32x4 (&acc)[2][2][4][2], const Unit& u, int wr, int wc, int fr, int fq) const {
        const int br = u.aux;
        const int row0 = u.pm * BM + wr * 64 + fr, col0 = u.pn * BM + wc * 32 + 8 * fq;
#pragma unroll
        for (int ai = 0; ai < 2; ++ai)
#pragma unroll
            for (int m = 0; m < 4; ++m) { const size_t r = (size_t)(row0 + ai * HALF + m * 16);
#pragma unroll
                for (int bj = 0; bj < 2; ++bj) {
                    const u32x4 gw = *(const u32x4*)(G + r * 3072 + br * 1024 + col0 + bj * HALF);
                    u16* op = O + r * 1024 + col0 + bj * HALF;
                    const f32x4 v0 = acc[ai][bj][m][0], v1 = acc[ai][bj][m][1];
                    float o0 = v0[0] * bflo(gw.x), o1 = v0[1] * bfhi(gw.x), o2 = v0[2] * bflo(gw.y), o3 = v0[3] * bfhi(gw.y);
                    float o4 = v1[0] * bflo(gw.z), o5 = v1[1] * bfhi(gw.z), o6 = v1[2] * bflo(gw.w), o7 = v1[3] * bfhi(gw.w);
                    if (br != 0) { const u32x4 pw = *(const u32x4*)op;
                        o0 += bflo(pw.x); o1 += bfhi(pw.x); o2 += bflo(pw.y); o3 += bfhi(pw.y); o4 += bflo(pw.z); o5 += bfhi(pw.z); o6 += bflo(pw.w); o7 += bfhi(pw.w); }
                    u32x4 w; w.x = cvt_pk_bf16(o0, o1); w.y = cvt_pk_bf16(o2, o3); w.z = cvt_pk_bf16(o4, o5); w.w = cvt_pk_bf16(o6, o7);
                    *(u32x4*)op = w; } }
    }
};
}

__device__ __forceinline__ void rownorm_phase(const Ctx p, bool first, float coef, const float* gpost, const float* gpre, bool write_xn) {
    float* X = p.out(); const float* Y = (const float*)(p.ws() + RC); u16* XN = (u16*)(p.ws() + RA);
    const int tid_ = otid(); const int lane = tid_ & 63, wid = tid_ >> 6;
    float4 gp[4], gq[4];
#pragma unroll
    for (int j = 0; j < 4; ++j) { gq[j] = *(const float4*)(gpre + lane * 4 + 256 * j); gp[j] = first ? gq[j] : *(const float4*)(gpost + lane * 4 + 256 * j); }
    for (int row = blockIdx.x * 8 + wid; row < MROWS; row += gridDim.x * 8) {
        const float* src = first ? (row < MP ? p.in(0) + (size_t)row * DM : p.in(1) + (size_t)(row - MP) * DM) : X + (size_t)row * DM;
        float4 x[4];
#pragma unroll
        for (int j = 0; j < 4; ++j) x[j] = *(const float4*)(src + lane * 4 + 256 * j);
        if (!first) {
            float4 y[4]; float ss = 0.f;
#pragma unroll
            for (int j = 0; j < 4; ++j) { y[j] = *(const float4*)(Y + (size_t)row * DM + lane * 4 + 256 * j); ss += y[j].x * y[j].x + y[j].y * y[j].y + y[j].z * y[j].z + y[j].w * y[j].w; }
            ss = wave_sum(ss);
            const float r = coef * rsqrtf(ss * (1.0f / DM) + EPS);
#pragma unroll
            for (int j = 0; j < 4; ++j) { x[j].x += r * y[j].x * gp[j].x; x[j].y += r * y[j].y * gp[j].y; x[j].z += r * y[j].z * gp[j].z; x[j].w += r * y[j].w * gp[j].w; }
        }
#pragma unroll
        for (int j = 0; j < 4; ++j) *(float4*)(X + (size_t)row * DM + lane * 4 + 256 * j) = x[j];
        if (write_xn) {
            float ss = 0.f;
#pragma unroll
            for (int j = 0; j < 4; ++j) ss += x[j].x * x[j].x + x[j].y * x[j].y + x[j].z * x[j].z + x[j].w * x[j].w;
            ss = wave_sum(ss);
            const float r = rsqrtf(ss * (1.0f / DM) + EPS);
#pragma unroll
            for (int j = 0; j < 4; ++j) { u32x2 w; w.x = cvt_pk_bf16(x[j].x * r * gq[j].x, x[j].y * r * gq[j].y); w.y = cvt_pk_bf16(x[j].z * r * gq[j].z, x[j].w * r * gq[j].w);
                *(u32x2*)(XN + (size_t)row * DM + lane * 4 + 256 * j) = w; }
        }
    }
}

__device__ __forceinline__ void convert_mat(LAS unsigned char* lds, const float* src, int ld, u16* dst, int K, int N, bool gu_map) {
    LAS float* tile = (LAS float*)lds;
    const int tid = otid(), nkt = K >> 6, ntiles = nkt * (N >> 6);
    for (int t = blockIdx.x; t < ntiles; t += gridDim.x) {
        const int kt = t % nkt, ntile = t / nkt, nd0 = ntile * 64;
        int sc0 = nd0;
        if (gu_map) { const int pb = nd0 >> 8, h = (nd0 >> 7) & 1, j = nd0 & 127; sc0 = h * DFF + 128 * pb + j; }
        const int kk = tid >> 4, c4 = (tid & 15) * 4;
#pragma unroll
        for (int q = 0; q < 2; ++q) { const float4 v = *(const float4*)(src + (size_t)(kt * 64 + kk + 32 * q) * ld + sc0 + c4);
            LAS float* tp = tile + (kk + 32 * q) * 65 + c4; tp[0] = v.x; tp[1] = v.y; tp[2] = v.z; tp[3] = v.w; }
        __syncthreads();
        const int n = tid >> 3, ks = (tid & 7) * 8;
        float e[8];
#pragma unroll
        for (int i = 0; i < 8; ++i) e[i] = tile[(ks + i) * 65 + n];
        u32x4 w; w.x = cvt_pk_bf16(e[0], e[1]); w.y = cvt_pk_bf16(e[2], e[3]); w.z = cvt_pk_bf16(e[4], e[5]); w.w = cvt_pk_bf16(e[6], e[7]);
        *(u32x4*)(dst + (size_t)(nd0 + n) * K + kt * 64 + ks) = w;
        __syncthreads();
    }
}
__device__ __forceinline__ void convert_ffn(const Ctx p, LAS unsigned char* lds, const float* wgu, const float* wdn) {
    convert_mat(lds, wgu, NGU, (u16*)(p.ws() + RWF), 1024, NGU, true);
    convert_mat(lds, wdn, 1024, (u16*)(p.ws() + RWF_DN), DFF, 1024, false);
}
__device__ __forceinline__ void convert_mix(const Ctx p, LAS unsigned char* lds, int l) {
    convert_mat(lds, p.in(7) + (size_t)l * 1024 * NIN, NIN, (u16*)(p.ws() + RWM), 1024, NIN, false);
    convert_mat(lds, p.in(15) + (size_t)l * 1536 * 1024, 1024, (u16*)(p.ws() + RWM_BR), 1536, 1024, false);
    convert_mat(lds, p.in(16) + (size_t)l * 1024 * 1024, 1024, (u16*)(p.ws() + RWM_OUT), 1024, 1024, false);
    for (int g = 0; g < 4; ++g) convert_mat(lds, p.in(11) + ((size_t)l * 4 + g) * 16384, 128, (u16*)(p.ws() + RWM_POOL) + g * 16384, 128, 128, false);
}

#define MFMA16(a, b, c) __builtin_amdgcn_mfma_f32_16x16x32_bf16((a), (b), (c), 0, 0, 0)
__device__ __forceinline__ bf16x8 ldsfrag(const LAS u16* base, int row, int ld, int k) { return *(const LAS bf16x8*)(base + row * ld + k); }

__device__ __forceinline__ void gmlp_unit(const Ctx p, LAS unsigned char* lds, int l, int unit, int wrf = 1) {
    const int tid = otid(), wid = tid >> 6, lane = tid & 63, fr = lane & 15, fq = lane >> 4;
    int row0, L, h, bs = -1;
    if (unit < 1024) { row0 = (unit >> 2) * 128; h = unit & 3; L = 128; } else { const int s = unit - 1024; bs = s >> 2; h = s & 3; row0 = MP + bs * 64; L = 64; }
    u16* U = (u16*)(p.ws() + RB); const u16* V = (const u16*)(p.ws() + RB + COLB);
    LAS float* rs = (LAS float*)lds; LAS u16* Vt = (LAS u16*)(lds + 1024); LAS u16* Wl = (LAS u16*)(lds + 35840);
    constexpr int LD = 136;
    {
        const int row = tid >> 2, part = tid & 3; float ss = 0.f;
        if (row < L) {
#pragma unroll
            for (int i = 0; i < 16; ++i) { const u32x4 w = *(const u32x4*)(V + (size_t)(row0 + row) * 512 + part * 128 + i * 8);
                float a; a = bflo(w.x); ss += a * a; a = bfhi(w.x); ss += a * a; a = bflo(w.y); ss += a * a; a = bfhi(w.y); ss += a * a;
                a = bflo(w.z); ss += a * a; a = bfhi(w.z); ss += a * a; a = bflo(w.w); ss += a * a; a = bfhi(w.w); ss += a * a; }
        }
        ss += __shfl_xor(ss, 1); ss += __shfl_xor(ss, 2);
        if (part == 0 && row < L) rs[row] = rsqrtf(ss * (1.0f / 512.0f) + EPS);
    }
    __syncthreads();
    {
        const int s = tid & 127, cg4 = tid >> 7;
        if (s < L) {
            const float r = rs[s]; const float* vg = p.in(8) + l * 512 + h * 128 + cg4 * 32;
            float* vout = bs >= 0 ? p.out() + O_VS + ((size_t)(l * 8 + bs) * 64 + s) * 512 + h * 128 + cg4 * 32 : nullptr;
#pragma unroll
            for (int i = 0; i < 4; ++i) { const u32x4 w = *(const u32x4*)(V + (size_t)(row0 + s) * 512 + h * 128 + cg4 * 32 + i * 8);
                float e[8] = {bflo(w.x), bfhi(w.x), bflo(w.y), bfhi(w.y), bflo(w.z), bfhi(w.z), bflo(w.w), bfhi(w.w)};
#pragma unroll
                for (int j = 0; j < 8; ++j) { const float vv = e[j] * r * vg[i * 8 + j]; Vt[(cg4 * 32 + i * 8 + j) * LD + s] = f2bf(vv); if (vout) vout[i * 8 + j] = vv; } }
        }
    }
    {
        const int t = tid >> 2, sq = (tid & 3) * 32;
        if (t < L) { const float* wp = p.in(9) + ((size_t)(l * 4 + h) * 128 + t) * 128 + sq;
#pragma unroll
            for (int i = 0; i < 4; ++i) { const float4 a = *(const float4*)(wp + i * 8), b = *(const float4*)(wp + i * 8 + 4); const int s0 = sq + i * 8;
                u32x4 w; w.x = cvt_pk_bf16(s0 + 0 <= t ? a.x : 0.f, s0 + 1 <= t ? a.y : 0.f); w.y = cvt_pk_bf16(s0 + 2 <= t ? a.z : 0.f, s0 + 3 <= t ? a.w : 0.f);
                w.z = cvt_pk_bf16(s0 + 4 <= t ? b.x : 0.f, s0 + 5 <= t ? b.y : 0.f); w.w = cvt_pk_bf16(s0 + 6 <= t ? b.z : 0.f, s0 + 7 <= t ? b.w : 0.f);
                *(LAS u32x4*)(Wl + t * LD + s0) = w; } }
    }
    __syncthreads();
    if (wid * 16 < L) {
        f32x4 acc[8];
#pragma unroll
        for (int n = 0; n < 8; ++n) acc[n] = (f32x4){0.f, 0.f, 0.f, 0.f};
        const int kmax = (wid * 16 + 15) / 32 + 1;
        for (int ks = 0; ks < kmax; ++ks) { const bf16x8 a = ldsfrag(Wl, wid * 16 + fr, LD, ks * 32 + fq * 8);
#pragma unroll
            for (int n = 0; n < 8; ++n) acc[n] = MFMA16(a, ldsfrag(Vt, n * 16 + fr, LD, ks * 32 + fq * 8), acc[n]); }
        const float* bsp = p.in(10) + (l * 4 + h) * 128;
#pragma unroll
        for (int j = 0; j < 4; ++j) { const int t = wid * 16 + fq * 4 + j; const float bias = bsp[t];
#pragma unroll
            for (int n = 0; n < 8; ++n) { u16* up = U + (size_t)(row0 + t) * 512 + h * 128 + n * 16 + fr; const u16 ov = f2bf(bf2f(*up) * (acc[n][j] + bias)); if (wrf) *up = ov; } }
    }
    __syncthreads();
}

__device__ __forceinline__ float hgrn_lb(const float* lbp, int l, int c) {
    const float x0 = lbp[c], x1 = lbp[512 + c], x2 = lbp[1024 + c], x3 = lbp[1536 + c];
    const float m = fmaxf(fmaxf(x0, x1), fmaxf(x2, x3));
    const float e0 = __expf(x0 - m), e1 = __expf(x1 - m), e2 = __expf(x2 - m), e3 = __expf(x3 - m);
    float num = 0.f; if (l >= 1) num += e1; if (l >= 2) num += e2; if (l >= 3) num += e3;
    return num / (e0 + e1 + e2 + e3);
}
__device__ __forceinline__ int chunk_row0(int cq) { return cq < 512 ? cq * 64 : MP + (cq - 512) * 64; }

__device__ __forceinline__ void hgrn_a_unit(const Ctx p, LAS unsigned char* lds, int l, int unit) {
    const int tid = otid(), wid = tid >> 6, lane = tid & 63, fr = lane & 15, fq = lane >> 4;
    const int cq = unit >> 2, h = unit & 3, row0 = chunk_row0(cq);
    const u16* F = (const u16*)(p.ws() + RB + 4 * COLB); const u16* I = (const u16*)(p.ws() + RB + 5 * COLB);
    u16* St = (u16*)(p.ws() + RA) + (size_t)unit * 16384; float* dcy = (float*)(p.ws() + RSM) + (size_t)unit * 128;
    LAS float* segtot = (LAS float*)lds; LAS u16* Kt = (LAS u16*)(lds + 4096); LAS u16* Vt = (LAS u16*)(lds + 22528);
    constexpr int LD = 72;
    const int k = tid & 127, seg = tid >> 7;
    const float lb = hgrn_lb(p.in(13), l, h * 128 + k);
    float lf[16], kk[16]; float run = 0.f;
#pragma unroll
    for (int i = 0; i < 16; ++i) { const u16 zb = F[(size_t)(row0 + seg * 16 + i) * 512 + h * 128 + k]; const float z = (float)__builtin_bit_cast(_Float16, zb);
        const float sg = fsig(z); const float f = lb + (1.0f - lb) * sg; kk[i] = 1.0f - f; run += __logf(fmaxf(f, 1e-30f)); lf[i] = run; }
    segtot[seg * 128 + k] = run;
    { const int s = tid & 63, cg = tid >> 6;
#pragma unroll
        for (int i = 0; i < 2; ++i) { const u32x4 w = *(const u32x4*)(I + (size_t)(row0 + s) * 512 + h * 128 + cg * 16 + i * 8); LAS u16* vp = Vt + (cg * 16 + i * 8) * LD + s;
            vp[0] = (u16)(w.x & 0xffff); vp[LD] = (u16)(w.x >> 16); vp[2 * LD] = (u16)(w.y & 0xffff); vp[3 * LD] = (u16)(w.y >> 16);
            vp[4 * LD] = (u16)(w.z & 0xffff); vp[5 * LD] = (u16)(w.z >> 16); vp[6 * LD] = (u16)(w.w & 0xffff); vp[7 * LD] = (u16)(w.w >> 16); } }
    __syncthreads();
    { const float t0 = segtot[k], t1 = segtot[128 + k], t2 = segtot[256 + k], t3 = segtot[384 + k];
        const float off = seg == 0 ? 0.f : (seg == 1 ? t0 : (seg == 2 ? t0 + t1 : t0 + t1 + t2)); const float blast = t0 + t1 + t2 + t3;
#pragma unroll
        for (int i = 0; i < 16; ++i) Kt[k * LD + seg * 16 + i] = f2bf(kk[i] * __expf(blast - (off + lf[i])));
        if (seg == 0) dcy[k] = __expf(blast); }
    __syncthreads();
    { f32x4 acc[8];
#pragma unroll
        for (int n = 0; n < 8; ++n) acc[n] = (f32x4){0.f, 0.f, 0.f, 0.f};
#pragma unroll
        for (int ks = 0; ks < 2; ++ks) { const bf16x8 a = ldsfrag(Kt, wid * 16 + fr, LD, ks * 32 + fq * 8);
#pragma unroll
            for (int n = 0; n < 8; ++n) acc[n] = MFMA16(a, ldsfrag(Vt, n * 16 + fr, LD, ks * 32 + fq * 8), acc[n]); }
#pragma unroll
        for (int n = 0; n < 8; ++n) { u32x2 w; w.x = cvt_pk_bf16(acc[n][0], acc[n][1]); w.y = cvt_pk_bf16(acc[n][2], acc[n][3]);
            *(u32x2*)(St + (size_t)(n * 16 + fr) * 128 + wid * 16 + fq * 4) = w; } }
    __syncthreads();
}

__device__ __forceinline__ void hgrn_scan_phase(const Ctx p, int l, int wrf = 1) {
    u16* SR = (u16*)(p.ws() + RA); const float* dcy = (const float*)(p.ws() + RSM);
    const int gtid = blockIdx.x * blockDim.x + otid(), gsz = gridDim.x * blockDim.x;
    for (int e = gtid; e < 8 * 16384; e += gsz) {
        const int seq = e >> 14, el = e & 16383, b = seq >> 2, h = seq & 3, k = el & 127, v = el >> 7;
        u16* sp = SR + ((size_t)(b * 256) * 4 + h) * 16384 + el; const float* dp = dcy + ((size_t)(b * 256) * 4 + h) * 128 + k;
        float st = 0.f;
        for (int n0 = 0; n0 < 256; n0 += 16) {
            float uu[16], dd[16];
#pragma unroll
            for (int j = 0; j < 16; ++j) { uu[j] = bf2f(sp[(size_t)(n0 + j) * 65536]); dd[j] = dp[(size_t)(n0 + j) * 512]; }
#pragma unroll
            for (int j = 0; j < 16; ++j) { if (wrf) sp[(size_t)(n0 + j) * 65536] = f2bf(st); st = dd[j] * st + uu[j]; }
        }
        if (wrf) p.out()[O_HGP + ((size_t)(l * 2 + b) * 4 + h) * 16384 + k * 128 + v] = st;
    }
    for (int e = gtid; e < 32 * 16384; e += gsz) {
        const int bh = e >> 14, el = e & 16383, k = el & 127, v = el >> 7;
        u16* sp = SR + ((size_t)(512 * 4) + bh) * 16384 + el;
        const float s0 = p.in(3)[((size_t)l * 32 + bh) * 16384 + k * 128 + v];
        const float uu = bf2f(*sp), dd = dcy[((size_t)(512 * 4) + bh) * 128 + k];
        if (wrf) *sp = f2bf(s0);
        if (wrf) p.out()[O_HGS + ((size_t)l * 32 + bh) * 16384 + k * 128 + v] = dd * s0 + uu;
    }
}

__device__ __forceinline__ void hgrn_c_unit(const Ctx p, LAS unsigned char* lds, int l, int unit, int wrf = 1) {
    const int tid = otid(), wid = tid >> 6, lane = tid & 63, fr = lane & 15, fq = lane >> 4;
    const int cq = unit >> 2, h = unit & 3, row0 = chunk_row0(cq);
    u16* Q = (u16*)(p.ws() + RB + 3 * COLB); const u16* F = (const u16*)(p.ws() + RB + 4 * COLB); const u16* I = (const u16*)(p.ws() + RB + 5 * COLB); const u16* GG = (const u16*)(p.ws() + RB + 6 * COLB);
    const u16* St = (const u16*)(p.ws() + RA) + (size_t)unit * 16384;
    LAS float* segtot = (LAS float*)lds; LAS float* red = (LAS float*)(lds + 2560);
    LAS u16* Qi = (LAS u16*)(lds + 4096); LAS u16* Qh = (LAS u16*)(lds + 21504); LAS u16* Kh = (LAS u16*)(lds + 38912);
    LAS u16* Vt = (LAS u16*)(lds + 56320); LAS u16* Sl = (LAS u16*)(lds + 74752); LAS u16* P = (LAS u16*)(lds + 109568);
    constexpr int LDK = 136, LDS_ = 72;
    const int k = tid & 127, seg = tid >> 7;
    const float lb = hgrn_lb(p.in(13), l, h * 128 + k);
    float lf[16], kk[16]; float run = 0.f;
#pragma unroll
    for (int i = 0; i < 16; ++i) { const u16 zb = F[(size_t)(row0 + seg * 16 + i) * 512 + h * 128 + k]; const float z = (float)__builtin_bit_cast(_Float16, zb);
        const float sg = fsig(z); const float f = lb + (1.0f - lb) * sg; kk[i] = 1.0f - f; run += __logf(fmaxf(f, 1e-30f)); lf[i] = run; }
    segtot[seg * 128 + k] = run;
    { const int s = tid & 63, cg = tid >> 6;
#pragma unroll
        for (int i = 0; i < 2; ++i) { const u32x4 w = *(const u32x4*)(I + (size_t)(row0 + s) * 512 + h * 128 + cg * 16 + i * 8); LAS u16* vp = Vt + (cg * 16 + i * 8) * LDS_ + s;
            vp[0] = (u16)(w.x & 0xffff); vp[LDS_] = (u16)(w.x >> 16); vp[2 * LDS_] = (u16)(w.y & 0xffff); vp[3 * LDS_] = (u16)(w.y >> 16);
            vp[4 * LDS_] = (u16)(w.z & 0xffff); vp[5 * LDS_] = (u16)(w.z >> 16); vp[6 * LDS_] = (u16)(w.w & 0xffff); vp[7 * LDS_] = (u16)(w.w >> 16); } }
#pragma unroll
    for (int i = 0; i < 4; ++i) { const int c = tid + i * 512, r = c >> 4, cc = (c & 15) * 8;
        *(LAS u32x4*)(Sl + r * LDK + cc) = *(const u32x4*)(St + r * 128 + cc); }
    __syncthreads();
    { const float t0 = segtot[k], t1 = segtot[128 + k], t2 = segtot[256 + k];
        const float off = seg == 0 ? 0.f : (seg == 1 ? t0 : (seg == 2 ? t0 + t1 : t0 + t1 + t2)); const float bref = t0 + t1;
#pragma unroll
        for (int i = 0; i < 16; ++i) { const int s = seg * 16 + i; const float b = off + lf[i]; const float q = bf2f(Q[(size_t)(row0 + s) * 512 + h * 128 + k]);
            Qi[s * LDK + k] = f2bf(q * __expf(b)); Qh[s * LDK + k] = f2bf(q * __expf(b - bref)); Kh[s * LDK + k] = f2bf(kk[i] * __expf(bref - b)); } }
    __syncthreads();
    {
        const int tt = wid >> 1;
#pragma unroll
        for (int q2 = 0; q2 < 2; ++q2) { const int stl = (wid & 1) * 2 + q2; f32x4 acc = (f32x4){0.f, 0.f, 0.f, 0.f};
            if (stl <= tt) {
#pragma unroll
                for (int ks = 0; ks < 4; ++ks) acc = MFMA16(ldsfrag(Qh, tt * 16 + fr, LDK, ks * 32 + fq * 8), ldsfrag(Kh, stl * 16 + fr, LDK, ks * 32 + fq * 8), acc); }
#pragma unroll
            for (int j = 0; j < 4; ++j) { const int t = tt * 16 + fq * 4 + j, s = stl * 16 + fr; P[t * LDS_ + s] = (stl <= tt && s <= t) ? f2bf(acc[j]) : (u16)0; } }
    }
    __syncthreads();
    { const int tt = wid & 3, nh = wid >> 2; f32x4 acc[4];
#pragma unroll
        for (int n = 0; n < 4; ++n) acc[n] = (f32x4){0.f, 0.f, 0.f, 0.f};
#pragma unroll
        for (int ks = 0; ks < 4; ++ks) { const bf16x8 a = ldsfrag(Qi, tt * 16 + fr, LDK, ks * 32 + fq * 8);
#pragma unroll
            for (int n = 0; n < 4; ++n) acc[n] = MFMA16(a, ldsfrag(Sl, (nh * 4 + n) * 16 + fr, LDK, ks * 32 + fq * 8), acc[n]); }
#pragma unroll
        for (int ks = 0; ks < 2; ++ks) { const bf16x8 a = ldsfrag(P, tt * 16 + fr, LDS_, ks * 32 + fq * 8);
#pragma unroll
            for (int n = 0; n < 4; ++n) acc[n] = MFMA16(a, ldsfrag(Vt, (nh * 4 + n) * 16 + fr, LDS_, ks * 32 + fq * 8), acc[n]); }
        float ssq[4];
#pragma unroll
        for (int j = 0; j < 4; ++j) { float s = 0.f;
#pragma unroll
            for (int n = 0; n < 4; ++n) s += acc[n][j] * acc[n][j];
            s += __shfl_xor(s, 1); s += __shfl_xor(s, 2); s += __shfl_xor(s, 4); s += __shfl_xor(s, 8); ssq[j] = s; }
        if (fr == 0) {
#pragma unroll
            for (int j = 0; j < 4; ++j) red[nh * 64 + tt * 16 + fq * 4 + j] = ssq[j]; }
        __syncthreads();
        const float* og = p.in(14) + l * 128;
#pragma unroll
        for (int j = 0; j < 4; ++j) { const int t = tt * 16 + fq * 4 + j; const float r = rsqrtf((red[t] + red[64 + t]) * (1.0f / 128.0f) + EPS);
#pragma unroll
            for (int n = 0; n < 4; ++n) { const int v = (nh * 4 + n) * 16 + fr; const size_t idx = (size_t)(row0 + t) * 512 + h * 128 + v;
                const u16 ov = f2bf(acc[n][j] * r * og[v] * bf2f(GG[idx])); if (wrf) Q[idx] = ov; } }
    }
    __syncthreads();
}

__device__ __forceinline__ void pool_unit(const Ctx p, LAS unsigned char* lds, int l, int unit) {
    const int tid = otid(), wid = tid >> 6, lane = tid & 63, fr = lane & 15, fq = lane >> 4;
    const int cq = unit >> 2, g = unit & 3, row0 = chunk_row0(cq);
    const bool samp = cq >= 512; const int bs = cq - 512; const int t0 = samp ? 0 : (cq & 255) * 64;
    const u16* XB = (const u16*)(p.ws() + RB + 2 * COLB); u16* OB = (u16*)(p.ws() + RB + COLB);
    const u16* Wpt = (const u16*)(p.ws() + RWM_POOL) + g * 16384;
    LAS float* Xs = (LAS float*)lds; LAS u16* Wp = (LAS u16*)(lds + 40448); LAS u16* Pp = (LAS u16*)(lds + 75264);
    constexpr int LD = 136;
    for (int c = tid; c < 79 * 16; c += 512) { const int j = c >> 4, cc = (c & 15) * 8; const int tk = t0 - 15 + j;
        LAS float* xp = Xs + j * 128 + cc;
        if (tk >= 0) { const u32x4 w = *(const u32x4*)(XB + (size_t)(row0 - 15 + j) * 512 + g * 128 + cc);
            xp[0] = bflo(w.x); xp[1] = bfhi(w.x); xp[2] = bflo(w.y); xp[3] = bfhi(w.y); xp[4] = bflo(w.z); xp[5] = bfhi(w.z); xp[6] = bflo(w.w); xp[7] = bfhi(w.w); }
        else if (samp) { const float* sp = p.in(2) + ((size_t)(l * 8 + bs) * 15 + j) * 512 + g * 128 + cc;
#pragma unroll
            for (int i = 0; i < 8; ++i) xp[i] = sp[i]; }
        else {
#pragma unroll
            for (int i = 0; i < 8; ++i) xp[i] = 0.f; } }
#pragma unroll
    for (int i = 0; i < 4; ++i) { const int c = tid + i * 512, r = c >> 4, cc = (c & 15) * 8; *(LAS u32x4*)(Wp + r * LD + cc) = *(const u32x4*)(Wpt + r * 128 + cc); }
    __syncthreads();
    { const int c = tid & 127, tq = tid >> 7; const int w = 2 << g; const int nvalid = samp ? 15 : 0;
        float s = 0.f;
        for (int j = 1; j < w; ++j) s += Xs[(15 + tq * 16 - j) * 128 + c];
        for (int i = 0; i < 16; ++i) { const int t = tq * 16 + i; const float x = Xs[(15 + t) * 128 + c]; s += x;
            const int avail = t0 + t + 1 + nvalid; const float cnt = (float)(avail < w ? avail : w);
            Pp[t * LD + c] = f2bf(s / cnt - x); s -= Xs[(15 + t - (w - 1)) * 128 + c]; } }
    if (samp || t0 == 16320) { float* po = samp ? p.out() + O_POOLS + ((size_t)(l * 8 + bs) * 15) * 512 : p.out() + O_POOLP + ((size_t)(l * 2 + (cq >> 8)) * 15) * 512;
        for (int c = tid; c < 15 * 128; c += 512) { const int j = c >> 7, cc = c & 127; po[(size_t)j * 512 + g * 128 + cc] = Xs[(15 + 49 + j) * 128 + cc]; } }
    __syncthreads();
    { const int tt = wid & 3, nh = wid >> 2; f32x4 acc[4];
#pragma unroll
        for (int n = 0; n < 4; ++n) acc[n] = (f32x4){0.f, 0.f, 0.f, 0.f};
#pragma unroll
        for (int ks = 0; ks < 4; ++ks) { const bf16x8 a = ldsfrag(Pp, tt * 16 + fr, LD, ks * 32 + fq * 8);
#pragma unroll
            for (int n = 0; n < 4; ++n) acc[n] = MFMA16(a, ldsfrag(Wp, (nh * 4 + n) * 16 + fr, LD, ks * 32 + fq * 8), acc[n]); }
        const float* sc = p.in(12) + l * 512 + g * 128;
#pragma unroll
        for (int n = 0; n < 4; ++n) { const int d = (nh * 4 + n) * 16 + fr; const float scd = sc[d];
#pragma unroll
            for (int j = 0; j < 4; ++j) { const int t = tt * 16 + fq * 4 + j; OB[(size_t)(row0 + t) * 512 + g * 128 + d] = f2bf(acc[n][j] * scd); } }
    }
    __syncthreads();
}


#define XB_TMO      128
#define XB_XCNT(j)  (256  + 64 * (j))
#define XB_XSUB(j)  (1280 + 64 * (j))
#define XB_XGEN(j)  (2304 + 64 * (j))
#define XB_TOP      3328
#define XB_TOPGEN   3392
#define XCD_BAR_WORDS 3456
#define XB_SPIN_CAP (1u << 20)
__device__ __forceinline__ unsigned xb_ld(unsigned* p)              { return __hip_atomic_load(p, __ATOMIC_RELAXED, __HIP_MEMORY_SCOPE_AGENT); }
__device__ __forceinline__ unsigned xb_add(unsigned* p, unsigned v) { return __hip_atomic_fetch_add(p, v, __ATOMIC_RELAXED, __HIP_MEMORY_SCOPE_AGENT); }
__device__ __forceinline__ unsigned xb_xcc_id() { return (unsigned)__builtin_amdgcn_s_getreg((3 << 11) | 20) & 0xFu; }
#define XB_SPIN(cond, bar) do { unsigned _sp = 0; while (cond) { __builtin_amdgcn_s_sleep(1); \
    if ((++_sp & 255u) == 0u) { if (xb_ld(&(bar)[XB_TMO])) break; if (_sp > XB_SPIN_CAP) { atomicAdd(&(bar)[XB_TMO], 1u); break; } } } } while (0)
__device__ __forceinline__ void xcd_barrier_complete(unsigned* bar, unsigned x, unsigned& nloc, unsigned& nx) {
    const unsigned G = gridDim.x;
    unsigned sum, cnt, mine, sp = 0u;
    for (;;) {
        sum = 0u; cnt = 0u; mine = 0u;
#pragma unroll
        for (unsigned j = 0; j < 16; ++j) { const unsigned c = xb_ld(&bar[XB_XCNT(j)]); sum += c; cnt += (c > 0u) ? 1u : 0u; mine = (j == x) ? c : mine; }
        if (sum == G) break;
        __builtin_amdgcn_s_sleep(1);
        if ((++sp & 255u) == 0u) { if (xb_ld(&bar[XB_TMO])) break; if (sp > XB_SPIN_CAP) { atomicAdd(&bar[XB_TMO], 1u); break; } }
    }
    nloc = mine > 0u ? mine : 1u; nx = cnt > 0u ? cnt : 1u;
}
__device__ __forceinline__ void xcd_barrier(unsigned* bar, volatile LAS unsigned* st) {
    asm volatile("s_waitcnt vmcnt(0)" ::: "memory");
    __syncthreads();
    if (threadIdx.x == 0) {
        const unsigned x = xb_xcc_id();
        __builtin_amdgcn_s_waitcnt(0);
        unsigned nloc = st[0], nx = st[1];
        if (nloc == 0u) { xcd_barrier_complete(bar, x, nloc, nx); st[0] = nloc; st[1] = nx; }
        const unsigned old = xb_add(&bar[XB_XSUB(x)], 1u);
        const unsigned gen = old / nloc;
        if (old + 1u == (gen + 1u) * nloc) {
            __builtin_amdgcn_fence(__ATOMIC_RELEASE, "agent");
            asm volatile("s_waitcnt vmcnt(0)" ::: "memory");
            const unsigned og = xb_add(&bar[XB_TOP], 1u);
            const unsigned tg = og / nx;
            if (og + 1u == (tg + 1u) * nx) xb_add(&bar[XB_TOPGEN], 1u);
            else XB_SPIN(xb_ld(&bar[XB_TOPGEN]) == tg, bar);
            __builtin_amdgcn_fence(__ATOMIC_ACQUIRE, "agent");
            xb_add(&bar[XB_XGEN(x)], 1u);
            asm volatile("s_waitcnt vmcnt(0)" ::: "memory");
        } else {
            XB_SPIN(xb_ld(&bar[XB_XGEN(x)]) == gen, bar);
            __builtin_amdgcn_fence(__ATOMIC_ACQUIRE, "agent");
            asm volatile("s_waitcnt vmcnt(0)" ::: "memory");
        }
    }
    __syncthreads();
}

__global__ void __launch_bounds__(512, 2) fwd_mega(Params kp) {
    extern __shared__ __attribute__((aligned(16))) unsigned char lds_raw[];
    LAS unsigned char* lds = (LAS unsigned char*)lds_raw;
    cg::grid_group grid = cg::this_grid();
    { LAS unsigned* pw = (LAS unsigned*)(lds + 131072); const unsigned* src = (const unsigned*)&kp; if (threadIdx.x < sizeof(Params) / 4) pw[threadIdx.x] = src[threadIdx.x];
      if (threadIdx.x >= 128 && threadIdx.x < 132) pw[threadIdx.x] = 0u; }
    __syncthreads();
    volatile LAS unsigned* bst = (volatile LAS unsigned*)(lds + 131072 + 512);
    if (threadIdx.x == 0) (void)xb_add(&((unsigned*)(kp.ws + RBAR))[XB_XCNT(xb_xcc_id())], 1u);
    Ctx p; p.pl = (LAS const unsigned*)(lds + 131072);
    const int ph_lo = __builtin_amdgcn_readfirstlane(p.pl[42]), ph_hi = __builtin_amdgcn_readfirstlane(p.pl[43]);
    for (int ph = ph_lo; ph < ph_hi; ++ph) {
        if (ph > ph_lo) { if (ph == ph_lo + 1) grid.sync(); else xcd_barrier((unsigned*)(p.ws() + RBAR), bst); }
        const int G = gridDim.x, c = blockIdx.x;
        if (ph == 0) {
            rownorm_phase(p, true, 0.f, nullptr, p.in(4), true);
            convert_ffn(p, lds, p.in(5), p.in(6));
            continue;
        }
        const int l = (ph - 1) / 13, s = (ph - 1) % 13 + 1;
        unsigned char* ws = p.ws();
        switch (s) {
        case 1: case 11: if (PHM & 1) {
            pg8::SchedPlain S; S.o.init(MROWS / 256, NGU / 256, G, c); S.A = (const char*)(ws + RA); S.B = (const char*)(ws + RWF); S.at = (size_t)256 * 1024 * 2; S.bt = (size_t)256 * 1024 * 2;
            pg8::EpiGU E{(u16*)(ws + RB)};
            REP(0) pg8::gemm_phase(lds, 1024, 1024, 1024, S, E);
        } break;
        case 2: case 12: if (PHM & 2) {
            pg8::SchedPlain S; S.o.init(MROWS / 256, 4, G, c); S.A = (const char*)(ws + RB); S.B = (const char*)(ws + RWF_DN); S.at = (size_t)256 * DFF * 2; S.bt = (size_t)256 * DFF * 2;
            pg8::EpiF32 E{(float*)(ws + RC), 1024};
            REP(1) pg8::gemm_phase(lds, DFF, DFF, DFF, S, E);
        } break;
        case 3: if (PHM & 4) { const float* gains = p.in(4) + (size_t)l * 6 * 1024; REP(11) rownorm_phase(p, false, rep_ ? 0.f : 0.5f, gains + 1024, gains + 2048, true); REP(7) convert_mix(p, lds, l); } break;
        case 4: if (PHM & 8) {
            pg8::SchedPlain S; S.o.init(MROWS / 256, NIN / 256, G, c); S.A = (const char*)(ws + RA); S.B = (const char*)(ws + RWM); S.at = (size_t)256 * 1024 * 2; S.bt = (size_t)256 * 1024 * 2;
            pg8::EpiIN E{(u16*)(ws + RB), (u16*)(ws + RC)};
            REP(2) pg8::gemm_phase(lds, 1024, 1024, 1024, S, E);
        } break;
        case 5: for (int it = c; it < 1056 + 2080; it += G) { if (it < 1056) { if (PHM & 16) REP(8) gmlp_unit(p, lds, l, it, osgpr(rep_ == 0 ? 1 : 0)); } else { if (PHM & 32) REP(5) hgrn_a_unit(p, lds, l, it - 1056); } } break;
        case 6: if (PHM & 64) REP(9) hgrn_scan_phase(p, l, osgpr(rep_ == 0 ? 1 : 0)); break;
        case 7: for (int it = c; it < 4160; it += G) { if (it < 2080) { if (PHM & 128) REP(10) hgrn_c_unit(p, lds, l, it, osgpr(rep_ == 0 ? 1 : 0)); } else { if (PHM & 256) REP(6) pool_unit(p, lds, l, it - 2080); } } break;
        case 8: if (PHM & 512) {
            pg8::SchedBranch S; S.o.init(MROWS / 256, 4, G, c); S.A0 = (const char*)(ws + RB); S.B = (const char*)(ws + RWM_BR);
            pg8::EpiBranch E{(const u16*)(ws + RC), (u16*)(ws + RA)};
            REP(3) pg8::gemm_phase(lds, 512, 512, 1536, S, E);
        } break;
        case 9: if (PHM & 1024) {
            pg8::SchedPlain S; S.o.init(MROWS / 256, 4, G, c); S.A = (const char*)(ws + RA); S.B = (const char*)(ws + RWM_OUT); S.at = (size_t)256 * 1024 * 2; S.bt = (size_t)256 * 1024 * 2;
            pg8::EpiF32 E{(float*)(ws + RC), 1024};
            REP(4) pg8::gemm_phase(lds, 1024, 1024, 1024, S, E);
        } break;
        case 10: { const float* gains = p.in(4) + (size_t)l * 6 * 1024; REP(11) rownorm_phase(p, false, rep_ ? 0.f : 1.0f, gains + 3 * 1024, gains + 4 * 1024, true); REP(12) convert_ffn(p, lds, p.in(17) + (size_t)l * 1024 * NGU, p.in(18) + (size_t)l * DFF * 1024); } break;
        case 13: { const float* gains = p.in(4) + (size_t)l * 6 * 1024; REP(11) rownorm_phase(p, false, rep_ ? 0.f : 0.5f, gains + 5 * 1024, gains + (l < DEPTH - 1 ? 6 * 1024 : 0), l < DEPTH - 1);
                 if (l < DEPTH - 1) REP(12) convert_ffn(p, lds, p.in(5) + (size_t)(l + 1) * 1024 * NGU, p.in(6) + (size_t)(l + 1) * DFF * 1024); } break;
        }
    }
}

constexpr int N_PHASES = 1 + 13 * DEPTH;

extern "C" void kernel_launch(void* const* d_in, const int* in_sizes, int n_in, void* d_out, int out_size, void* d_ws, size_t ws_size, hipStream_t stream) {
    static int grid = 0;
    if (grid == 0) {
        if (n_in != 19 || ws_size < WS_END) { fprintf(stderr, "kernel_launch: need 19 inputs and %zu bytes of workspace (got %d, %zu)\n", (size_t)WS_END, n_in, ws_size); grid = -1; return; }
        int dev = 0, cus = 0, per_cu = 0;
        hipGetDevice(&dev); hipDeviceGetAttribute(&cus, hipDeviceAttributeMultiprocessorCount, dev);
        hipFuncSetAttribute((const void*)fwd_mega, hipFuncAttributeMaxDynamicSharedMemorySize, LDS_BYTES);
        hipOccupancyMaxActiveBlocksPerMultiprocessor(&per_cu, (const void*)fwd_mega, 512, LDS_BYTES);
        if (per_cu < 1) { fprintf(stderr, "kernel_launch: occupancy query says %d blocks per CU\n", per_cu); per_cu = 1; }
        (void)hipGetLastError();
        grid = cus * per_cu;
    }
    if (grid < 0) return;
    Params p{};
    for (int i = 0; i < 19; ++i) p.in[i] = (const float*)d_in[i];
    p.out = (float*)d_out; p.ws = (unsigned char*)d_ws;
    (void)hipMemsetAsync((unsigned char*)d_ws + RBAR, 0, 3456 * 4, stream);
#if MULTI_LAUNCH
    for (int ph = 0; ph < N_PHASES; ++ph) { p.ph_lo = ph; p.ph_hi = ph + 1; hipLaunchKernelGGL(fwd_mega, dim3(grid), dim3(512), LDS_BYTES, stream, p); }
#else
    p.ph_lo = 0; p.ph_hi = N_PHASES;
    void* args[] = {&p};
    hipError_t e = hipLaunchCooperativeKernel((const void*)fwd_mega, dim3(grid), dim3(512), args, LDS_BYTES, stream);
    if (e != hipSuccess) fprintf(stderr, "cooperative launch failed: %s (grid %d)\n", hipGetErrorString(e), grid);
#endif
}
```

```cpp
#include <hip/hip_runtime.h>
#include <hip/hip_cooperative_groups.h>
#include <cstdio>
namespace cg = cooperative_groups;

#define LAS __attribute__((address_space(3)))
typedef unsigned short u16;
typedef short bf16x8 __attribute__((ext_vector_type(8)));
typedef float f32x4 __attribute__((ext_vector_type(4)));
typedef unsigned u32x4 __attribute__((ext_vector_type(4)));
typedef unsigned u32x2 __attribute__((ext_vector_type(2)));
typedef _Float16 h16x2 __attribute__((ext_vector_type(2)));

#ifndef PHM
#define PHM 0xffff
#endif
#ifndef DUP
#define DUP 0x0
#endif
#define REP(bit) for (int rep_ = 0; rep_ <= ((DUP >> (bit)) & 1); ++rep_)
#ifndef TPM
#define TPM 0
#endif
#define TMULT 4
#ifndef SPLITK
#define SPLITK 1
#endif
#ifndef USE_SP2
#define USE_SP2 1
#endif
#ifndef USE_ALIGN
#define USE_ALIGN 1
#endif
#ifndef MULTI_LAUNCH
#define MULTI_LAUNCH 0
#endif

constexpr int MROWS = 33280, MP = 32768, DM = 1024, DFF = 2816, NGU = 5632, NIN = 6656, DEPTH = 4;
constexpr int NCH64 = MROWS / 64;
constexpr float EPS = 1e-6f;
constexpr size_t O_POOLP = 34078720, O_POOLS = 34140160, O_HGP = 34385920, O_HGS = 34910208, O_VS = 37007360;
constexpr size_t COLB = (size_t)MROWS * 512 * 2;
constexpr size_t RA = 0;
constexpr size_t RB = RA + (size_t)MROWS * 1024 * 2;
constexpr size_t RC = RB + 7 * COLB;
constexpr size_t RYP = RC + (size_t)MROWS * 1024 * 4;
constexpr size_t RWF = RC + (size_t)MROWS * 3072 * 2;
constexpr size_t RWF_DN = RWF + (size_t)NGU * 1024 * 2;
constexpr size_t RWM = RWF_DN + (size_t)1024 * DFF * 2;
constexpr size_t RWM_BR = RWM + (size_t)NIN * 1024 * 2;
constexpr size_t RWM_OUT = RWM_BR + (size_t)1024 * 1536 * 2;
constexpr size_t RWM_POOL = RWM_OUT + (size_t)1024 * 1024 * 2;
constexpr size_t RSM = RWM_POOL + (size_t)4 * 128 * 128 * 2;
constexpr size_t RBAR = RSM + (size_t)NCH64 * 4 * 128 * 4;
constexpr size_t RWF2 = RBAR + 3456 * 4 + 256;
constexpr size_t WS_END = RWF2 + (RWF_DN - RWF) + (size_t)1024 * DFF * 2;
constexpr int LDS_BYTES = 131072 + 2048;

struct Params { const float* in[19]; float* out; unsigned char* ws; int ph_lo, ph_hi; };
struct Ctx {
    LAS const unsigned* pl;
    __device__ __forceinline__ unsigned long long q(int k) const { const unsigned lo = __builtin_amdgcn_readfirstlane(pl[2 * k]), hi = __builtin_amdgcn_readfirstlane(pl[2 * k + 1]); return ((unsigned long long)hi << 32) | lo; }
    __device__ __forceinline__ const float* in(int k) const { return (const float*)(const __attribute__((address_space(1))) float*)q(k); }
    __device__ __forceinline__ float* out() const { return (float*)(__attribute__((address_space(1))) float*)q(19); }
    __device__ __forceinline__ unsigned char* ws() const { return (unsigned char*)(__attribute__((address_space(1))) unsigned char*)q(20); }
};

__device__ __forceinline__ float bf2f(unsigned b) { return __uint_as_float(b << 16); }
__device__ __forceinline__ float bflo(unsigned w) { return __uint_as_float(w << 16); }
__device__ __forceinline__ float bfhi(unsigned w) { return __uint_as_float(w & 0xffff0000u); }
__device__ __forceinline__ u16 f2bf(float f) { unsigned u = __float_as_uint(f); u += 0x7FFFu + ((u >> 16) & 1u); return (u16)(u >> 16); }
typedef __bf16 bf16x2_t __attribute__((ext_vector_type(2)));
typedef float f32x2_t __attribute__((ext_vector_type(2)));
__device__ __forceinline__ unsigned cvt_pk_bf16(float lo, float hi) { const f32x2_t v = {lo, hi}; const bf16x2_t r = __builtin_convertvector(v, bf16x2_t); return __builtin_bit_cast(unsigned, r); }
__device__ __forceinline__ float fsig(float x) { return __builtin_amdgcn_rcpf(1.0f + __expf(-x)); }
__device__ __forceinline__ float fsilu(float x) { return x * fsig(x); }
__device__ __forceinline__ float fgelu(float x) { return x * fsig(1.5957691216f * (x + 0.044715f * x * x * x)); }
__device__ __forceinline__ float wave_sum(float v) {
#pragma unroll
    for (int o = 32; o >= 1; o >>= 1) v += __shfl_xor(v, o);
    return v;
}

__device__ __forceinline__ int otid() { int t = threadIdx.x; asm volatile("" : "+v"(t)); return t; }
template <class T> __device__ __forceinline__ T osgpr(T x) { asm volatile("" : "+s"(x)); return x; }
__device__ __forceinline__ int obid() { return osgpr((int)blockIdx.x); }
__device__ __forceinline__ int ogdim() { return osgpr((int)gridDim.x); }

namespace pg8 {
constexpr int BM = 256, BK = 64, HALF = 128, HTB = HALF * BK * 2, STAGE_BYTES = 8 * HTB, NXCD = 8, WGM = 8;
__device__ __forceinline__ int lds_byte(int r, int c) { const int st = (r >> 4) * 2 + (c >> 5), rr = r & 15, cc = c & 31, ob = rr * 64 + cc * 2; return st * 1024 + (ob ^ (((ob >> 9) & 1) << 5)); }
__device__ __forceinline__ void stage_rc(int b, int& R, int& C) { const int st = b / 1024, sb = b % 1024, swz = sb ^ (((sb >> 9) & 1) << 5); R = (st >> 1) * 16 + swz / 64; C = (st & 1) * 32 + (swz % 64) / 2; }
__device__ __forceinline__ int perm32(int rho) { const int n = rho >> 4, i = rho & 15; return 8 * (i >> 2) + 4 * n + (i & 3); }

struct Unit { const char* a; const char* b; int pm, pn, aux, nt; };

struct TileOrder {
    int nM, nN, nwg, G, c;
    __device__ void init(int nM_, int nN_, int G_, int c_) { nM = nM_; nN = nN_; nwg = nM * nN; G = G_; c = c_; }
    __device__ bool tile(int i, int& pm, int& pn) const {
        const long L = (long)i * G + c; if (L >= nwg) return false;
        int wgid = (int)L; { const int q = nwg / NXCD, r = nwg % NXCD, xcd = wgid % NXCD, off = wgid / NXCD; wgid = (xcd < r ? xcd * (q + 1) : r * (q + 1) + (xcd - r) * q) + off; }
        const int nig = WGM * nN, gid = wgid / nig, fm = gid * WGM, gsz = (nM - fm) < WGM ? (nM - fm) : WGM;
        pm = fm + ((wgid % nig) % gsz); pn = (wgid % nig) / gsz; return true;
    }
};
struct SchedPlain {
    TileOrder o; const char* A; const char* B; size_t at, bt;
    int nt;
    int ns;
    int nseg;
    const char* Asplit;
    __device__ bool next(int i, Unit& u) const {
        int pm, pn;
        if (o.tile(i, pm, pn)) { u.a = A + (size_t)pm * at; u.b = B + (size_t)pn * bt; u.pm = pm; u.pn = pn; u.aux = 0; u.nt = nt; return true; }
        const int nfull = (o.nwg - o.c + o.G - 1) / o.G;
        if (i != nfull) return false;
        if (nseg) { if (o.c >= 24) return false;
            const int tile = o.c / 3, sg = o.c - tile * 3, pms = tile >> 2; pn = tile & 3;
            u.a = A + (sg == 0 ? (size_t)0 : (sg == 1 ? COLB : 3 * COLB)) + (size_t)(128 + pms) * at; u.b = B + (size_t)pn * bt + (size_t)sg * 1024; u.pm = pms; u.pn = pn; u.aux = sg + 1; u.nt = 8; return true; }
        if (ns == 0 || o.c >= 8 * ns) return false;
        const int tile = o.c / ns, j = o.c - tile * ns, pms = tile >> 2; pn = tile & 3;
        u.a = (Asplit ? Asplit + (size_t)o.c * (512 * 1024) : A + (size_t)(128 + pms) * at) + (size_t)j * 512; u.b = B + (size_t)pn * bt + (size_t)j * 512; u.pm = pms; u.pn = pn; u.aux = j + 1; u.nt = 4; return true;
    }
};

template <class Epi, class Sched>
__device__ __forceinline__ void gemm_phase(LAS unsigned char* lds, const int K, const int lda, const int ldb, const Sched& S, const Epi& E) {
    const int tid = otid(), wid = __builtin_amdgcn_readfirstlane(tid >> 6), lane = tid & 63, wr = wid >> 2, wc = wid & 3, fr = lane & 15, fq = lane >> 4;
    unsigned voffA[2], voffB[2];
#pragma unroll
    for (int i = 0; i < 2; ++i) { int R, C; stage_rc(tid * 16 + i * 8192, R, C); const int Rb = Epi::PERM ? ((R & ~31) + perm32(R & 31)) : R;
        voffA[i] = (unsigned)(R * lda + C) * 2u; voffB[i] = (unsigned)(Rb * ldb + C) * 2u; }
    const size_t kstep = (size_t)(BK * 2);
    const size_t hstepA = (size_t)HALF * lda * 2, hstepB = (size_t)HALF * ldb * 2;
    const unsigned ldsw = (unsigned)wid * 1024u;
    const int aoff = lds_byte(wr * 64 + fr, fq * 8), boff = lds_byte(wc * 32 + fr, fq * 8);
#define PG8_SA(b, h) (((b) * 2 + (h)) * HTB)
#define PG8_SB(b, h) ((4 + (b) * 2 + (h)) * HTB)
#define PG8_STAGE(bufoff, gbase, voff) do { _Pragma("unroll") for (int _i = 0; _i < 2; ++_i) \
        __builtin_amdgcn_global_load_lds((const unsigned*)((const char*)(gbase) + (voff)[_i]), (LAS unsigned*)(lds + (bufoff) + ldsw + _i * 8192), 16, 0, 0); } while (0)
#define PG8_LDA(dst, b, h) do { _Pragma("unroll") for (int m = 0; m < 4; ++m) _Pragma("unroll") for (int k = 0; k < 2; ++k) dst[m][k] = *(const LAS bf16x8*)(lds + PG8_SA(b, h) + aoff + m * 2048 + k * 1024); } while (0)
#define PG8_LDB(dst, b, h) do { _Pragma("unroll") for (int n = 0; n < 2; ++n) _Pragma("unroll") for (int k = 0; k < 2; ++k) dst[n][k] = *(const LAS bf16x8*)(lds + PG8_SB(b, h) + boff + n * 2048 + k * 1024); } while (0)
#define PG8_MMA(ai, bj, At, Bt) do { __builtin_amdgcn_s_setprio(1); _Pragma("unroll") for (int m = 0; m < 4; ++m) _Pragma("unroll") for (int n = 0; n < 2; ++n) _Pragma("unroll") for (int k = 0; k < 2; ++k) \
        acc[ai][bj][m][n] = __builtin_amdgcn_mfma_f32_16x16x32_bf16(Bt[n][k], At[m][k], acc[ai][bj][m][n], 0, 0, 0); __builtin_amdgcn_s_setprio(0); } while (0)
#define PG8_WAIT_V(n) asm volatile("s_waitcnt vmcnt(" #n ")" ::: "memory")
#define PG8_WAIT_L(n) asm volatile("s_waitcnt lgkmcnt(" #n ")" ::: "memory")
#define PG8_BAR __builtin_amdgcn_s_barrier()
#define PG8_SCHED __builtin_amdgcn_sched_barrier(0)
    Unit cur, nxt; int ui = 0;
    if (!S.next(0, cur)) return;
    f32x4 acc[2][2][4][2];
#pragma unroll
    for (int a = 0; a < 2; ++a)
#pragma unroll
        for (int b = 0; b < 2; ++b)
#pragma unroll
            for (int m = 0; m < 4; ++m)
#pragma unroll
                for (int n = 0; n < 2; ++n) acc[a][b][m][n] = (f32x4){0.f, 0.f, 0.f, 0.f};
    bf16x8 At[4][2], B0[2][2], B1[2][2];
    const char* cA = cur.a; const char* cB = cur.b;
    if constexpr (USE_SP2) {
        PG8_STAGE(PG8_SB(0, 0), cB, voffB); PG8_STAGE(PG8_SB(0, 1), cB + hstepB, voffB); PG8_STAGE(PG8_SA(0, 0), cA, voffA); PG8_STAGE(PG8_SA(0, 1), cA + hstepA, voffA);
        if (wr == 1) PG8_BAR;
        PG8_WAIT_V(2); PG8_BAR;
        PG8_STAGE(PG8_SB(1, 0), cB + kstep, voffB); PG8_STAGE(PG8_SA(1, 0), cA + kstep, voffA); PG8_STAGE(PG8_SB(1, 1), cB + hstepB + kstep, voffB);
        PG8_WAIT_V(6); PG8_BAR;
    } else {
    PG8_STAGE(PG8_SB(0, 0), cB, voffB); PG8_STAGE(PG8_SA(0, 0), cA, voffA); PG8_STAGE(PG8_SB(0, 1), cB + hstepB, voffB); PG8_STAGE(PG8_SA(0, 1), cA + hstepA, voffA);
    if (wr == 1) PG8_BAR;
    PG8_WAIT_V(4); PG8_BAR;
    PG8_STAGE(PG8_SB(1, 0), cB + kstep, voffB); PG8_STAGE(PG8_SA(1, 0), cA + kstep, voffA); PG8_STAGE(PG8_SB(1, 1), cB + hstepB + kstep, voffB);
    PG8_WAIT_V(6); PG8_BAR;
    }
    for (;;) {
        const bool has_next = S.next(ui + 1, nxt);
        const char* nA = has_next ? nxt.a : cA; const char* nB = has_next ? nxt.b : cB;
        const int nt = cur.nt;
        for (int t = 0; t < nt; t += 2) {
            const bool last = (t == nt - 2);
            if constexpr (Epi::SEG) { if (t == 8 || t == 16) E.rescale(acc, cur, t >> 3, wr, wc, fr, fq); }
            const char* a1 = cA + (size_t)(t + 1) * kstep + (Epi::SEG ? Epi::segoff(t >> 3) : (size_t)0);
            const char* a2 = last ? nA : cA + (size_t)(t + 2) * kstep + (Epi::SEG ? Epi::segoff((t + 2) >> 3) : (size_t)0); const char* b2 = last ? nB : cB + (size_t)(t + 2) * kstep;
            const char* a3 = a2 + kstep; const char* b3 = b2 + kstep;
            if constexpr (USE_SP2) {
            PG8_LDB(B0, 0, 0); PG8_LDB(B1, 0, 1); PG8_SCHED; PG8_LDA(At, 0, 0); PG8_STAGE(PG8_SA(1, 1), a1 + hstepA, voffA);
            PG8_WAIT_V(8); PG8_WAIT_L(0); PG8_BAR; PG8_MMA(0, 0, At, B0); PG8_MMA(0, 1, At, B1); PG8_BAR; PG8_SCHED;
            PG8_LDA(At, 0, 1); PG8_STAGE(PG8_SB(0, 0), b2, voffB); PG8_STAGE(PG8_SB(0, 1), b2 + hstepB, voffB); PG8_STAGE(PG8_SA(0, 0), a2, voffA);
            PG8_WAIT_V(8); PG8_WAIT_L(0); PG8_BAR; PG8_MMA(1, 0, At, B0); PG8_MMA(1, 1, At, B1); PG8_BAR; PG8_SCHED;
            PG8_LDB(B0, 1, 0); PG8_LDB(B1, 1, 1); PG8_SCHED; PG8_LDA(At, 1, 0); PG8_STAGE(PG8_SA(0, 1), a2 + hstepA, voffA);
            PG8_WAIT_V(8); PG8_WAIT_L(0); PG8_BAR; PG8_MMA(0, 0, At, B0); PG8_MMA(0, 1, At, B1); PG8_BAR; PG8_SCHED;
            PG8_LDA(At, 1, 1); PG8_STAGE(PG8_SB(1, 0), b3, voffB); PG8_STAGE(PG8_SB(1, 1), b3 + hstepB, voffB); PG8_STAGE(PG8_SA(1, 0), a3, voffA);
            PG8_WAIT_V(8); PG8_WAIT_L(0); PG8_BAR; PG8_MMA(1, 0, At, B0); PG8_MMA(1, 1, At, B1); PG8_BAR; PG8_SCHED;
            } else {
            PG8_LDB(B0, 0, 0); PG8_SCHED; PG8_LDA(At, 0, 0); PG8_STAGE(PG8_SA(1, 1), a1 + hstepA, voffA);
            PG8_WAIT_L(8); PG8_BAR; PG8_WAIT_L(0); PG8_MMA(0, 0, At, B0); PG8_BAR; PG8_SCHED;
            PG8_LDB(B1, 0, 1); PG8_STAGE(PG8_SB(0, 0), b2, voffB);
            PG8_BAR; PG8_WAIT_L(0); PG8_MMA(0, 1, At, B1); PG8_BAR;
            PG8_LDA(At, 0, 1); PG8_STAGE(PG8_SA(0, 0), a2, voffA);
            PG8_BAR; PG8_WAIT_L(0); PG8_MMA(1, 0, At, B0); PG8_BAR; PG8_SCHED;
            PG8_STAGE(PG8_SB(0, 1), b2 + hstepB, voffB);
            PG8_WAIT_V(6); PG8_BAR; PG8_MMA(1, 1, At, B1); PG8_BAR;
            PG8_LDB(B0, 1, 0); PG8_SCHED; PG8_LDA(At, 1, 0); PG8_STAGE(PG8_SA(0, 1), a2 + hstepA, voffA);
            PG8_WAIT_L(8); PG8_BAR; PG8_WAIT_L(0); PG8_MMA(0, 0, At, B0); PG8_BAR; PG8_SCHED;
            PG8_LDB(B1, 1, 1); PG8_STAGE(PG8_SB(1, 0), b3, voffB);
            PG8_BAR; PG8_WAIT_L(0); PG8_MMA(0, 1, At, B1); PG8_BAR;
            PG8_LDA(At, 1, 1); PG8_STAGE(PG8_SA(1, 0), a3, voffA);
            PG8_BAR; PG8_WAIT_L(0); PG8_MMA(1, 0, At, B0); PG8_BAR; PG8_SCHED;
            PG8_STAGE(PG8_SB(1, 1), b3 + hstepB, voffB);
            PG8_WAIT_V(6); PG8_BAR; PG8_MMA(1, 1, At, B1); PG8_BAR;
            }
        }
        if constexpr (USE_ALIGN) { if (wr == 0) PG8_BAR; }
        E(acc, cur, wr, wc, fr, fq);
        if (!has_next) break;
#pragma unroll
        for (int a = 0; a < 2; ++a)
#pragma unroll
            for (int b = 0; b < 2; ++b)
#pragma unroll
                for (int m = 0; m < 4; ++m)
#pragma unroll
                    for (int n = 0; n < 2; ++n) acc[a][b][m][n] = (f32x4){0.f, 0.f, 0.f, 0.f};
        cur = nxt; cA = nA; cB = nB; ++ui;
        if constexpr (USE_ALIGN) { if (wr == 1) PG8_BAR; }
    }
    PG8_WAIT_V(0);
    if constexpr (!USE_ALIGN) { if (wr == 0) PG8_BAR; }
    PG8_BAR;
#undef PG8_SA
#undef PG8_SB
#undef PG8_STAGE
#undef PG8_LDA
#undef PG8_LDB
#undef PG8_MMA
#undef PG8_WAIT_V
#undef PG8_WAIT_L
#undef PG8_BAR
#undef PG8_SCHED
}

struct EpiF32 {
    static constexpr bool PERM = true;
    static constexpr bool SEG = false; static __device__ __forceinline__ size_t segoff(int) { return 0; }
    u16* C; int ldc; float* P;
    __device__ __forceinline__ void operator()(const f32x4 (&acc)[2][2][4][2], const Unit& u, int wr, int wc, int fr, int fq) const {
        const int row0 = u.pm * BM + wr * 64 + fr, col0 = u.pn * BM + wc * 32 + 8 * fq;
        if (u.aux == 0) {
            const unsigned o0 = (unsigned)(row0 * ldc + col0) * 2u;
#pragma unroll
            for (int ai = 0; ai < 2; ++ai)
#pragma unroll
                for (int m = 0; m < 4; ++m) { const unsigned ro = o0 + (unsigned)((ai * HALF + m * 16) * ldc) * 2u;
#pragma unroll
                    for (int bj = 0; bj < 2; ++bj) { const f32x4 v0 = acc[ai][bj][m][0], v1 = acc[ai][bj][m][1]; u32x4 w;
                        w.x = cvt_pk_bf16(v0[0], v0[1]); w.y = cvt_pk_bf16(v0[2], v0[3]); w.z = cvt_pk_bf16(v1[0], v1[1]); w.w = cvt_pk_bf16(v1[2], v1[3]);
                        *(u32x4*)((char*)C + (ro + (unsigned)(bj * HALF) * 2u)) = w; } }
        } else {
            char* Cb = (char*)(P + (size_t)(u.aux - 1) * ((size_t)512 * 1024)); const unsigned o0 = (unsigned)(row0 * ldc + col0) * 4u;
#pragma unroll
            for (int ai = 0; ai < 2; ++ai)
#pragma unroll
                for (int m = 0; m < 4; ++m) { const unsigned ro = o0 + (unsigned)((ai * HALF + m * 16) * ldc) * 4u;
#pragma unroll
                    for (int bj = 0; bj < 2; ++bj)
#pragma unroll
                        for (int n = 0; n < 2; ++n) *(f32x4*)(Cb + (ro + (unsigned)(bj * HALF + n * 4) * 4u)) = acc[ai][bj][m][n]; }
        }
    }
};
struct EpiGU {
    static constexpr bool SEG = false; static __device__ __forceinline__ size_t segoff(int) { return 0; }
    static constexpr bool PERM = true;
    u16* H;
    __device__ __forceinline__ void operator()(const f32x4 (&acc)[2][2][4][2], const Unit& u, int wr, int wc, int fr, int fq) const {
        const int row0 = u.pm * BM + wr * 64 + fr, col0 = u.pn * 128 + wc * 32 + 8 * fq;
#pragma unroll
        for (int ai = 0; ai < 2; ++ai)
#pragma unroll
            for (int m = 0; m < 4; ++m) { u16* rowp = (u16*)((char*)H + (unsigned)((row0 + ai * HALF + m * 16) * DFF + col0) * 2u);
                const f32x4 g0 = acc[ai][0][m][0], g1 = acc[ai][0][m][1], u0 = acc[ai][1][m][0], u1 = acc[ai][1][m][1];
                u32x4 w; w.x = cvt_pk_bf16(fsilu(g0[0]) * u0[0], fsilu(g0[1]) * u0[1]); w.y = cvt_pk_bf16(fsilu(g0[2]) * u0[2], fsilu(g0[3]) * u0[3]);
                w.z = cvt_pk_bf16(fsilu(g1[0]) * u1[0], fsilu(g1[1]) * u1[1]); w.w = cvt_pk_bf16(fsilu(g1[2]) * u1[2], fsilu(g1[3]) * u1[3]);
                *(u32x4*)rowp = w; }
    }
};
struct EpiIN {
    static constexpr bool PERM = true;
    static constexpr bool SEG = false; static __device__ __forceinline__ size_t segoff(int) { return 0; }
    u16* cols; u16* G;
    static __device__ __forceinline__ float act(float x, float k1, float k3, float px, float p1) {
        const float e = __builtin_amdgcn_exp2f(x * (k3 * (x * x) + k1));
        return (px * x + p1) * __builtin_amdgcn_rcpf(1.0f + e);
    }
    __device__ __forceinline__ void operator()(const f32x4 (&acc)[2][2][4][2], const Unit& u, int wr, int wc, int fr, int fq) const {
        const int pn = u.pn; const int mode = pn < 14 ? (pn >> 1) : 7;
        u16* base = pn < 14 ? cols + (size_t)(pn >> 1) * ((size_t)MROWS * 512) : G;
        const int ldc = pn < 14 ? 512 : 3072; const int colt = pn < 14 ? (pn & 1) * 256 : (pn - 14) * 256;
        const int row0 = u.pm * BM + wr * 64 + fr, col0 = colt + wc * 32 + 8 * fq;
        const bool isg = mode <= 1, ident = (mode == 2 || mode == 4 || mode == 5);
        const float L2E = 1.4426950408889634f;
        const float k1 = ident ? 0.f : (isg ? -1.5957691216f * L2E : -L2E), k3 = isg ? -1.5957691216f * 0.044715f * L2E : 0.f;
        const float px = ident ? 2.0f : (mode == 3 ? 0.08838834764831845f : (mode == 7 ? 0.f : 1.0f)), p1 = mode == 7 ? 1.0f : 0.f;
#pragma unroll
        for (int ai = 0; ai < 2; ++ai)
#pragma unroll
            for (int m = 0; m < 4; ++m) { u16* rowp = (u16*)((char*)base + (unsigned)((row0 + ai * HALF + m * 16) * ldc + col0) * 2u);
#pragma unroll
                for (int bj = 0; bj < 2; ++bj) { const f32x4 v0 = acc[ai][bj][m][0], v1 = acc[ai][bj][m][1]; u32x4 w;
                    if (mode == 4) {
                        w.x = __builtin_bit_cast(unsigned, (h16x2){(_Float16)v0[0], (_Float16)v0[1]}); w.y = __builtin_bit_cast(unsigned, (h16x2){(_Float16)v0[2], (_Float16)v0[3]});
                        w.z = __builtin_bit_cast(unsigned, (h16x2){(_Float16)v1[0], (_Float16)v1[1]}); w.w = __builtin_bit_cast(unsigned, (h16x2){(_Float16)v1[2], (_Float16)v1[3]});
                    } else {
                        w.x = cvt_pk_bf16(act(v0[0], k1, k3, px, p1), act(v0[1], k1, k3, px, p1)); w.y = cvt_pk_bf16(act(v0[2], k1, k3, px, p1), act(v0[3], k1, k3, px, p1));
                        w.z = cvt_pk_bf16(act(v1[0], k1, k3, px, p1), act(v1[1], k1, k3, px, p1)); w.w = cvt_pk_bf16(act(v1[2], k1, k3, px, p1), act(v1[3], k1, k3, px, p1));
                    }
                    *(u32x4*)(rowp + bj * HALF) = w; } }
    }
};
struct EpiBranch {
    static constexpr bool PERM = true, SEG = true;
    const u16* G; u16* O; float* P;
    static __device__ __forceinline__ size_t segoff(int sgi) { return sgi == 0 ? (size_t)0 : (sgi == 1 ? COLB - 1024 : 3 * COLB - 2048); }
    __device__ __forceinline__ void rescale(f32x4 (&acc)[2][2][4][2], const Unit& u, int j, int wr, int wc, int fr, int fq) const {
        const int row0 = u.pm * BM + wr * 64 + fr, col0 = u.pn * BM + wc * 32 + 8 * fq;
        const char* Gb = (const char*)G; const unsigned goff = (unsigned)((row0 * 3072 + (j - 1) * 1024 + col0) * 2);
#pragma unroll
        for (int am = 0; am < 4; ++am) { const int ai = am >> 1, m0 = (am & 1) * 2;
            u32x4 na[2][2], nb[2][2];
#pragma unroll
            for (int m = 0; m < 2; ++m)
#pragma unroll
                for (int bj = 0; bj < 2; ++bj) { const unsigned go = goff + (unsigned)(((ai * HALF + (m0 + m) * 16) * 3072 + bj * HALF) * 2);
                    na[m][bj] = *(const u32x4*)(Gb + go); nb[m][bj] = *(const u32x4*)(Gb + go + 2048u); }
#pragma unroll
            for (int m = 0; m < 2; ++m)
#pragma unroll
                for (int bj = 0; bj < 2; ++bj) { const u32x4 a = na[m][bj], b = nb[m][bj]; f32x4& v0 = acc[ai][bj][m0 + m][0]; f32x4& v1 = acc[ai][bj][m0 + m][1];
                    v0[0] *= bflo(a.x) * __builtin_amdgcn_rcpf(bflo(b.x)); v0[1] *= bfhi(a.x) * __builtin_amdgcn_rcpf(bfhi(b.x));
                    v0[2] *= bflo(a.y) * __builtin_amdgcn_rcpf(bflo(b.y)); v0[3] *= bfhi(a.y) * __builtin_amdgcn_rcpf(bfhi(b.y));
                    v1[0] *= bflo(a.z) * __builtin_amdgcn_rcpf(bflo(b.z)); v1[1] *= bfhi(a.z) * __builtin_amdgcn_rcpf(bfhi(b.z));
                    v1[2] *= bflo(a.w) * __builtin_amdgcn_rcpf(bflo(b.w)); v1[3] *= bfhi(a.w) * __builtin_amdgcn_rcpf(bfhi(b.w)); }
            asm volatile("" ::: "memory");
        }
    }
    __device__ __forceinline__ void operator()(const f32x4 (&acc)[2][2][4][2], const Unit& u, int wr, int wc, int fr, int fq) const {
        if (u.aux > 0) {
            const int sg = u.aux - 1; const int rrel = u.pm * BM + wr * 64 + fr, col0 = u.pn * BM + wc * 32 + 8 * fq;
            const unsigned g0 = (unsigned)(((MP + rrel) * 3072 + sg * 1024 + col0) * 2), p0 = (unsigned)((sg * 512 * 1024 + rrel * 1024 + col0) * 4);
#pragma unroll
            for (int ai = 0; ai < 2; ++ai) {
                u32x4 gw[4][2];
#pragma unroll
                for (int m = 0; m < 4; ++m)
#pragma unroll
                    for (int bj = 0; bj < 2; ++bj) gw[m][bj] = *(const u32x4*)((const char*)G + (g0 + (unsigned)(((ai * HALF + m * 16) * 3072 + bj * HALF) * 2)));
#pragma unroll
                for (int m = 0; m < 4; ++m)
#pragma unroll
                    for (int bj = 0; bj < 2; ++bj) { const u32x4 g = gw[m][bj]; const f32x4 v0 = acc[ai][bj][m][0], v1 = acc[ai][bj][m][1];
                        char* pp = (char*)P + (p0 + (unsigned)(((ai * HALF + m * 16) * 1024 + bj * HALF) * 4));
                        *(f32x4*)pp = (f32x4){v0[0] * bflo(g.x), v0[1] * bfhi(g.x), v0[2] * bflo(g.y), v0[3] * bfhi(g.y)};
                        *(f32x4*)(pp + 16) = (f32x4){v1[0] * bflo(g.z), v1[1] * bfhi(g.z), v1[2] * bflo(g.w), v1[3] * bfhi(g.w)}; }
            }
            return;
        }
        const int row0 = u.pm * BM + wr * 64 + fr, col0 = u.pn * BM + wc * 32 + 8 * fq;
#pragma unroll
        for (int ai = 0; ai < 2; ++ai) {
            u32x4 gw[4][2];
#pragma unroll
            for (int m = 0; m < 4; ++m)
#pragma unroll
                for (int bj = 0; bj < 2; ++bj) gw[m][bj] = *(const u32x4*)((const char*)G + (unsigned)((row0 + ai * HALF + m * 16) * 3072 + 2048 + col0 + bj * HALF) * 2u);
#pragma unroll
            for (int m = 0; m < 4; ++m)
#pragma unroll
                for (int bj = 0; bj < 2; ++bj) { const u32x4 g = gw[m][bj]; const f32x4 v0 = acc[ai][bj][m][0], v1 = acc[ai][bj][m][1]; u32x4 w;
                    w.x = cvt_pk_bf16(v0[0] * bflo(g.x), v0[1] * bfhi(g.x)); w.y = cvt_pk_bf16(v0[2] * bflo(g.y), v0[3] * bfhi(g.y));
                    w.z = cvt_pk_bf16(v1[0] * bflo(g.z), v1[1] * bfhi(g.z)); w.w = cvt_pk_bf16(v1[2] * bflo(g.w), v1[3] * bfhi(g.w));
                    *(u32x4*)((char*)O + (unsigned)((row0 + ai * HALF + m * 16) * 1024 + col0 + bj * HALF) * 2u) = w; }
        }
    }
};
}

__device__ __forceinline__ void rn_load(const Ctx p, bool first, int row, int lane, int ns, float4 (&x)[4], float4 (&y)[4]) {
    const float* src = first ? (row < MP ? p.in(0) + (size_t)row * DM : p.in(1) + (size_t)(row - MP) * DM) : p.out() + (size_t)row * DM;
#pragma unroll
    for (int j = 0; j < 4; ++j) x[j] = *(const float4*)(src + lane * 4 + 256 * j);
    if (!first) {
#pragma unroll
        for (int j = 0; j < 4; ++j) {
            if (row < MP) { const u32x2 yw = *(const u32x2*)((const u16*)(p.ws() + RC) + (size_t)row * DM + lane * 4 + 256 * j); y[j].x = bflo(yw.x); y[j].y = bfhi(yw.x); y[j].z = bflo(yw.y); y[j].w = bfhi(yw.y); }
            else { const float* yp = (const float*)(p.ws() + RYP) + (size_t)(row - MP) * DM + lane * 4 + 256 * j; y[j] = *(const float4*)yp;
                for (int q = 1; q < ns; ++q) { const float4 t = *(const float4*)(yp + (size_t)q * 512 * 1024); y[j].x += t.x; y[j].y += t.y; y[j].z += t.z; y[j].w += t.w; } } }
    }
}
__device__ __forceinline__ void rownorm_phase(const Ctx p, bool first, float coef, const float* gpost, const float* gpre, bool write_xn, int ns) {
    float* X = p.out(); u16* XN = (u16*)(p.ws() + RA);
    const int tid_ = otid(); const int lane = tid_ & 63, wid = tid_ >> 6;
    float4 gp[4], gq[4];
#pragma unroll
    for (int j = 0; j < 4; ++j) { gq[j] = *(const float4*)(gpre + lane * 4 + 256 * j); gp[j] = first ? gq[j] : *(const float4*)(gpost + lane * 4 + 256 * j); }
    const int stride = ogdim() * 8;
    int row = obid() * 8 + wid;
    float4 x[4], y[4];
    if (row < MROWS) rn_load(p, first, row, lane, ns, x, y);
    for (; row < MROWS; row += stride) {
        float4 xn[4], yn[4];
        if (row + stride < MROWS) rn_load(p, first, row + stride, lane, ns, xn, yn);
        if (!first) {
            float ss = 0.f;
#pragma unroll
            for (int j = 0; j < 4; ++j) ss += y[j].x * y[j].x + y[j].y * y[j].y + y[j].z * y[j].z + y[j].w * y[j].w;
            ss = wave_sum(ss);
            const float r = coef * rsqrtf(ss * (1.0f / DM) + EPS);
#pragma unroll
            for (int j = 0; j < 4; ++j) { x[j].x += r * y[j].x * gp[j].x; x[j].y += r * y[j].y * gp[j].y; x[j].z += r * y[j].z * gp[j].z; x[j].w += r * y[j].w * gp[j].w; }
        }
#pragma unroll
        for (int j = 0; j < 4; ++j) *(float4*)(X + (size_t)row * DM + lane * 4 + 256 * j) = x[j];
        if (write_xn) {
            float ss = 0.f;
#pragma unroll
            for (int j = 0; j < 4; ++j) ss += x[j].x * x[j].x + x[j].y * x[j].y + x[j].z * x[j].z + x[j].w * x[j].w;
            ss = wave_sum(ss);
            const float r = rsqrtf(ss * (1.0f / DM) + EPS);
#pragma unroll
            for (int j = 0; j < 4; ++j) { u32x2 w; w.x = cvt_pk_bf16(x[j].x * r * gq[j].x, x[j].y * r * gq[j].y); w.y = cvt_pk_bf16(x[j].z * r * gq[j].z, x[j].w * r * gq[j].w);
                *(u32x2*)(XN + (size_t)row * DM + lane * 4 + 256 * j) = w; }
        }
#pragma unroll
        for (int j = 0; j < 4; ++j) { x[j] = xn[j]; y[j] = yn[j]; }
    }
}

#define MFMA16(a, b, c) __builtin_amdgcn_mfma_f32_16x16x32_bf16((a), (b), (c), 0, 0, 0)
__device__ __forceinline__ bf16x8 ldsfrag(const LAS u16* base, int row, int ld, int k) { return *(const LAS bf16x8*)(base + row * ld + k); }

__device__ __forceinline__ void convert_mat(LAS unsigned char* lds, int rank, int nwork, const float* src, int ld, u16* dst, int K, int N, bool gu_map, int dld = 0) {
    if (dld == 0) dld = K;
    LAS float* tile = (LAS float*)lds;
    const int tid = otid(), nkt = K >> 6, ntiles = nkt * (N >> 6);
    const int kk = tid >> 4, c4 = (tid & 15) * 4, n = tid >> 3, ks = (tid & 7) * 8;
    float4 v0, v1;
    auto tile_src = [&](int t) -> const float* { const int kt = t % nkt, nd0 = (t / nkt) * 64; int sc0 = nd0;
        if (gu_map) { const int pb = nd0 >> 8, h = (nd0 >> 7) & 1, j = nd0 & 127; sc0 = h * DFF + 128 * pb + j; }
        return src + (size_t)(kt * 64 + kk) * ld + sc0 + c4; };
    int t = rank, it = 0;
    if (t < ntiles) { const float* sp = tile_src(t); v0 = *(const float4*)sp; v1 = *(const float4*)(sp + (size_t)32 * ld); }
    for (; t < ntiles; t += nwork, ++it) {
        LAS float* tb = tile + (it & 1) * 4160;
        { LAS float* tp = tb + kk * 65 + c4; tp[0] = v0.x; tp[1] = v0.y; tp[2] = v0.z; tp[3] = v0.w; tp += 32 * 65; tp[0] = v1.x; tp[1] = v1.y; tp[2] = v1.z; tp[3] = v1.w; }
        if (t + nwork < ntiles) { const float* sp = tile_src(t + nwork); v0 = *(const float4*)sp; v1 = *(const float4*)(sp + (size_t)32 * ld); }
        __syncthreads();
        const int kt = t % nkt, nd0 = (t / nkt) * 64;
        float e[8];
#pragma unroll
        for (int i = 0; i < 8; ++i) e[i] = tb[(ks + i) * 65 + n];
        u32x4 w; w.x = cvt_pk_bf16(e[0], e[1]); w.y = cvt_pk_bf16(e[2], e[3]); w.z = cvt_pk_bf16(e[4], e[5]); w.w = cvt_pk_bf16(e[6], e[7]);
        *(u32x4*)(dst + (size_t)(nd0 + n) * dld + kt * 64 + ks) = w;
    }
    __syncthreads();
}
__device__ __forceinline__ void convert_ffn(const Ctx p, LAS unsigned char* lds, int rank, int nwork, const float* wgu, const float* wdn, size_t dstoff) {
    convert_mat(lds, rank, nwork, wgu, NGU, (u16*)(p.ws() + dstoff), 1024, NGU, true);
    convert_mat(lds, rank, nwork, wdn, 1024, (u16*)(p.ws() + dstoff + (RWF_DN - RWF)), DFF, 1024, false);
}
__device__ __forceinline__ void fuse_pool_unit(const Ctx p, LAS unsigned char* lds, int l, int unit) {
    const int tid = otid(), wid = tid >> 6, lane = tid & 63, fr = lane & 15, fq = lane >> 4;
    const int g = unit >> 3, nb = unit & 7;
    LAS u16* Xt = (LAS u16*)lds; LAS u16* Yl = (LAS u16*)(lds + 34816);
    constexpr int LD = 136;
    const float* wb = p.in(15) + (size_t)l * 1536 * 1024 + (size_t)(512 + g * 128) * 1024 + nb * 128;
    const float* pw = p.in(11) + ((size_t)l * 4 + g) * 16384;
    const float* sc = p.in(12) + l * 512 + g * 128;
#pragma unroll
    for (int i = 0; i < 8; ++i) { const int e = tid + i * 512, d = e >> 5, n4 = (e & 31) * 4; const float4 v = *(const float4*)(wb + (size_t)d * 1024 + n4);
        Xt[(n4 + 0) * LD + d] = f2bf(v.x); Xt[(n4 + 1) * LD + d] = f2bf(v.y); Xt[(n4 + 2) * LD + d] = f2bf(v.z); Xt[(n4 + 3) * LD + d] = f2bf(v.w); }
#pragma unroll
    for (int i = 0; i < 8; ++i) { const int e = tid + i * 512, c = e >> 5, d4 = (e & 31) * 4; const float4 v = *(const float4*)(pw + c * 128 + d4); const float4 s4 = *(const float4*)(sc + d4);
        u32x2 w; w.x = cvt_pk_bf16(v.x * s4.x, v.y * s4.y); w.y = cvt_pk_bf16(v.z * s4.z, v.w * s4.w); *(LAS u32x2*)(Yl + c * LD + d4) = w; }
    __syncthreads();
    f32x4 acc[8];
#pragma unroll
    for (int n = 0; n < 8; ++n) acc[n] = (f32x4){0.f, 0.f, 0.f, 0.f};
#pragma unroll
    for (int ks = 0; ks < 4; ++ks) { const bf16x8 a = ldsfrag(Xt, wid * 16 + fr, LD, ks * 32 + fq * 8);
#pragma unroll
        for (int n = 0; n < 8; ++n) acc[n] = MFMA16(a, ldsfrag(Yl, n * 16 + fr, LD, ks * 32 + fq * 8), acc[n]); }
    u16* dst = (u16*)(p.ws() + RWM_BR);
#pragma unroll
    for (int j = 0; j < 4; ++j) { const int n = nb * 128 + wid * 16 + fq * 4 + j;
#pragma unroll
        for (int c8 = 0; c8 < 8; ++c8) dst[(size_t)n * 1536 + 512 + g * 128 + c8 * 16 + fr] = f2bf(acc[c8][j]); }
    __syncthreads();
}
__device__ __forceinline__ void convert_mix(const Ctx p, LAS unsigned char* lds, int rank, int nwork, int l) {
    convert_mat(lds, rank, nwork, p.in(7) + (size_t)l * 1024 * NIN, NIN, (u16*)(p.ws() + RWM), 1024, NIN, false);
    convert_mat(lds, rank, nwork, p.in(15) + (size_t)l * 1536 * 1024, 1024, (u16*)(p.ws() + RWM_BR), 512, 1024, false, 1536);
    convert_mat(lds, rank, nwork, p.in(15) + (size_t)l * 1536 * 1024 + (size_t)1024 * 1024, 1024, (u16*)(p.ws() + RWM_BR) + 1024, 512, 1024, false, 1536);
    convert_mat(lds, rank, nwork, p.in(16) + (size_t)l * 1024 * 1024, 1024, (u16*)(p.ws() + RWM_OUT), 1024, 1024, false);
    { const int c2 = nwork - 1 - rank; if (c2 < 32) fuse_pool_unit(p, lds, l, c2); }
}


__device__ __forceinline__ void gmlp_unit(const Ctx p, LAS unsigned char* lds, int l, int unit, int wrf = 1) {
    const int tid = otid(), wid = tid >> 6, lane = tid & 63, fr = lane & 15, fq = lane >> 4;
    int row0, L, h, bs = -1;
    if (unit < 1024) { row0 = (unit >> 2) * 128; h = unit & 3; L = 128; } else { const int s = unit - 1024; bs = s >> 2; h = s & 3; row0 = MP + bs * 64; L = 64; }
    u16* U = (u16*)(p.ws() + RB); const u16* V = (const u16*)(p.ws() + RB + COLB);
    LAS float* rs = (LAS float*)lds; LAS u16* Vt = (LAS u16*)(lds + 1024); LAS u16* Wl = (LAS u16*)(lds + 35840);
    constexpr int LD = 136;
    const int srow = tid >> 2, part = tid & 3;
    u32x4 sv[16];
    if (srow < L) {
#pragma unroll
        for (int i = 0; i < 16; ++i) sv[i] = *(const u32x4*)(V + (size_t)(row0 + srow) * 512 + part * 128 + i * 8);
    }
    const int vs = tid & 127, cg4 = tid >> 7;
    u32x4 hv[4]; float4 vgv[8];
    if (vs < L) {
#pragma unroll
        for (int i = 0; i < 4; ++i) hv[i] = *(const u32x4*)(V + (size_t)(row0 + vs) * 512 + h * 128 + cg4 * 32 + i * 8);
    }
    { const float* vg = p.in(8) + l * 512 + h * 128 + cg4 * 32;
#pragma unroll
        for (int i = 0; i < 8; ++i) vgv[i] = *(const float4*)(vg + i * 4); }
    const int wt = tid >> 2, sq = (tid & 3) * 32;
    float4 wv[8];
    if (wt < L) { const float* wp = p.in(9) + ((size_t)(l * 4 + h) * 128 + wt) * 128 + sq;
#pragma unroll
        for (int i = 0; i < 8; ++i) wv[i] = *(const float4*)(wp + i * 4); }
    {
        float ss = 0.f;
        if (srow < L) {
#pragma unroll
            for (int i = 0; i < 16; ++i) { const u32x4 w = sv[i];
                float a; a = bflo(w.x); ss += a * a; a = bfhi(w.x); ss += a * a; a = bflo(w.y); ss += a * a; a = bfhi(w.y); ss += a * a;
                a = bflo(w.z); ss += a * a; a = bfhi(w.z); ss += a * a; a = bflo(w.w); ss += a * a; a = bfhi(w.w); ss += a * a; }
        }
        ss += __shfl_xor(ss, 1); ss += __shfl_xor(ss, 2);
        if (part == 0 && srow < L) rs[srow] = rsqrtf(ss * (1.0f / 512.0f) + EPS);
    }
    {
        if (wt < L) {
#pragma unroll
            for (int i = 0; i < 4; ++i) { const float4 a = wv[2 * i], b = wv[2 * i + 1]; const int s0 = sq + i * 8, t = wt;
                u32x4 w; w.x = cvt_pk_bf16(s0 + 0 <= t ? a.x : 0.f, s0 + 1 <= t ? a.y : 0.f); w.y = cvt_pk_bf16(s0 + 2 <= t ? a.z : 0.f, s0 + 3 <= t ? a.w : 0.f);
                w.z = cvt_pk_bf16(s0 + 4 <= t ? b.x : 0.f, s0 + 5 <= t ? b.y : 0.f); w.w = cvt_pk_bf16(s0 + 6 <= t ? b.z : 0.f, s0 + 7 <= t ? b.w : 0.f);
                *(LAS u32x4*)(Wl + t * LD + s0) = w; } }
    }
    __syncthreads();
    {
        if (vs < L) {
            const float r = rs[vs];
            float* vout = bs >= 0 ? p.out() + O_VS + ((size_t)(l * 8 + bs) * 64 + vs) * 512 + h * 128 + cg4 * 32 : nullptr;
#pragma unroll
            for (int i = 0; i < 4; ++i) { const u32x4 w = hv[i];
                const float e[8] = {bflo(w.x), bfhi(w.x), bflo(w.y), bfhi(w.y), bflo(w.z), bfhi(w.z), bflo(w.w), bfhi(w.w)};
                const float gz[8] = {vgv[2 * i].x, vgv[2 * i].y, vgv[2 * i].z, vgv[2 * i].w, vgv[2 * i + 1].x, vgv[2 * i + 1].y, vgv[2 * i + 1].z, vgv[2 * i + 1].w};
                float vv[8];
#pragma unroll
                for (int j = 0; j < 8; ++j) { vv[j] = e[j] * r * gz[j]; Vt[(cg4 * 32 + i * 8 + j) * LD + vs] = f2bf(vv[j]); }
                if (vout) { *(float4*)(vout + i * 8) = (float4){vv[0], vv[1], vv[2], vv[3]}; *(float4*)(vout + i * 8 + 4) = (float4){vv[4], vv[5], vv[6], vv[7]}; } }
        }
    }
    __syncthreads();
    if (wid * 16 < L) {
        const float* bsp = p.in(10) + (l * 4 + h) * 128;
        u16 uv[4][8]; float bias[4];
#pragma unroll
        for (int j = 0; j < 4; ++j) { const int t = wid * 16 + fq * 4 + j; bias[j] = bsp[t];
#pragma unroll
            for (int n = 0; n < 8; ++n) uv[j][n] = U[(size_t)(row0 + t) * 512 + h * 128 + n * 16 + fr]; }
        f32x4 acc[8];
#pragma unroll
        for (int n = 0; n < 8; ++n) acc[n] = (f32x4){0.f, 0.f, 0.f, 0.f};
        const int kmax = (wid * 16 + 15) / 32 + 1;
        for (int ks = 0; ks < kmax; ++ks) { const bf16x8 a = ldsfrag(Wl, wid * 16 + fr, LD, ks * 32 + fq * 8);
#pragma unroll
            for (int n = 0; n < 8; ++n) acc[n] = MFMA16(a, ldsfrag(Vt, n * 16 + fr, LD, ks * 32 + fq * 8), acc[n]); }
#pragma unroll
        for (int j = 0; j < 4; ++j) { const int t = wid * 16 + fq * 4 + j;
#pragma unroll
            for (int n = 0; n < 8; ++n) { const u16 ov = f2bf(bf2f(uv[j][n]) * (acc[n][j] + bias[j])); if (wrf) U[(size_t)(row0 + t) * 512 + h * 128 + n * 16 + fr] = ov; } }
    }
    __syncthreads();
}

__device__ __forceinline__ float hgrn_lb(const float* lbp, int l, int c) {
    const float x0 = lbp[c], x1 = lbp[512 + c], x2 = lbp[1024 + c], x3 = lbp[1536 + c];
    const float m = fmaxf(fmaxf(x0, x1), fmaxf(x2, x3));
    const float e0 = __expf(x0 - m), e1 = __expf(x1 - m), e2 = __expf(x2 - m), e3 = __expf(x3 - m);
    float num = 0.f; if (l >= 1) num += e1; if (l >= 2) num += e2; if (l >= 3) num += e3;
    return num / (e0 + e1 + e2 + e3);
}
__device__ __forceinline__ int chunk_row0(int cq) { return cq < 512 ? cq * 64 : MP + (cq - 512) * 64; }

struct HaIn { u16 z[16]; u32x4 v[2]; float lbx[4]; };
__device__ __forceinline__ void ha_load(const Ctx p, int unit, HaIn& L) {
    const int tid = otid();
    const int cq = unit >> 2, h = unit & 3, row0 = chunk_row0(cq);
    const u16* F = (const u16*)(p.ws() + RB + 4 * COLB); const u16* I = (const u16*)(p.ws() + RB + 5 * COLB);
    const int k = tid & 127, seg = tid >> 7;
    { const float* lbp = p.in(13) + h * 128 + k; L.lbx[0] = lbp[0]; L.lbx[1] = lbp[512]; L.lbx[2] = lbp[1024]; L.lbx[3] = lbp[1536]; }
#pragma unroll
    for (int i = 0; i < 16; ++i) L.z[i] = F[(size_t)(row0 + seg * 16 + i) * 512 + h * 128 + k];
    { const int s = tid & 63, cg = tid >> 6;
#pragma unroll
        for (int i = 0; i < 2; ++i) L.v[i] = *(const u32x4*)(I + (size_t)(row0 + s) * 512 + h * 128 + cg * 16 + i * 8); }
}
__device__ __forceinline__ void hgrn_a_unit(const Ctx p, LAS unsigned char* lds, int l, int unit, int next_unit, HaIn& L) {
    const int tid = otid(), wid = tid >> 6, lane = tid & 63, fr = lane & 15, fq = lane >> 4;
    u16* St = (u16*)(p.ws() + RA) + (size_t)unit * 16384; float* dcy = (float*)(p.ws() + RSM) + (size_t)unit * 128;
    LAS float* segtot = (LAS float*)lds; LAS u16* Kt = (LAS u16*)(lds + 4096); LAS u16* Vt = (LAS u16*)(lds + 22528);
    constexpr int LD = 72;
    const int k = tid & 127, seg = tid >> 7;
    float lb;
    { const float x0 = L.lbx[0], x1 = L.lbx[1], x2 = L.lbx[2], x3 = L.lbx[3]; const float m = fmaxf(fmaxf(x0, x1), fmaxf(x2, x3));
      const float e0 = __expf(x0 - m), e1 = __expf(x1 - m), e2 = __expf(x2 - m), e3 = __expf(x3 - m);
      float num = 0.f; if (l >= 1) num += e1; if (l >= 2) num += e2; if (l >= 3) num += e3; lb = num / (e0 + e1 + e2 + e3); }
    float lf[16], kk[16]; float run = 0.f;
#pragma unroll
    for (int i = 0; i < 16; ++i) { const float z = (float)__builtin_bit_cast(_Float16, L.z[i]);
        const float sg = fsig(z); const float f = lb + (1.0f - lb) * sg; kk[i] = 1.0f - f; run += __logf(fmaxf(f, 1e-30f)); lf[i] = run; }
    segtot[seg * 128 + k] = run;
    { const int s = tid & 63, cg = tid >> 6;
#pragma unroll
        for (int i = 0; i < 2; ++i) { const u32x4 w = L.v[i]; LAS u16* vp = Vt + (cg * 16 + i * 8) * LD + s;
            vp[0] = (u16)(w.x & 0xffff); vp[LD] = (u16)(w.x >> 16); vp[2 * LD] = (u16)(w.y & 0xffff); vp[3 * LD] = (u16)(w.y >> 16);
            vp[4 * LD] = (u16)(w.z & 0xffff); vp[5 * LD] = (u16)(w.z >> 16); vp[6 * LD] = (u16)(w.w & 0xffff); vp[7 * LD] = (u16)(w.w >> 16); } }
    if (next_unit < 2080) ha_load(p, next_unit, L);
    __syncthreads();
    { const float t0 = segtot[k], t1 = segtot[128 + k], t2 = segtot[256 + k], t3 = segtot[384 + k];
        const float off = seg == 0 ? 0.f : (seg == 1 ? t0 : (seg == 2 ? t0 + t1 : t0 + t1 + t2)); const float blast = t0 + t1 + t2 + t3;
#pragma unroll
        for (int i = 0; i < 16; ++i) Kt[k * LD + seg * 16 + i] = f2bf(kk[i] * __expf(blast - (off + lf[i])));
        if (seg == 0) dcy[k] = __expf(blast); }
    __syncthreads();
    { f32x4 acc[8];
#pragma unroll
        for (int n = 0; n < 8; ++n) acc[n] = (f32x4){0.f, 0.f, 0.f, 0.f};
#pragma unroll
        for (int ks = 0; ks < 2; ++ks) { const bf16x8 a = ldsfrag(Kt, wid * 16 + fr, LD, ks * 32 + fq * 8);
#pragma unroll
            for (int n = 0; n < 8; ++n) acc[n] = MFMA16(a, ldsfrag(Vt, n * 16 + fr, LD, ks * 32 + fq * 8), acc[n]); }
#pragma unroll
        for (int n = 0; n < 8; ++n) { u32x2 w; w.x = cvt_pk_bf16(acc[n][0], acc[n][1]); w.y = cvt_pk_bf16(acc[n][2], acc[n][3]);
            *(u32x2*)(St + (size_t)(n * 16 + fr) * 128 + wid * 16 + fq * 4) = w; } }
    __syncthreads();
}

__device__ __forceinline__ void hgrn_scan_phase(const Ctx p, int l, int wrf = 1) {
    u16* SR = (u16*)(p.ws() + RA); const float* dcy = (const float*)(p.ws() + RSM);
    const int gtid = obid() * 512 + otid(), gsz = ogdim() * 512;
    for (int e = gtid; e < 8 * 16384; e += gsz) {
        const int seq = e >> 14, el = e & 16383, b = seq >> 2, h = seq & 3, k = el & 127, v = el >> 7;
        u16* sp = SR + ((size_t)(b * 256) * 4 + h) * 16384 + el; const float* dp = dcy + ((size_t)(b * 256) * 4 + h) * 128 + k;
        float st = 0.f;
        for (int n0 = 0; n0 < 256; n0 += 16) {
            float uu[16], dd[16];
#pragma unroll
            for (int j = 0; j < 16; ++j) { uu[j] = bf2f(sp[(size_t)(n0 + j) * 65536]); dd[j] = dp[(size_t)(n0 + j) * 512]; }
#pragma unroll
            for (int j = 0; j < 16; ++j) { if (wrf) sp[(size_t)(n0 + j) * 65536] = f2bf(st); st = dd[j] * st + uu[j]; }
        }
        if (wrf) p.out()[O_HGP + ((size_t)(l * 2 + b) * 4 + h) * 16384 + k * 128 + v] = st;
    }
    for (int e = gtid; e < 32 * 16384; e += gsz) {
        const int bh = e >> 14, el = e & 16383, k = el & 127, v = el >> 7;
        u16* sp = SR + ((size_t)(512 * 4) + bh) * 16384 + el;
        const float s0 = p.in(3)[((size_t)l * 32 + bh) * 16384 + k * 128 + v];
        const float uu = bf2f(*sp), dd = dcy[((size_t)(512 * 4) + bh) * 128 + k];
        if (wrf) *sp = f2bf(s0);
        if (wrf) p.out()[O_HGS + ((size_t)l * 32 + bh) * 16384 + k * 128 + v] = dd * s0 + uu;
    }
}

struct HcIn { u16 z[16]; u32x4 v[2], st[4]; float lbx[4]; };
__device__ __forceinline__ void hc_load(const Ctx p, int l, int unit, HcIn& L) {
    const int tid = otid();
    const int cq = unit >> 2, h = unit & 3, row0 = chunk_row0(cq);
    const u16* F = (const u16*)(p.ws() + RB + 4 * COLB); const u16* I = (const u16*)(p.ws() + RB + 5 * COLB);
    const u16* St = (const u16*)(p.ws() + RA) + (size_t)unit * 16384;
    const int k = tid & 127, seg = tid >> 7;
    { const float* lbp = p.in(13) + h * 128 + k; L.lbx[0] = lbp[0]; L.lbx[1] = lbp[512]; L.lbx[2] = lbp[1024]; L.lbx[3] = lbp[1536]; }
#pragma unroll
    for (int i = 0; i < 16; ++i) L.z[i] = F[(size_t)(row0 + seg * 16 + i) * 512 + h * 128 + k];
    { const int s = tid & 63, cg = tid >> 6;
#pragma unroll
        for (int i = 0; i < 2; ++i) L.v[i] = *(const u32x4*)(I + (size_t)(row0 + s) * 512 + h * 128 + cg * 16 + i * 8); }
#pragma unroll
    for (int i = 0; i < 4; ++i) { const int c = tid + i * 512, r = c >> 4, cc = (c & 15) * 8; L.st[i] = *(const u32x4*)(St + r * 128 + cc); }
}
__device__ __forceinline__ void hgrn_c_unit(const Ctx p, LAS unsigned char* lds, int l, int unit, int next_unit, HcIn& L, int wrf = 1) {
    const int tid = otid(), wid = tid >> 6, lane = tid & 63, fr = lane & 15, fq = lane >> 4;
    const int cq = unit >> 2, h = unit & 3, row0 = chunk_row0(cq);
    u16* Q = (u16*)(p.ws() + RB + 3 * COLB); const u16* GG = (const u16*)(p.ws() + RB + 6 * COLB);
    u16 qv[16], gg[4][4]; float ogv[4];
#pragma unroll
    for (int i = 0; i < 16; ++i) qv[i] = Q[(size_t)(row0 + (tid >> 7) * 16 + i) * 512 + h * 128 + (tid & 127)];
    { const int tt = wid & 3, nh = wid >> 2; const float* og = p.in(14) + l * 128;
#pragma unroll
        for (int n = 0; n < 4; ++n) { const int v = (nh * 4 + n) * 16 + fr; ogv[n] = og[v];
#pragma unroll
            for (int j = 0; j < 4; ++j) gg[j][n] = GG[(size_t)(row0 + tt * 16 + fq * 4 + j) * 512 + h * 128 + v]; } }
    LAS float* segtot = (LAS float*)lds; LAS float* red = (LAS float*)(lds + 2560);
    LAS u16* Qi = (LAS u16*)(lds + 4096); LAS u16* Qh = (LAS u16*)(lds + 21504); LAS u16* Kh = (LAS u16*)(lds + 38912);
    LAS u16* Vt = (LAS u16*)(lds + 56320); LAS u16* Sl = (LAS u16*)(lds + 74752); LAS u16* P = (LAS u16*)(lds + 109568);
    constexpr int LDK = 136, LDS_ = 72;
    const int k = tid & 127, seg = tid >> 7;
    float lb;
    { const float x0 = L.lbx[0], x1 = L.lbx[1], x2 = L.lbx[2], x3 = L.lbx[3]; const float m = fmaxf(fmaxf(x0, x1), fmaxf(x2, x3));
      const float e0 = __expf(x0 - m), e1 = __expf(x1 - m), e2 = __expf(x2 - m), e3 = __expf(x3 - m);
      float num = 0.f; if (l >= 1) num += e1; if (l >= 2) num += e2; if (l >= 3) num += e3; lb = num / (e0 + e1 + e2 + e3); }
    float lf[16], kk[16]; float run = 0.f;
#pragma unroll
    for (int i = 0; i < 16; ++i) { const float z = (float)__builtin_bit_cast(_Float16, L.z[i]);
        const float sg = fsig(z); const float f = lb + (1.0f - lb) * sg; kk[i] = 1.0f - f; run += __logf(fmaxf(f, 1e-30f)); lf[i] = run; }
    segtot[seg * 128 + k] = run;
    { const int s = tid & 63, cg = tid >> 6;
#pragma unroll
        for (int i = 0; i < 2; ++i) { const u32x4 w = L.v[i]; LAS u16* vp = Vt + (cg * 16 + i * 8) * LDS_ + s;
            vp[0] = (u16)(w.x & 0xffff); vp[LDS_] = (u16)(w.x >> 16); vp[2 * LDS_] = (u16)(w.y & 0xffff); vp[3 * LDS_] = (u16)(w.y >> 16);
            vp[4 * LDS_] = (u16)(w.z & 0xffff); vp[5 * LDS_] = (u16)(w.z >> 16); vp[6 * LDS_] = (u16)(w.w & 0xffff); vp[7 * LDS_] = (u16)(w.w >> 16); } }
#pragma unroll
    for (int i = 0; i < 4; ++i) { const int c = tid + i * 512, r = c >> 4, cc = (c & 15) * 8; *(LAS u32x4*)(Sl + r * LDK + cc) = L.st[i]; }
    if (next_unit < 2080) hc_load(p, l, next_unit, L);
    __syncthreads();
    { const float t0 = segtot[k], t1 = segtot[128 + k], t2 = segtot[256 + k];
        const float off = seg == 0 ? 0.f : (seg == 1 ? t0 : (seg == 2 ? t0 + t1 : t0 + t1 + t2)); const float bref = t0 + t1;
#pragma unroll
        for (int i = 0; i < 16; ++i) { const int s = seg * 16 + i; const float b = off + lf[i]; const float q = bf2f(qv[i]);
            Qi[s * LDK + k] = f2bf(q * __expf(b)); Qh[s * LDK + k] = f2bf(q * __expf(b - bref)); Kh[s * LDK + k] = f2bf(kk[i] * __expf(bref - b)); } }
    __syncthreads();
    {
        const int tt = wid >> 1;
#pragma unroll
        for (int q2 = 0; q2 < 2; ++q2) { const int stl = (wid & 1) * 2 + q2; f32x4 acc = (f32x4){0.f, 0.f, 0.f, 0.f};
            if (stl <= tt) {
#pragma unroll
                for (int ks = 0; ks < 4; ++ks) acc = MFMA16(ldsfrag(Qh, tt * 16 + fr, LDK, ks * 32 + fq * 8), ldsfrag(Kh, stl * 16 + fr, LDK, ks * 32 + fq * 8), acc); }
#pragma unroll
            for (int j = 0; j < 4; ++j) { const int t = tt * 16 + fq * 4 + j, s = stl * 16 + fr; P[t * LDS_ + s] = (stl <= tt && s <= t) ? f2bf(acc[j]) : (u16)0; } }
    }
    __syncthreads();
    { const int tt = wid & 3, nh = wid >> 2; f32x4 acc[4];
#pragma unroll
        for (int n = 0; n < 4; ++n) acc[n] = (f32x4){0.f, 0.f, 0.f, 0.f};
#pragma unroll
        for (int ks = 0; ks < 4; ++ks) { const bf16x8 a = ldsfrag(Qi, tt * 16 + fr, LDK, ks * 32 + fq * 8);
#pragma unroll
            for (int n = 0; n < 4; ++n) acc[n] = MFMA16(a, ldsfrag(Sl, (nh * 4 + n) * 16 + fr, LDK, ks * 32 + fq * 8), acc[n]); }
#pragma unroll
        for (int ks = 0; ks < 2; ++ks) { const bf16x8 a = ldsfrag(P, tt * 16 + fr, LDS_, ks * 32 + fq * 8);
#pragma unroll
            for (int n = 0; n < 4; ++n) acc[n] = MFMA16(a, ldsfrag(Vt, (nh * 4 + n) * 16 + fr, LDS_, ks * 32 + fq * 8), acc[n]); }
        float ssq[4];
#pragma unroll
        for (int j = 0; j < 4; ++j) { float s = 0.f;
#pragma unroll
            for (int n = 0; n < 4; ++n) s += acc[n][j] * acc[n][j];
            s += __shfl_xor(s, 1); s += __shfl_xor(s, 2); s += __shfl_xor(s, 4); s += __shfl_xor(s, 8); ssq[j] = s; }
        if (fr == 0) {
#pragma unroll
            for (int j = 0; j < 4; ++j) red[nh * 64 + tt * 16 + fq * 4 + j] = ssq[j]; }
        __syncthreads();
#pragma unroll
        for (int j = 0; j < 4; ++j) { const int t = tt * 16 + fq * 4 + j; const float r = rsqrtf((red[t] + red[64 + t]) * (1.0f / 128.0f) + EPS);
#pragma unroll
            for (int n = 0; n < 4; ++n) { const int v = (nh * 4 + n) * 16 + fr; const size_t idx = (size_t)(row0 + t) * 512 + h * 128 + v;
                const u16 ov = f2bf(acc[n][j] * r * ogv[n] * bf2f(gg[j][n])); if (wrf) Q[idx] = ov; } }
    }
    __syncthreads();
}

template <int W> __device__ __forceinline__ void pool_rows(const u32x4 (&x)[31], int t0q, int nvalid, u16* ob) {
    float s[8];
#pragma unroll
    for (int e = 0; e < 8; ++e) s[e] = 0.f;
#pragma unroll
    for (int j = 16 - W; j < 15; ++j) { const u32x4 v = x[j]; s[0] += bflo(v.x); s[1] += bfhi(v.x); s[2] += bflo(v.y); s[3] += bfhi(v.y); s[4] += bflo(v.z); s[5] += bfhi(v.z); s[6] += bflo(v.w); s[7] += bfhi(v.w); }
#pragma unroll
    for (int i = 0; i < 16; ++i) { const u32x4 v = x[15 + i]; const float xv[8] = {bflo(v.x), bfhi(v.x), bflo(v.y), bfhi(v.y), bflo(v.z), bfhi(v.z), bflo(v.w), bfhi(v.w)};
        const int avail = t0q + i + 1 + nvalid; const float rc = 1.0f / (float)(avail < W ? avail : W);
        float o[8];
#pragma unroll
        for (int e = 0; e < 8; ++e) { s[e] += xv[e]; o[e] = s[e] * rc - xv[e]; }
        u32x4 w; w.x = cvt_pk_bf16(o[0], o[1]); w.y = cvt_pk_bf16(o[2], o[3]); w.z = cvt_pk_bf16(o[4], o[5]); w.w = cvt_pk_bf16(o[6], o[7]);
        *(u32x4*)(ob + (size_t)i * 512) = w;
        const u32x4 r = x[15 + i - (W - 1)];
        s[0] -= bflo(r.x); s[1] -= bfhi(r.x); s[2] -= bflo(r.y); s[3] -= bfhi(r.y); s[4] -= bflo(r.z); s[5] -= bfhi(r.z); s[6] -= bflo(r.w); s[7] -= bfhi(r.w); }
}
__device__ __forceinline__ void pool_pass(const Ctx p, int l) {
    const int tid = otid(), lane = tid & 63, cgp = lane & 15, rq = lane >> 4;
    const u16* XB = (const u16*)(p.ws() + RB + 2 * COLB); u16* OB = (u16*)(p.ws() + RB + COLB);
    const int u0 = obid() * 8 + (tid >> 6), ustride = ogdim() * 8;
    for (int unit = u0; unit < NCH64 * 4; unit += ustride) {
        const int cq = unit >> 2, g = unit & 3, row0 = chunk_row0(cq);
        const bool samp = cq >= 512; const int bs = cq - 512; const int t0 = samp ? 0 : (cq & 255) * 64;
        const int t0q = t0 + rq * 16;
        const int col = g * 128 + cgp * 8;
        u32x4 x[31];
#pragma unroll
        for (int j = 0; j < 31; ++j) { const int tk = t0q - 15 + j;
            if (tk >= 0) x[j] = *(const u32x4*)(XB + (size_t)(row0 + rq * 16 - 15 + j) * 512 + col);
            else if (samp) { const float* sp = p.in(2) + ((size_t)(l * 8 + bs) * 15 + (15 + tk)) * 512 + col; const float4 a = *(const float4*)sp, b = *(const float4*)(sp + 4);
                x[j].x = cvt_pk_bf16(a.x, a.y); x[j].y = cvt_pk_bf16(a.z, a.w); x[j].z = cvt_pk_bf16(b.x, b.y); x[j].w = cvt_pk_bf16(b.z, b.w); }
            else x[j] = (u32x4){0u, 0u, 0u, 0u}; }
        u16* ob = OB + (size_t)(row0 + rq * 16) * 512 + col; const int nvalid = samp ? 15 : 0;
        if (g == 0) pool_rows<2>(x, t0q, nvalid, ob); else if (g == 1) pool_rows<4>(x, t0q, nvalid, ob); else if (g == 2) pool_rows<8>(x, t0q, nvalid, ob); else pool_rows<16>(x, t0q, nvalid, ob);
        if ((samp || t0 == 16320) && rq == 3) { float* po = (samp ? p.out() + O_POOLS + ((size_t)(l * 8 + bs) * 15) * 512 : p.out() + O_POOLP + ((size_t)(l * 2 + (cq >> 8)) * 15) * 512) + col;
#pragma unroll
            for (int j = 0; j < 15; ++j) { const u32x4 v = x[16 + j]; float* q = po + (size_t)j * 512;
                *(float4*)q = (float4){bflo(v.x), bfhi(v.x), bflo(v.y), bfhi(v.y)}; *(float4*)(q + 4) = (float4){bflo(v.z), bfhi(v.z), bflo(v.w), bfhi(v.w)}; } }
    }
}

#define XB_TMO      128
#define XB_XCNT(j)  (256  + 64 * (j))
#define XB_XSUB(j)  (1280 + 64 * (j))
#define XB_XGEN(j)  (2304 + 64 * (j))
#define XB_TOP      3328
#define XB_TOPGEN   3392
#define XCD_BAR_WORDS 3456
#define XB_SPIN_CAP (1u << 20)
__device__ __forceinline__ unsigned xb_ld(unsigned* p)              { return __hip_atomic_load(p, __ATOMIC_RELAXED, __HIP_MEMORY_SCOPE_AGENT); }
__device__ __forceinline__ unsigned xb_add(unsigned* p, unsigned v) { return __hip_atomic_fetch_add(p, v, __ATOMIC_RELAXED, __HIP_MEMORY_SCOPE_AGENT); }
__device__ __forceinline__ unsigned xb_xcc_id() { return (unsigned)__builtin_amdgcn_s_getreg((3 << 11) | 20) & 0xFu; }
#define XB_SPIN(cond, bar) do { unsigned _sp = 0; while (cond) { __builtin_amdgcn_s_sleep(1); \
    if ((++_sp & 255u) == 0u) { if (xb_ld(&(bar)[XB_TMO])) break; if (_sp > XB_SPIN_CAP) { atomicAdd(&(bar)[XB_TMO], 1u); break; } } } } while (0)
__device__ __forceinline__ void xcd_barrier_complete(unsigned* bar, unsigned x, unsigned& nloc, unsigned& nx) {
    const unsigned G = gridDim.x;
    unsigned sum, cnt, mine, sp = 0u;
    for (;;) {
        sum = 0u; cnt = 0u; mine = 0u;
#pragma unroll
        for (unsigned j = 0; j < 16; ++j) { const unsigned c = xb_ld(&bar[XB_XCNT(j)]); sum += c; cnt += (c > 0u) ? 1u : 0u; mine = (j == x) ? c : mine; }
        if (sum == G) break;
        __builtin_amdgcn_s_sleep(1);
        if ((++sp & 255u) == 0u) { if (xb_ld(&bar[XB_TMO])) break; if (sp > XB_SPIN_CAP) { atomicAdd(&bar[XB_TMO], 1u); break; } }
    }
    nloc = mine > 0u ? mine : 1u; nx = cnt > 0u ? cnt : 1u;
}
__device__ __forceinline__ void xcd_barrier(unsigned* bar, volatile LAS unsigned* st) {
    asm volatile("s_waitcnt vmcnt(0)" ::: "memory");
    __syncthreads();
    if (threadIdx.x == 0) {
        const unsigned x = xb_xcc_id();
        __builtin_amdgcn_s_waitcnt(0);
        unsigned nloc = st[0], nx = st[1];
        if (nloc == 0u) { xcd_barrier_complete(bar, x, nloc, nx); st[0] = nloc; st[1] = nx; }
        const unsigned old = xb_add(&bar[XB_XSUB(x)], 1u);
        const unsigned gen = old / nloc;
        if (old + 1u == (gen + 1u) * nloc) {
            __builtin_amdgcn_fence(__ATOMIC_RELEASE, "agent");
            asm volatile("s_waitcnt vmcnt(0)" ::: "memory");
            const unsigned og = xb_add(&bar[XB_TOP], 1u);
            const unsigned tg = og / nx;
            if (og + 1u == (tg + 1u) * nx) xb_add(&bar[XB_TOPGEN], 1u);
            else XB_SPIN(xb_ld(&bar[XB_TOPGEN]) == tg, bar);
            __builtin_amdgcn_fence(__ATOMIC_ACQUIRE, "agent");
            xb_add(&bar[XB_XGEN(x)], 1u);
            asm volatile("s_waitcnt vmcnt(0)" ::: "memory");
        } else {
            XB_SPIN(xb_ld(&bar[XB_XGEN(x)]) == gen, bar);
            __builtin_amdgcn_fence(__ATOMIC_ACQUIRE, "agent");
            asm volatile("s_waitcnt vmcnt(0)" ::: "memory");
        }
    }
    __syncthreads();
}

__global__ void __launch_bounds__(512, 2) fwd_mega(Params kp) {
    extern __shared__ __attribute__((aligned(16))) unsigned char lds_raw[];
    LAS unsigned char* lds = (LAS unsigned char*)lds_raw;
    cg::grid_group grid = cg::this_grid();
    { LAS unsigned* pw = (LAS unsigned*)(lds + 131072); const unsigned* src = (const unsigned*)&kp; if (threadIdx.x < sizeof(Params) / 4) pw[threadIdx.x] = src[threadIdx.x];
      if (threadIdx.x >= 128 && threadIdx.x < 132) pw[threadIdx.x] = 0u; }
    __syncthreads();
    volatile LAS unsigned* bst = (volatile LAS unsigned*)(lds + 131072 + 512);
    if (threadIdx.x == 0) (void)xb_add(&((unsigned*)(kp.ws + RBAR))[XB_XCNT(xb_xcc_id())], 1u);
    Ctx p; p.pl = (LAS const unsigned*)(lds + 131072);
    const int ph_lo = __builtin_amdgcn_readfirstlane(p.pl[42]), ph_hi = __builtin_amdgcn_readfirstlane(p.pl[43]);
    unsigned long long tp_prev = 0, tp_acc = 0; int tp_sel = 0;
    for (int ph = ph_lo; ph < ph_hi; ++ph) {
        if (ph > ph_lo) { if (ph == ph_lo + 1) grid.sync(); else xcd_barrier((unsigned*)(p.ws() + RBAR), bst); }
        if (TPM) { const unsigned long long now = __builtin_amdgcn_s_memrealtime(); if (tp_sel) tp_acc += now - tp_prev; tp_prev = now; tp_sel = ph == 0 ? (TPM & 1) : ((TPM >> ((ph - 1) % 13 + 1)) & 1); }
        const int G = osgpr((int)gridDim.x), c = osgpr((int)blockIdx.x);
        if (ph == 0) {
            rownorm_phase(p, true, 0.f, nullptr, p.in(4), true, 0);
            convert_ffn(p, lds, c, G, p.in(5), p.in(6), RWF);
            convert_mix(p, lds, c, G, 0);
            continue;
        }
        const int l = (ph - 1) / 13, s = (ph - 1) % 13 + 1;
        unsigned char* ws = p.ws();
        switch (s) {
        case 1: case 11: if (PHM & 1) {
            const size_t wf = s == 1 ? RWF : RWF2;
            pg8::SchedPlain S; S.o.init(MROWS / 256, NGU / 256, G, c); S.A = (const char*)(ws + RA); S.B = (const char*)(ws + wf); S.at = (size_t)256 * 1024 * 2; S.bt = (size_t)256 * 1024 * 2; S.nt = 16; S.ns = 0; S.nseg = 0; S.Asplit = nullptr;
            pg8::EpiGU E{(u16*)(ws + RB)};
            REP(0) pg8::gemm_phase(lds, 1024, 1024, 1024, S, E);
            const int extra = S.o.nwg % G;
            if (c >= extra) {
                if (s == 1) convert_ffn(p, lds, c - extra, G - extra, p.in(17) + (size_t)l * 1024 * NGU, p.in(18) + (size_t)l * DFF * 1024, RWF2);
                else if (l < DEPTH - 1) convert_mix(p, lds, c - extra, G - extra, l + 1);
            }
        } break;
        case 2: case 12: if (PHM & 2) {
            pg8::SchedPlain S; S.o.init(MP / 256, 4, G, c); S.A = (const char*)(ws + RB); S.B = (const char*)(ws + (s == 2 ? RWF : RWF2) + (RWF_DN - RWF)); S.at = (size_t)256 * DFF * 2; S.bt = (size_t)256 * DFF * 2; S.nt = DFF / 64; S.ns = 11; S.nseg = 0; S.Asplit = nullptr;
            pg8::EpiF32 E{(u16*)(ws + RC), 1024, (float*)(ws + RYP)};
            REP(1) pg8::gemm_phase(lds, DFF, DFF, DFF, S, E);
        } break;
        case 3: if (PHM & 4) { const float* gains = p.in(4) + (size_t)l * 6 * 1024; REP(11) rownorm_phase(p, false, rep_ ? 0.f : 0.5f, gains + 1024, gains + 2048, true, 11); } break;
        case 4: if (PHM & 8) {
            pg8::SchedPlain S; S.o.init(MROWS / 256, NIN / 256, G, c); S.A = (const char*)(ws + RA); S.B = (const char*)(ws + RWM); S.at = (size_t)256 * 1024 * 2; S.bt = (size_t)256 * 1024 * 2; S.nt = 16; S.ns = 0; S.nseg = 0; S.Asplit = nullptr;
            pg8::EpiIN E{(u16*)(ws + RB), (u16*)(ws + RC)};
            REP(2) pg8::gemm_phase(lds, 1024, 1024, 1024, S, E);
            const int extra = S.o.nwg % G;
            if (c >= extra && l < DEPTH - 1) convert_ffn(p, lds, c - extra, G - extra, p.in(5) + (size_t)(l + 1) * 1024 * NGU, p.in(6) + (size_t)(l + 1) * DFF * 1024, RWF);
        } break;
        case 5: { int it = c;
                    for (; it < 1056; it += G) { if (PHM & 16) REP(8) gmlp_unit(p, lds, l, it, osgpr(rep_ == 0 ? 1 : 0)); }
                    if (PHM & 32) { HaIn A; ha_load(p, it - 1056 < 2080 ? it - 1056 : 0, A);
                        for (; it < 1056 + 2080; it += G) hgrn_a_unit(p, lds, l, it - 1056, it + G - 1056, A); } } break;
        case 6: if (PHM & 64) REP(9) hgrn_scan_phase(p, l, osgpr(rep_ == 0 ? 1 : 0)); break;
        case 7: if (PHM & 128) { int it = c; HcIn A; hc_load(p, l, it < 2080 ? it : 0, A);
                    for (; it < 2080; it += G) hgrn_c_unit(p, lds, l, it, it + G, A, 1); }
                if (PHM & 256) REP(6) pool_pass(p, l); break;
        case 8: if (PHM & 512) {
            pg8::SchedPlain S; S.o.init(MP / 256, 4, G, c); S.A = (const char*)(ws + RB); S.B = (const char*)(ws + RWM_BR); S.at = (size_t)256 * 512 * 2; S.bt = (size_t)256 * 1536 * 2; S.nt = 24; S.ns = 0; S.nseg = 3; S.Asplit = nullptr;
            pg8::EpiBranch E{(const u16*)(ws + RC), (u16*)(ws + RA), (float*)(ws + RB + 2 * COLB)};
            REP(3) pg8::gemm_phase(lds, 1536, 512, 1536, S, E);
        } break;
        case 9: if (PHM & 1024) {
            if (c < 32) {
                const int tile = c >> 2, j = c & 3, pms = tile >> 2; const int tid = otid();
                const float* Pp = (const float*)(ws + RB + 2 * COLB); u16* blk = (u16*)(ws + RB + 4 * COLB + (size_t)c * (512 * 1024));
#pragma unroll 4
                for (int e = tid; e < 8192; e += 512) { const int r = e >> 5, col = j * 256 + (e & 31) * 8; const float* sp = Pp + (size_t)(pms * 256 + r) * 1024 + col;
                    float4 a = *(const float4*)sp, b = *(const float4*)(sp + 4);
#pragma unroll
                    for (int q = 1; q < 3; ++q) { const float4 a2 = *(const float4*)(sp + (size_t)q * 512 * 1024), b2 = *(const float4*)(sp + (size_t)q * 512 * 1024 + 4);
                        a.x += a2.x; a.y += a2.y; a.z += a2.z; a.w += a2.w; b.x += b2.x; b.y += b2.y; b.z += b2.z; b.w += b2.w; }
                    u32x4 w; w.x = cvt_pk_bf16(a.x, a.y); w.y = cvt_pk_bf16(a.z, a.w); w.z = cvt_pk_bf16(b.x, b.y); w.w = cvt_pk_bf16(b.z, b.w);
                    *(u32x4*)(blk + (size_t)r * 1024 + col) = w; }
                asm volatile("s_waitcnt vmcnt(0)" ::: "memory");
            }
            __syncthreads();
            pg8::SchedPlain S; S.o.init(MP / 256, 4, G, c); S.A = (const char*)(ws + RA); S.B = (const char*)(ws + RWM_OUT); S.at = (size_t)256 * 1024 * 2; S.bt = (size_t)256 * 1024 * 2; S.nt = 16; S.ns = 4; S.nseg = 0; S.Asplit = (const char*)(ws + RB + 4 * COLB);
            pg8::EpiF32 E{(u16*)(ws + RC), 1024, (float*)(ws + RYP)};
            REP(4) pg8::gemm_phase(lds, 1024, 1024, 1024, S, E);
        } break;
        case 10: { const float* gains = p.in(4) + (size_t)l * 6 * 1024; REP(11) rownorm_phase(p, false, rep_ ? 0.f : 1.0f, gains + 3 * 1024, gains + 4 * 1024, true, 4); } break;
        case 13: { const float* gains = p.in(4) + (size_t)l * 6 * 1024; REP(11) rownorm_phase(p, false, rep_ ? 0.f : 0.5f, gains + 5 * 1024, gains + (l < DEPTH - 1 ? 6 * 1024 : 0), l < DEPTH - 1, 11); } break;
        }
    }
    if (TPM) { unsigned long long now = __builtin_amdgcn_s_memrealtime(); if (tp_sel) tp_acc += now - tp_prev;
        if (blockIdx.x == 0 && threadIdx.x == 0) { const unsigned long long t0 = now; while (__builtin_amdgcn_s_memrealtime() - t0 < TMULT * tp_acc) __builtin_amdgcn_s_sleep(8); } }
}

constexpr int N_PHASES = 1 + 13 * DEPTH;

extern "C" void kernel_launch(void* const* d_in, const int* in_sizes, int n_in, void* d_out, int out_size, void* d_ws, size_t ws_size, hipStream_t stream) {
    static int grid = 0;
    if (grid == 0) {
        if (n_in != 19 || ws_size < WS_END) { fprintf(stderr, "kernel_launch: need 19 inputs and %zu bytes of workspace (got %d, %zu)\n", (size_t)WS_END, n_in, ws_size); grid = -1; return; }
        int dev = 0, cus = 0, per_cu = 0;
        hipGetDevice(&dev); hipDeviceGetAttribute(&cus, hipDeviceAttributeMultiprocessorCount, dev);
        hipFuncSetAttribute((const void*)fwd_mega, hipFuncAttributeMaxDynamicSharedMemorySize, LDS_BYTES);
        hipOccupancyMaxActiveBlocksPerMultiprocessor(&per_cu, (const void*)fwd_mega, 512, LDS_BYTES);
        if (per_cu < 1) { fprintf(stderr, "kernel_launch: occupancy query says %d blocks per CU\n", per_cu); per_cu = 1; }
        (void)hipGetLastError();
        grid = cus * per_cu;
    }
    if (grid < 0) return;
    Params p{};
    for (int i = 0; i < 19; ++i) p.in[i] = (const float*)d_in[i];
    p.out = (float*)d_out; p.ws = (unsigned char*)d_ws;
    (void)hipMemsetAsync((unsigned char*)d_ws + RBAR, 0, 3456 * 4, stream);
#if MULTI_LAUNCH
    for (int ph = 0; ph < N_PHASES; ++ph) { p.ph_lo = ph; p.ph_hi = ph + 1; hipLaunchKernelGGL(fwd_mega, dim3(grid), dim3(512), LDS_BYTES, stream, p); }
#else
    p.ph_lo = 0; p.ph_hi = N_PHASES;
    void* args[] = {&p};
    hipError_t e = hipLaunchCooperativeKernel((const void*)fwd_mega, dim3(grid), dim3(512), args, LDS_BYTES, stream);
    if (e != hipSuccess) fprintf(stderr, "cooperative launch failed: %s (grid %d)\n", hipGetErrorString(e), grid);
#endif
}
```

```cpp
#include <hip/hip_runtime.h>
#include <hip/hip_cooperative_groups.h>
#include <cstdio>
namespace cg = cooperative_groups;

#define LAS __attribute__((address_space(3)))
typedef unsigned short u16;
typedef short bf16x8 __attribute__((ext_vector_type(8)));
typedef float f32x4 __attribute__((ext_vector_type(4)));
typedef unsigned u32x4 __attribute__((ext_vector_type(4)));
typedef unsigned u32x2 __attribute__((ext_vector_type(2)));
typedef _Float16 h16x2 __attribute__((ext_vector_type(2)));

#ifndef PHM
#define PHM 0xffff
#endif
#ifndef DUP
#define DUP 0x0
#endif
#define REP(bit) for (int rep_ = 0; rep_ <= ((DUP >> (bit)) & 1); ++rep_)
#ifndef TPM
#define TPM 0
#endif
#define TMULT 4
#ifndef SPLITK
#define SPLITK 1
#endif
#ifndef USE_SP2
#define USE_SP2 1
#endif
#ifndef USE_ALIGN
#define USE_ALIGN 1
#endif
#ifndef MULTI_LAUNCH
#define MULTI_LAUNCH 0
#endif

constexpr int MROWS = 33280, MP = 32768, DM = 1024, DFF = 2816, NGU = 5632, NIN = 6656, DEPTH = 4;
constexpr int NCH64 = MROWS / 64;
constexpr float EPS = 1e-6f;
constexpr size_t O_POOLP = 34078720, O_POOLS = 34140160, O_HGP = 34385920, O_HGS = 34910208, O_VS = 37007360;
constexpr size_t COLB = (size_t)MROWS * 512 * 2;
constexpr size_t RA = 0;
constexpr size_t RB = RA + (size_t)MROWS * 1024 * 2;
constexpr size_t RC = RB + 7 * COLB;
constexpr size_t RYP = RC + (size_t)MROWS * 1024 * 4;
constexpr size_t RWF = RC + (size_t)MROWS * 3072 * 2;
constexpr size_t RWF_DN = RWF + (size_t)NGU * 1024 * 2;
constexpr size_t RWM = RWF_DN + (size_t)1024 * DFF * 2;
constexpr size_t RWM_BR = RWM + (size_t)NIN * 1024 * 2;
constexpr size_t RWM_OUT = RWM_BR + (size_t)1024 * 1536 * 2;
constexpr size_t RWM_POOL = RWM_OUT + (size_t)1024 * 1024 * 2;
constexpr size_t RSM = RWM_POOL + (size_t)4 * 128 * 128 * 2;
constexpr size_t RBAR = RSM + (size_t)NCH64 * 4 * 128 * 4;
constexpr size_t RWF2 = RBAR + 3456 * 4 + 256;
constexpr size_t WS_END = RWF2 + (RWF_DN - RWF) + (size_t)1024 * DFF * 2;
constexpr int LDS_BYTES = 131072 + 2048;

struct Params { const float* in[19]; float* out; unsigned char* ws; int ph_lo, ph_hi; };
struct Ctx {
    LAS const unsigned* pl;
    __device__ __forceinline__ unsigned long long q(int k) const { const unsigned lo = __builtin_amdgcn_readfirstlane(pl[2 * k]), hi = __builtin_amdgcn_readfirstlane(pl[2 * k + 1]); return ((unsigned long long)hi << 32) | lo; }
    __device__ __forceinline__ const float* in(int k) const { return (const float*)q(k); }
    __device__ __forceinline__ float* out() const { return (float*)q(19); }
    __device__ __forceinline__ unsigned char* ws() const { return (unsigned char*)q(20); }
};

__device__ __forceinline__ float bf2f(unsigned b) { return __uint_as_float(b << 16); }
__device__ __forceinline__ float bflo(unsigned w) { return __uint_as_float(w << 16); }
__device__ __forceinline__ float bfhi(unsigned w) { return __uint_as_float(w & 0xffff0000u); }
__device__ __forceinline__ u16 f2bf(float f) { unsigned u = __float_as_uint(f); u += 0x7FFFu + ((u >> 16) & 1u); return (u16)(u >> 16); }
typedef __bf16 bf16x2_t __attribute__((ext_vector_type(2)));
typedef float f32x2_t __attribute__((ext_vector_type(2)));
__device__ __forceinline__ unsigned cvt_pk_bf16(float lo, float hi) { const f32x2_t v = {lo, hi}; const bf16x2_t r = __builtin_convertvector(v, bf16x2_t); return __builtin_bit_cast(unsigned, r); }
__device__ __forceinline__ float fsig(float x) { return __builtin_amdgcn_rcpf(1.0f + __expf(-x)); }
__device__ __forceinline__ float fsilu(float x) { return x * fsig(x); }
__device__ __forceinline__ float fgelu(float x) { return x * fsig(1.5957691216f * (x + 0.044715f * x * x * x)); }
__device__ __forceinline__ float wave_sum(float v) {
#pragma unroll
    for (int o = 32; o >= 1; o >>= 1) v += __shfl_xor(v, o);
    return v;
}

__device__ __forceinline__ int otid() { int t = threadIdx.x; asm volatile("" : "+v"(t)); return t; }
template <class T> __device__ __forceinline__ T osgpr(T x) { asm volatile("" : "+s"(x)); return x; }
__device__ __forceinline__ int obid() { return osgpr((int)blockIdx.x); }
__device__ __forceinline__ int ogdim() { return osgpr((int)gridDim.x); }

namespace pg8 {
constexpr int BM = 256, BK = 64, HALF = 128, HTB = HALF * BK * 2, STAGE_BYTES = 8 * HTB, NXCD = 8, WGM = 8;
__device__ __forceinline__ int lds_byte(int r, int c) { const int st = (r >> 4) * 2 + (c >> 5), rr = r & 15, cc = c & 31, ob = rr * 64 + cc * 2; return st * 1024 + (ob ^ (((ob >> 9) & 1) << 5)); }
__device__ __forceinline__ void stage_rc(int b, int& R, int& C) { const int st = b / 1024, sb = b % 1024, swz = sb ^ (((sb >> 9) & 1) << 5); R = (st >> 1) * 16 + swz / 64; C = (st & 1) * 32 + (swz % 64) / 2; }
__device__ __forceinline__ int perm32(int rho) { const int n = rho >> 4, i = rho & 15; return 8 * (i >> 2) + 4 * n + (i & 3); }

struct Unit { const char* a; const char* b; int pm, pn, aux, nt; };

struct TileOrder {
    int nM, nN, nwg, G, c;
    __device__ void init(int nM_, int nN_, int G_, int c_) { nM = nM_; nN = nN_; nwg = nM * nN; G = G_; c = c_; }
    __device__ bool tile(int i, int& pm, int& pn) const {
        const long L = (long)i * G + c; if (L >= nwg) return false;
        int wgid = (int)L; { const int q = nwg / NXCD, r = nwg % NXCD, xcd = wgid % NXCD, off = wgid / NXCD; wgid = (xcd < r ? xcd * (q + 1) : r * (q + 1) + (xcd - r) * q) + off; }
        const int nig = WGM * nN, gid = wgid / nig, fm = gid * WGM, gsz = (nM - fm) < WGM ? (nM - fm) : WGM;
        pm = fm + ((wgid % nig) % gsz); pn = (wgid % nig) / gsz; return true;
    }
};
struct SchedPlain {
    TileOrder o; const char* A; const char* B; size_t at, bt;
    int nt;
    int ns;
    int nseg;
    const char* Asplit;
    __device__ bool next(int i, Unit& u) const {
        int pm, pn;
        if (o.tile(i, pm, pn)) { u.a = A + (size_t)pm * at; u.b = B + (size_t)pn * bt; u.pm = pm; u.pn = pn; u.aux = 0; u.nt = nt; return true; }
        const int nfull = (o.nwg - o.c + o.G - 1) / o.G;
        if (i != nfull) return false;
        if (nseg) { if (o.c >= 24) return false;
            const int tile = o.c / 3, sg = o.c - tile * 3, pms = tile >> 2; pn = tile & 3;
            u.a = A + (sg == 0 ? (size_t)0 : (sg == 1 ? COLB : 3 * COLB)) + (size_t)(128 + pms) * at; u.b = B + (size_t)pn * bt + (size_t)sg * 1024; u.pm = pms; u.pn = pn; u.aux = sg + 1; u.nt = 8; return true; }
        if (ns == 0 || o.c >= 8 * ns) return false;
        const int tile = o.c / ns, j = o.c - tile * ns, pms = tile >> 2; pn = tile & 3;
        u.a = (Asplit ? Asplit + (size_t)o.c * (512 * 1024) : A + (size_t)(128 + pms) * at) + (size_t)j * 512; u.b = B + (size_t)pn * bt + (size_t)j * 512; u.pm = pms; u.pn = pn; u.aux = j + 1; u.nt = 4; return true;
    }
};

template <class Epi, class Sched>
__device__ __forceinline__ void gemm_phase(LAS unsigned char* lds, const int K, const int lda, const int ldb, const Sched& S, const Epi& E) {
    const int tid = otid(), wid = __builtin_amdgcn_readfirstlane(tid >> 6), lane = tid & 63, wr = wid >> 2, wc = wid & 3, fr = lane & 15, fq = lane >> 4;
    unsigned voffA[2], voffB[2];
#pragma unroll
    for (int i = 0; i < 2; ++i) { int R, C; stage_rc(tid * 16 + i * 8192, R, C); const int Rb = Epi::PERM ? ((R & ~31) + perm32(R & 31)) : R;
        voffA[i] = (unsigned)(R * lda + C) * 2u; voffB[i] = (unsigned)(Rb * ldb + C) * 2u; }
    const size_t kstep = (size_t)(BK * 2);
    const size_t hstepA = (size_t)HALF * lda * 2, hstepB = (size_t)HALF * ldb * 2;
    const unsigned ldsw = (unsigned)wid * 1024u;
    const int aoff = lds_byte(wr * 64 + fr, fq * 8), boff = lds_byte(wc * 32 + fr, fq * 8);
#define PG8_SA(b, h) (((b) * 2 + (h)) * HTB)
#define PG8_SB(b, h) ((4 + (b) * 2 + (h)) * HTB)
#define PG8_STAGE(bufoff, gbase, voff) do { _Pragma("unroll") for (int _i = 0; _i < 2; ++_i) \
        __builtin_amdgcn_global_load_lds((const unsigned*)((const char*)(gbase) + (voff)[_i]), (LAS unsigned*)(lds + (bufoff) + ldsw + _i * 8192), 16, 0, 0); } while (0)
#define PG8_LDA(dst, b, h) do { _Pragma("unroll") for (int m = 0; m < 4; ++m) _Pragma("unroll") for (int k = 0; k < 2; ++k) dst[m][k] = *(const LAS bf16x8*)(lds + PG8_SA(b, h) + aoff + m * 2048 + k * 1024); } while (0)
#define PG8_LDB(dst, b, h) do { _Pragma("unroll") for (int n = 0; n < 2; ++n) _Pragma("unroll") for (int k = 0; k < 2; ++k) dst[n][k] = *(const LAS bf16x8*)(lds + PG8_SB(b, h) + boff + n * 2048 + k * 1024); } while (0)
#define PG8_MMA(ai, bj, At, Bt) do { __builtin_amdgcn_s_setprio(1); _Pragma("unroll") for (int m = 0; m < 4; ++m) _Pragma("unroll") for (int n = 0; n < 2; ++n) _Pragma("unroll") for (int k = 0; k < 2; ++k) \
        acc[ai][bj][m][n] = __builtin_amdgcn_mfma_f32_16x16x32_bf16(Bt[n][k], At[m][k], acc[ai][bj][m][n], 0, 0, 0); __builtin_amdgcn_s_setprio(0); } while (0)
#define PG8_WAIT_V(n) asm volatile("s_waitcnt vmcnt(" #n ")" ::: "memory")
#define PG8_WAIT_L(n) asm volatile("s_waitcnt lgkmcnt(" #n ")" ::: "memory")
#define PG8_BAR __builtin_amdgcn_s_barrier()
#define PG8_SCHED __builtin_amdgcn_sched_barrier(0)
    Unit cur, nxt; int ui = 0;
    if (!S.next(0, cur)) return;
    f32x4 acc[2][2][4][2];
#pragma unroll
    for (int a = 0; a < 2; ++a)
#pragma unroll
        for (int b = 0; b < 2; ++b)
#pragma unroll
            for (int m = 0; m < 4; ++m)
#pragma unroll
                for (int n = 0; n < 2; ++n) acc[a][b][m][n] = (f32x4){0.f, 0.f, 0.f, 0.f};
    bf16x8 At[4][2], B0[2][2], B1[2][2];
    const char* cA = cur.a; const char* cB = cur.b;
    if constexpr (USE_SP2) {
        PG8_STAGE(PG8_SB(0, 0), cB, voffB); PG8_STAGE(PG8_SB(0, 1), cB + hstepB, voffB); PG8_STAGE(PG8_SA(0, 0), cA, voffA); PG8_STAGE(PG8_SA(0, 1), cA + hstepA, voffA);
        if (wr == 1) PG8_BAR;
        PG8_WAIT_V(2); PG8_BAR;
        PG8_STAGE(PG8_SB(1, 0), cB + kstep, voffB); PG8_STAGE(PG8_SA(1, 0), cA + kstep, voffA); PG8_STAGE(PG8_SB(1, 1), cB + hstepB + kstep, voffB);
        PG8_WAIT_V(6); PG8_BAR;
    } else {
    PG8_STAGE(PG8_SB(0, 0), cB, voffB); PG8_STAGE(PG8_SA(0, 0), cA, voffA); PG8_STAGE(PG8_SB(0, 1), cB + hstepB, voffB); PG8_STAGE(PG8_SA(0, 1), cA + hstepA, voffA);
    if (wr == 1) PG8_BAR;
    PG8_WAIT_V(4); PG8_BAR;
    PG8_STAGE(PG8_SB(1, 0), cB + kstep, voffB); PG8_STAGE(PG8_SA(1, 0), cA + kstep, voffA); PG8_STAGE(PG8_SB(1, 1), cB + hstepB + kstep, voffB);
    PG8_WAIT_V(6); PG8_BAR;
    }
    for (;;) {
        const bool has_next = S.next(ui + 1, nxt);
        const char* nA = has_next ? nxt.a : cA; const char* nB = has_next ? nxt.b : cB;
        const int nt = cur.nt;
        for (int t = 0; t < nt; t += 2) {
            const bool last = (t == nt - 2);
            if constexpr (Epi::SEG) { if (t == 8 || t == 16) E.rescale(acc, cur, t >> 3, wr, wc, fr, fq); }
            const char* a1 = cA + (size_t)(t + 1) * kstep + (Epi::SEG ? Epi::segoff(t >> 3) : (size_t)0);
            const char* a2 = last ? nA : cA + (size_t)(t + 2) * kstep + (Epi::SEG ? Epi::segoff((t + 2) >> 3) : (size_t)0); const char* b2 = last ? nB : cB + (size_t)(t + 2) * kstep;
            const char* a3 = a2 + kstep; const char* b3 = b2 + kstep;
            if constexpr (USE_SP2) {
            PG8_LDB(B0, 0, 0); PG8_LDB(B1, 0, 1); PG8_SCHED; PG8_LDA(At, 0, 0); PG8_STAGE(PG8_SA(1, 1), a1 + hstepA, voffA);
            PG8_WAIT_V(8); PG8_WAIT_L(0); PG8_BAR; PG8_MMA(0, 0, At, B0); PG8_MMA(0, 1, At, B1); PG8_BAR; PG8_SCHED;
            PG8_LDA(At, 0, 1); PG8_STAGE(PG8_SB(0, 0), b2, voffB); PG8_STAGE(PG8_SB(0, 1), b2 + hstepB, voffB); PG8_STAGE(PG8_SA(0, 0), a2, voffA);
            PG8_WAIT_V(8); PG8_WAIT_L(0); PG8_BAR; PG8_MMA(1, 0, At, B0); PG8_MMA(1, 1, At, B1); PG8_BAR; PG8_SCHED;
            PG8_LDB(B0, 1, 0); PG8_LDB(B1, 1, 1); PG8_SCHED; PG8_LDA(At, 1, 0); PG8_STAGE(PG8_SA(0, 1), a2 + hstepA, voffA);
            PG8_WAIT_V(8); PG8_WAIT_L(0); PG8_BAR; PG8_MMA(0, 0, At, B0); PG8_MMA(0, 1, At, B1); PG8_BAR; PG8_SCHED;
            PG8_LDA(At, 1, 1); PG8_STAGE(PG8_SB(1, 0), b3, voffB); PG8_STAGE(PG8_SB(1, 1), b3 + hstepB, voffB); PG8_STAGE(PG8_SA(1, 0), a3, voffA);
            PG8_WAIT_V(8); PG8_WAIT_L(0); PG8_BAR; PG8_MMA(1, 0, At, B0); PG8_MMA(1, 1, At, B1); PG8_BAR; PG8_SCHED;
            } else {
            PG8_LDB(B0, 0, 0); PG8_SCHED; PG8_LDA(At, 0, 0); PG8_STAGE(PG8_SA(1, 1), a1 + hstepA, voffA);
            PG8_WAIT_L(8); PG8_BAR; PG8_WAIT_L(0); PG8_MMA(0, 0, At, B0); PG8_BAR; PG8_SCHED;
            PG8_LDB(B1, 0, 1); PG8_STAGE(PG8_SB(0, 0), b2, voffB);
            PG8_BAR; PG8_WAIT_L(0); PG8_MMA(0, 1, At, B1); PG8_BAR;
            PG8_LDA(At, 0, 1); PG8_STAGE(PG8_SA(0, 0), a2, voffA);
            PG8_BAR; PG8_WAIT_L(0); PG8_MMA(1, 0, At, B0); PG8_BAR; PG8_SCHED;
            PG8_STAGE(PG8_SB(0, 1), b2 + hstepB, voffB);
            PG8_WAIT_V(6); PG8_BAR; PG8_MMA(1, 1, At, B1); PG8_BAR;
            PG8_LDB(B0, 1, 0); PG8_SCHED; PG8_LDA(At, 1, 0); PG8_STAGE(PG8_SA(0, 1), a2 + hstepA, voffA);
            PG8_WAIT_L(8); PG8_BAR; PG8_WAIT_L(0); PG8_MMA(0, 0, At, B0); PG8_BAR; PG8_SCHED;
            PG8_LDB(B1, 1, 1); PG8_STAGE(PG8_SB(1, 0), b3, voffB);
            PG8_BAR; PG8_WAIT_L(0); PG8_MMA(0, 1, At, B1); PG8_BAR;
            PG8_LDA(At, 1, 1); PG8_STAGE(PG8_SA(1, 0), a3, voffA);
            PG8_BAR; PG8_WAIT_L(0); PG8_MMA(1, 0, At, B0); PG8_BAR; PG8_SCHED;
            PG8_STAGE(PG8_SB(1, 1), b3 + hstepB, voffB);
            PG8_WAIT_V(6); PG8_BAR; PG8_MMA(1, 1, At, B1); PG8_BAR;
            }
        }
        if constexpr (USE_ALIGN) { if (wr == 0) PG8_BAR; }
        E(acc, cur, wr, wc, fr, fq);
        if (!has_next) break;
#pragma unroll
        for (int a = 0; a < 2; ++a)
#pragma unroll
            for (int b = 0; b < 2; ++b)
#pragma unroll
                for (int m = 0; m < 4; ++m)
#pragma unroll
                    for (int n = 0; n < 2; ++n) acc[a][b][m][n] = (f32x4){0.f, 0.f, 0.f, 0.f};
        cur = nxt; cA = nA; cB = nB; ++ui;
        if constexpr (USE_ALIGN) { if (wr == 1) PG8_BAR; }
    }
    PG8_WAIT_V(0);
    if constexpr (!USE_ALIGN) { if (wr == 0) PG8_BAR; }
    PG8_BAR;
    asm volatile("" ::: "memory");
#undef PG8_SA
#undef PG8_SB
#undef PG8_STAGE
#undef PG8_LDA
#undef PG8_LDB
#undef PG8_MMA
#undef PG8_WAIT_V
#undef PG8_WAIT_L
#undef PG8_BAR
#undef PG8_SCHED
}

struct EpiF32 {
    static constexpr bool PERM = true;
    static constexpr bool SEG = false; static __device__ __forceinline__ size_t segoff(int) { return 0; }
    u16* C; int ldc; float* P;
    __device__ __forceinline__ void operator()(const f32x4 (&acc)[2][2][4][2], const Unit& u, int wr, int wc, int fr, int fq) const {
        const int row0 = u.pm * BM + wr * 64 + fr, col0 = u.pn * BM + wc * 32 + 8 * fq;
        if (u.aux == 0) {
            const unsigned o0 = (unsigned)(row0 * ldc + col0) * 2u;
#pragma unroll
            for (int ai = 0; ai < 2; ++ai)
#pragma unroll
                for (int m = 0; m < 4; ++m) { const unsigned ro = o0 + (unsigned)((ai * HALF + m * 16) * ldc) * 2u;
#pragma unroll
                    for (int bj = 0; bj < 2; ++bj) { const f32x4 v0 = acc[ai][bj][m][0], v1 = acc[ai][bj][m][1]; u32x4 w;
                        w.x = cvt_pk_bf16(v0[0], v0[1]); w.y = cvt_pk_bf16(v0[2], v0[3]); w.z = cvt_pk_bf16(v1[0], v1[1]); w.w = cvt_pk_bf16(v1[2], v1[3]);
                        *(u32x4*)((char*)C + (ro + (unsigned)(bj * HALF) * 2u)) = w; } }
        } else {
            char* Cb = (char*)(P + (size_t)(u.aux - 1) * ((size_t)512 * 1024)); const unsigned o0 = (unsigned)(row0 * ldc + col0) * 4u;
#pragma unroll
            for (int ai = 0; ai < 2; ++ai)
#pragma unroll
                for (int m = 0; m < 4; ++m) { const unsigned ro = o0 + (unsigned)((ai * HALF + m * 16) * ldc) * 4u;
#pragma unroll
                    for (int bj = 0; bj < 2; ++bj)
#pragma unroll
                        for (int n = 0; n < 2; ++n) *(f32x4*)(Cb + (ro + (unsigned)(bj * HALF + n * 4) * 4u)) = acc[ai][bj][m][n]; }
        }
    }
};
struct EpiGU {
    static constexpr bool SEG = false; static __device__ __forceinline__ size_t segoff(int) { return 0; }
    static constexpr bool PERM = true;
    u16* H;
    __device__ __forceinline__ void operator()(const f32x4 (&acc)[2][2][4][2], const Unit& u, int wr, int wc, int fr, int fq) const {
        const int row0 = u.pm * BM + wr * 64 + fr, col0 = u.pn * 128 + wc * 32 + 8 * fq;
#pragma unroll
        for (int ai = 0; ai < 2; ++ai)
#pragma unroll
            for (int m = 0; m < 4; ++m) { u16* rowp = (u16*)((char*)H + (unsigned)((row0 + ai * HALF + m * 16) * DFF + col0) * 2u);
                const f32x4 g0 = acc[ai][0][m][0], g1 = acc[ai][0][m][1], u0 = acc[ai][1][m][0], u1 = acc[ai][1][m][1];
                u32x4 w; w.x = cvt_pk_bf16(fsilu(g0[0]) * u0[0], fsilu(g0[1]) * u0[1]); w.y = cvt_pk_bf16(fsilu(g0[2]) * u0[2], fsilu(g0[3]) * u0[3]);
                w.z = cvt_pk_bf16(fsilu(g1[0]) * u1[0], fsilu(g1[1]) * u1[1]); w.w = cvt_pk_bf16(fsilu(g1[2]) * u1[2], fsilu(g1[3]) * u1[3]);
                *(u32x4*)rowp = w; }
    }
};
struct EpiIN {
    static constexpr bool PERM = true;
    static constexpr bool SEG = false; static __device__ __forceinline__ size_t segoff(int) { return 0; }
    u16* cols; u16* G;
    static __device__ __forceinline__ float act(float x, float k1, float k3, float px, float p1) {
        const float e = __builtin_amdgcn_exp2f(x * (k3 * (x * x) + k1));
        return (px * x + p1) * __builtin_amdgcn_rcpf(1.0f + e);
    }
    __device__ __forceinline__ void operator()(const f32x4 (&acc)[2][2][4][2], const Unit& u, int wr, int wc, int fr, int fq) const {
        const int pn = u.pn; const int mode = pn < 14 ? (pn >> 1) : 7;
        u16* base = pn < 14 ? cols + (size_t)(pn >> 1) * ((size_t)MROWS * 512) : G;
        const int ldc = pn < 14 ? 512 : 3072; const int colt = pn < 14 ? (pn & 1) * 256 : (pn - 14) * 256;
        const int row0 = u.pm * BM + wr * 64 + fr, col0 = colt + wc * 32 + 8 * fq;
        const bool isg = mode <= 1, ident = (mode == 2 || mode == 4 || mode == 5);
        const float L2E = 1.4426950408889634f;
        const float k1 = ident ? 0.f : (isg ? -1.5957691216f * L2E : -L2E), k3 = isg ? -1.5957691216f * 0.044715f * L2E : 0.f;
        const float px = ident ? 2.0f : (mode == 3 ? 0.08838834764831845f : (mode == 7 ? 0.f : 1.0f)), p1 = mode == 7 ? 1.0f : 0.f;
#pragma unroll
        for (int ai = 0; ai < 2; ++ai)
#pragma unroll
            for (int m = 0; m < 4; ++m) { u16* rowp = (u16*)((char*)base + (unsigned)((row0 + ai * HALF + m * 16) * ldc + col0) * 2u);
#pragma unroll
                for (int bj = 0; bj < 2; ++bj) { const f32x4 v0 = acc[ai][bj][m][0], v1 = acc[ai][bj][m][1]; u32x4 w;
                    if (mode == 4) {
                        w.x = __builtin_bit_cast(unsigned, (h16x2){(_Float16)v0[0], (_Float16)v0[1]}); w.y = __builtin_bit_cast(unsigned, (h16x2){(_Float16)v0[2], (_Float16)v0[3]});
                        w.z = __builtin_bit_cast(unsigned, (h16x2){(_Float16)v1[0], (_Float16)v1[1]}); w.w = __builtin_bit_cast(unsigned, (h16x2){(_Float16)v1[2], (_Float16)v1[3]});
                    } else {
                        w.x = cvt_pk_bf16(act(v0[0], k1, k3, px, p1), act(v0[1], k1, k3, px, p1)); w.y = cvt_pk_bf16(act(v0[2], k1, k3, px, p1), act(v0[3], k1, k3, px, p1));
                        w.z = cvt_pk_bf16(act(v1[0], k1, k3, px, p1), act(v1[1], k1, k3, px, p1)); w.w = cvt_pk_bf16(act(v1[2], k1, k3, px, p1), act(v1[3], k1, k3, px, p1));
                    }
                    *(u32x4*)(rowp + bj * HALF) = w; } }
    }
};
struct EpiBranch {
    static constexpr bool PERM = true, SEG = true;
    const u16* G; u16* O; float* P;
    static __device__ __forceinline__ size_t segoff(int sgi) { return sgi == 0 ? (size_t)0 : (sgi == 1 ? COLB - 1024 : 3 * COLB - 2048); }
    __device__ __forceinline__ void rescale(f32x4 (&acc)[2][2][4][2], const Unit& u, int j, int wr, int wc, int fr, int fq) const {
        const int row0 = u.pm * BM + wr * 64 + fr, col0 = u.pn * BM + wc * 32 + 8 * fq;
        const char* Gb = (const char*)G; const unsigned goff = (unsigned)((row0 * 3072 + (j - 1) * 1024 + col0) * 2);
#pragma unroll
        for (int am = 0; am < 4; ++am) { const int ai = am >> 1, m0 = (am & 1) * 2;
            u32x4 na[2][2], nb[2][2];
#pragma unroll
            for (int m = 0; m < 2; ++m)
#pragma unroll
                for (int bj = 0; bj < 2; ++bj) { const unsigned go = goff + (unsigned)(((ai * HALF + (m0 + m) * 16) * 3072 + bj * HALF) * 2);
                    na[m][bj] = *(const u32x4*)(Gb + go); nb[m][bj] = *(const u32x4*)(Gb + go + 2048u); }
#pragma unroll
            for (int m = 0; m < 2; ++m)
#pragma unroll
                for (int bj = 0; bj < 2; ++bj) { const u32x4 a = na[m][bj], b = nb[m][bj]; f32x4& v0 = acc[ai][bj][m0 + m][0]; f32x4& v1 = acc[ai][bj][m0 + m][1];
                    v0[0] *= bflo(a.x) * __builtin_amdgcn_rcpf(bflo(b.x)); v0[1] *= bfhi(a.x) * __builtin_amdgcn_rcpf(bfhi(b.x));
                    v0[2] *= bflo(a.y) * __builtin_amdgcn_rcpf(bflo(b.y)); v0[3] *= bfhi(a.y) * __builtin_amdgcn_rcpf(bfhi(b.y));
                    v1[0] *= bflo(a.z) * __builtin_amdgcn_rcpf(bflo(b.z)); v1[1] *= bfhi(a.z) * __builtin_amdgcn_rcpf(bfhi(b.z));
                    v1[2] *= bflo(a.w) * __builtin_amdgcn_rcpf(bflo(b.w)); v1[3] *= bfhi(a.w) * __builtin_amdgcn_rcpf(bfhi(b.w)); }
            asm volatile("" ::: "memory");
        }
    }
    __device__ __forceinline__ void operator()(const f32x4 (&acc)[2][2][4][2], const Unit& u, int wr, int wc, int fr, int fq) const {
        if (u.aux > 0) {
            const int sg = u.aux - 1; const int rrel = u.pm * BM + wr * 64 + fr, col0 = u.pn * BM + wc * 32 + 8 * fq;
            const unsigned g0 = (unsigned)(((MP + rrel) * 3072 + sg * 1024 + col0) * 2), p0 = (unsigned)((sg * 512 * 1024 + rrel * 1024 + col0) * 4);
#pragma unroll
            for (int ai = 0; ai < 2; ++ai) {
                u32x4 gw[4][2];
#pragma unroll
                for (int m = 0; m < 4; ++m)
#pragma unroll
                    for (int bj = 0; bj < 2; ++bj) gw[m][bj] = *(const u32x4*)((const char*)G + (g0 + (unsigned)(((ai * HALF + m * 16) * 3072 + bj * HALF) * 2)));
#pragma unroll
                for (int m = 0; m < 4; ++m)
#pragma unroll
                    for (int bj = 0; bj < 2; ++bj) { const u32x4 g = gw[m][bj]; const f32x4 v0 = acc[ai][bj][m][0], v1 = acc[ai][bj][m][1];
                        char* pp = (char*)P + (p0 + (unsigned)(((ai * HALF + m * 16) * 1024 + bj * HALF) * 4));
                        *(f32x4*)pp = (f32x4){v0[0] * bflo(g.x), v0[1] * bfhi(g.x), v0[2] * bflo(g.y), v0[3] * bfhi(g.y)};
                        *(f32x4*)(pp + 16) = (f32x4){v1[0] * bflo(g.z), v1[1] * bfhi(g.z), v1[2] * bflo(g.w), v1[3] * bfhi(g.w)}; }
            }
            return;
        }
        const int row0 = u.pm * BM + wr * 64 + fr, col0 = u.pn * BM + wc * 32 + 8 * fq;
#pragma unroll
        for (int ai = 0; ai < 2; ++ai) {
            u32x4 gw[4][2];
#pragma unroll
            for (int m = 0; m < 4; ++m)
#pragma unroll
                for (int bj = 0; bj < 2; ++bj) gw[m][bj] = *(const u32x4*)((const char*)G + (unsigned)((row0 + ai * HALF + m * 16) * 3072 + 2048 + col0 + bj * HALF) * 2u);
#pragma unroll
            for (int m = 0; m < 4; ++m)
#pragma unroll
                for (int bj = 0; bj < 2; ++bj) { const u32x4 g = gw[m][bj]; const f32x4 v0 = acc[ai][bj][m][0], v1 = acc[ai][bj][m][1]; u32x4 w;
                    w.x = cvt_pk_bf16(v0[0] * bflo(g.x), v0[1] * bfhi(g.x)); w.y = cvt_pk_bf16(v0[2] * bflo(g.y), v0[3] * bfhi(g.y));
                    w.z = cvt_pk_bf16(v1[0] * bflo(g.z), v1[1] * bfhi(g.z)); w.w = cvt_pk_bf16(v1[2] * bflo(g.w), v1[3] * bfhi(g.w));
                    *(u32x4*)((char*)O + (unsigned)((row0 + ai * HALF + m * 16) * 1024 + col0 + bj * HALF) * 2u) = w; }
        }
    }
};
}

__device__ __forceinline__ void rn_load(const Ctx p, bool first, int row, int lane, int ns, float4 (&x)[4], float4 (&y)[4]) {
    const float* src = first ? (row < MP ? p.in(0) + (size_t)row * DM : p.in(1) + (size_t)(row - MP) * DM) : p.out() + (size_t)row * DM;
#pragma unroll
    for (int j = 0; j < 4; ++j) x[j] = *(const float4*)(src + lane * 4 + 256 * j);
    if (!first) {
#pragma unroll
        for (int j = 0; j < 4; ++j) {
            if (row < MP) { const u32x2 yw = *(const u32x2*)((const u16*)(p.ws() + RC) + (size_t)row * DM + lane * 4 + 256 * j); y[j].x = bflo(yw.x); y[j].y = bfhi(yw.x); y[j].z = bflo(yw.y); y[j].w = bfhi(yw.y); }
            else { const float* yp = (const float*)(p.ws() + RYP) + (size_t)(row - MP) * DM + lane * 4 + 256 * j; y[j] = *(const float4*)yp;
                for (int q = 1; q < ns; ++q) { const float4 t = *(const float4*)(yp + (size_t)q * 512 * 1024); y[j].x += t.x; y[j].y += t.y; y[j].z += t.z; y[j].w += t.w; } } }
    }
}
__device__ __forceinline__ void rownorm_phase(const Ctx p, bool first, float coef, const float* gpost, const float* gpre, bool write_xn, int ns) {
    float* X = p.out(); u16* XN = (u16*)(p.ws() + RA);
    const int tid_ = otid(); const int lane = tid_ & 63, wid = tid_ >> 6;
    float4 gp[4], gq[4];
#pragma unroll
    for (int j = 0; j < 4; ++j) { gq[j] = *(const float4*)(gpre + lane * 4 + 256 * j); gp[j] = first ? gq[j] : *(const float4*)(gpost + lane * 4 + 256 * j); }
    const int stride = ogdim() * 8;
    int row = obid() * 8 + wid;
    float4 x[4], y[4];
    if (row < MROWS) rn_load(p, first, row, lane, ns, x, y);
    for (; row < MROWS; row += stride) {
        float4 xn[4], yn[4];
        if (row + stride < MROWS) rn_load(p, first, row + stride, lane, ns, xn, yn);
        if (!first) {
            float ss = 0.f;
#pragma unroll
            for (int j = 0; j < 4; ++j) ss += y[j].x * y[j].x + y[j].y * y[j].y + y[j].z * y[j].z + y[j].w * y[j].w;
            ss = wave_sum(ss);
            const float r = coef * rsqrtf(ss * (1.0f / DM) + EPS);
#pragma unroll
            for (int j = 0; j < 4; ++j) { x[j].x += r * y[j].x * gp[j].x; x[j].y += r * y[j].y * gp[j].y; x[j].z += r * y[j].z * gp[j].z; x[j].w += r * y[j].w * gp[j].w; }
        }
#pragma unroll
        for (int j = 0; j < 4; ++j) *(float4*)(X + (size_t)row * DM + lane * 4 + 256 * j) = x[j];
        if (write_xn) {
            float ss = 0.f;
#pragma unroll
            for (int j = 0; j < 4; ++j) ss += x[j].x * x[j].x + x[j].y * x[j].y + x[j].z * x[j].z + x[j].w * x[j].w;
            ss = wave_sum(ss);
            const float r = rsqrtf(ss * (1.0f / DM) + EPS);
#pragma unroll
            for (int j = 0; j < 4; ++j) { u32x2 w; w.x = cvt_pk_bf16(x[j].x * r * gq[j].x, x[j].y * r * gq[j].y); w.y = cvt_pk_bf16(x[j].z * r * gq[j].z, x[j].w * r * gq[j].w);
                *(u32x2*)(XN + (size_t)row * DM + lane * 4 + 256 * j) = w; }
        }
#pragma unroll
        for (int j = 0; j < 4; ++j) { x[j] = xn[j]; y[j] = yn[j]; }
    }
}

#define MFMA16(a, b, c) __builtin_amdgcn_mfma_f32_16x16x32_bf16((a), (b), (c), 0, 0, 0)
__device__ __forceinline__ bf16x8 ldsfrag(const LAS u16* base, int row, int ld, int k) { return *(const LAS bf16x8*)(base + row * ld + k); }

__device__ __forceinline__ void convert_mat(LAS unsigned char* lds, int rank, int nwork, const float* src, int ld, u16* dst, int K, int N, bool gu_map, int dld = 0) {
    if (dld == 0) dld = K;
    LAS float* tile = (LAS float*)lds;
    const int tid = otid(), nkt = K >> 6, ntiles = nkt * (N >> 6);
    const int kk = tid >> 4, c4 = (tid & 15) * 4, n = tid >> 3, ks = (tid & 7) * 8;
    float4 v0, v1;
    auto tile_src = [&](int t) -> const float* { const int kt = t % nkt, nd0 = (t / nkt) * 64; int sc0 = nd0;
        if (gu_map) { const int pb = nd0 >> 8, h = (nd0 >> 7) & 1, j = nd0 & 127; sc0 = h * DFF + 128 * pb + j; }
        return src + (size_t)(kt * 64 + kk) * ld + sc0 + c4; };
    int t = rank, it = 0;
    if (t < ntiles) { const float* sp = tile_src(t); v0 = *(const float4*)sp; v1 = *(const float4*)(sp + (size_t)32 * ld); }
    for (; t < ntiles; t += nwork, ++it) {
        LAS float* tb = tile + (it & 1) * 4160;
        { LAS float* tp = tb + kk * 65 + c4; tp[0] = v0.x; tp[1] = v0.y; tp[2] = v0.z; tp[3] = v0.w; tp += 32 * 65; tp[0] = v1.x; tp[1] = v1.y; tp[2] = v1.z; tp[3] = v1.w; }
        if (t + nwork < ntiles) { const float* sp = tile_src(t + nwork); v0 = *(const float4*)sp; v1 = *(const float4*)(sp + (size_t)32 * ld); }
        __syncthreads();
        const int kt = t % nkt, nd0 = (t / nkt) * 64;
        float e[8];
#pragma unroll
        for (int i = 0; i < 8; ++i) e[i] = tb[(ks + i) * 65 + n];
        u32x4 w; w.x = cvt_pk_bf16(e[0], e[1]); w.y = cvt_pk_bf16(e[2], e[3]); w.z = cvt_pk_bf16(e[4], e[5]); w.w = cvt_pk_bf16(e[6], e[7]);
        *(u32x4*)(dst + (size_t)(nd0 + n) * dld + kt * 64 + ks) = w;
    }
    __syncthreads();
}
__device__ __forceinline__ void convert_ffn(const Ctx p, LAS unsigned char* lds, int rank, int nwork, const float* wgu, const float* wdn, size_t dstoff) {
    convert_mat(lds, rank, nwork, wgu, NGU, (u16*)(p.ws() + dstoff), 1024, NGU, true);
    convert_mat(lds, rank, nwork, wdn, 1024, (u16*)(p.ws() + dstoff + (RWF_DN - RWF)), DFF, 1024, false);
}
__device__ __forceinline__ void fuse_pool_unit(const Ctx p, LAS unsigned char* lds, int l, int unit) {
    const int tid = otid(), wid = tid >> 6, lane = tid & 63, fr = lane & 15, fq = lane >> 4;
    const int g = unit >> 3, nb = unit & 7;
    LAS u16* Xt = (LAS u16*)lds; LAS u16* Yl = (LAS u16*)(lds + 34816);
    constexpr int LD = 136;
    const float* wb = p.in(15) + (size_t)l * 1536 * 1024 + (size_t)(512 + g * 128) * 1024 + nb * 128;
    const float* pw = p.in(11) + ((size_t)l * 4 + g) * 16384;
    const float* sc = p.in(12) + l * 512 + g * 128;
#pragma unroll
    for (int i = 0; i < 8; ++i) { const int e = tid + i * 512, d = e >> 5, n4 = (e & 31) * 4; const float4 v = *(const float4*)(wb + (size_t)d * 1024 + n4);
        Xt[(n4 + 0) * LD + d] = f2bf(v.x); Xt[(n4 + 1) * LD + d] = f2bf(v.y); Xt[(n4 + 2) * LD + d] = f2bf(v.z); Xt[(n4 + 3) * LD + d] = f2bf(v.w); }
#pragma unroll
    for (int i = 0; i < 8; ++i) { const int e = tid + i * 512, c = e >> 5, d4 = (e & 31) * 4; const float4 v = *(const float4*)(pw + c * 128 + d4); const float4 s4 = *(const float4*)(sc + d4);
        u32x2 w; w.x = cvt_pk_bf16(v.x * s4.x, v.y * s4.y); w.y = cvt_pk_bf16(v.z * s4.z, v.w * s4.w); *(LAS u32x2*)(Yl + c * LD + d4) = w; }
    __syncthreads();
    f32x4 acc[8];
#pragma unroll
    for (int n = 0; n < 8; ++n) acc[n] = (f32x4){0.f, 0.f, 0.f, 0.f};
#pragma unroll
    for (int ks = 0; ks < 4; ++ks) { const bf16x8 a = ldsfrag(Xt, wid * 16 + fr, LD, ks * 32 + fq * 8);
#pragma unroll
        for (int n = 0; n < 8; ++n) acc[n] = MFMA16(a, ldsfrag(Yl, n * 16 + fr, LD, ks * 32 + fq * 8), acc[n]); }
    u16* dst = (u16*)(p.ws() + RWM_BR);
#pragma unroll
    for (int j = 0; j < 4; ++j) { const int n = nb * 128 + wid * 16 + fq * 4 + j;
#pragma unroll
        for (int c8 = 0; c8 < 8; ++c8) dst[(size_t)n * 1536 + 512 + g * 128 + c8 * 16 + fr] = f2bf(acc[c8][j]); }
    __syncthreads();
}
__device__ __forceinline__ void convert_mix(const Ctx p, LAS unsigned char* lds, int rank, int nwork, int l) {
    convert_mat(lds, rank, nwork, p.in(7) + (size_t)l * 1024 * NIN, NIN, (u16*)(p.ws() + RWM), 1024, NIN, false);
    convert_mat(lds, rank, nwork, p.in(15) + (size_t)l * 1536 * 1024, 1024, (u16*)(p.ws() + RWM_BR), 512, 1024, false, 1536);
    convert_mat(lds, rank, nwork, p.in(15) + (size_t)l * 1536 * 1024 + (size_t)1024 * 1024, 1024, (u16*)(p.ws() + RWM_BR) + 1024, 512, 1024, false, 1536);
    convert_mat(lds, rank, nwork, p.in(16) + (size_t)l * 1024 * 1024, 1024, (u16*)(p.ws() + RWM_OUT), 1024, 1024, false);
    { const int c2 = nwork - 1 - rank; if (c2 < 32) fuse_pool_unit(p, lds, l, c2); }
}


__device__ __forceinline__ void gmlp_unit(const Ctx p, LAS unsigned char* lds, int l, int unit, int wrf = 1) {
    const int tid = otid(), wid = tid >> 6, lane = tid & 63, fr = lane & 15, fq = lane >> 4;
    int row0, L, h, bs = -1;
    if (unit < 1024) { row0 = (unit >> 2) * 128; h = unit & 3; L = 128; } else { const int s = unit - 1024; bs = s >> 2; h = s & 3; row0 = MP + bs * 64; L = 64; }
    u16* U = (u16*)(p.ws() + RB); const u16* V = (const u16*)(p.ws() + RB + COLB);
    LAS float* rs = (LAS float*)lds; LAS u16* Vt = (LAS u16*)(lds + 1024); LAS u16* Wl = (LAS u16*)(lds + 35840);
    constexpr int LD = 136;
    const int srow = tid >> 2, part = tid & 3;
    u32x4 sv[16];
    if (srow < L) {
#pragma unroll
        for (int i = 0; i < 16; ++i) sv[i] = *(const u32x4*)(V + (size_t)(row0 + srow) * 512 + part * 128 + i * 8);
    }
    const int vs = tid & 127, cg4 = tid >> 7;
    u32x4 hv[4]; float4 vgv[8];
    if (vs < L) {
#pragma unroll
        for (int i = 0; i < 4; ++i) hv[i] = *(const u32x4*)(V + (size_t)(row0 + vs) * 512 + h * 128 + cg4 * 32 + i * 8);
    }
    { const float* vg = p.in(8) + l * 512 + h * 128 + cg4 * 32;
#pragma unroll
        for (int i = 0; i < 8; ++i) vgv[i] = *(const float4*)(vg + i * 4); }
    const int wt = tid >> 2, sq = (tid & 3) * 32;
    float4 wv[8];
    if (wt < L) { const float* wp = p.in(9) + ((size_t)(l * 4 + h) * 128 + wt) * 128 + sq;
#pragma unroll
        for (int i = 0; i < 8; ++i) wv[i] = *(const float4*)(wp + i * 4); }
    {
        float ss = 0.f;
        if (srow < L) {
#pragma unroll
            for (int i = 0; i < 16; ++i) { const u32x4 w = sv[i];
                float a; a = bflo(w.x); ss += a * a; a = bfhi(w.x); ss += a * a; a = bflo(w.y); ss += a * a; a = bfhi(w.y); ss += a * a;
                a = bflo(w.z); ss += a * a; a = bfhi(w.z); ss += a * a; a = bflo(w.w); ss += a * a; a = bfhi(w.w); ss += a * a; }
        }
        ss += __shfl_xor(ss, 1); ss += __shfl_xor(ss, 2);
        if (part == 0 && srow < L) rs[srow] = rsqrtf(ss * (1.0f / 512.0f) + EPS);
    }
    {
        if (wt < L) {
#pragma unroll
            for (int i = 0; i < 4; ++i) { const float4 a = wv[2 * i], b = wv[2 * i + 1]; const int s0 = sq + i * 8, t = wt;
                u32x4 w; w.x = cvt_pk_bf16(s0 + 0 <= t ? a.x : 0.f, s0 + 1 <= t ? a.y : 0.f); w.y = cvt_pk_bf16(s0 + 2 <= t ? a.z : 0.f, s0 + 3 <= t ? a.w : 0.f);
                w.z = cvt_pk_bf16(s0 + 4 <= t ? b.x : 0.f, s0 + 5 <= t ? b.y : 0.f); w.w = cvt_pk_bf16(s0 + 6 <= t ? b.z : 0.f, s0 + 7 <= t ? b.w : 0.f);
                *(LAS u32x4*)(Wl + t * LD + s0) = w; } }
    }
    __syncthreads();
    {
        if (vs < L) {
            const float r = rs[vs];
            float* vout = bs >= 0 ? p.out() + O_VS + ((size_t)(l * 8 + bs) * 64 + vs) * 512 + h * 128 + cg4 * 32 : nullptr;
#pragma unroll
            for (int i = 0; i < 4; ++i) { const u32x4 w = hv[i];
                const float e[8] = {bflo(w.x), bfhi(w.x), bflo(w.y), bfhi(w.y), bflo(w.z), bfhi(w.z), bflo(w.w), bfhi(w.w)};
                const float gz[8] = {vgv[2 * i].x, vgv[2 * i].y, vgv[2 * i].z, vgv[2 * i].w, vgv[2 * i + 1].x, vgv[2 * i + 1].y, vgv[2 * i + 1].z, vgv[2 * i + 1].w};
                float vv[8];
#pragma unroll
                for (int j = 0; j < 8; ++j) { vv[j] = e[j] * r * gz[j]; Vt[(cg4 * 32 + i * 8 + j) * LD + vs] = f2bf(vv[j]); }
                if (vout) { *(float4*)(vout + i * 8) = (float4){vv[0], vv[1], vv[2], vv[3]}; *(float4*)(vout + i * 8 + 4) = (float4){vv[4], vv[5], vv[6], vv[7]}; } }
        }
    }
    __syncthreads();
    if (wid * 16 < L) {
        const float* bsp = p.in(10) + (l * 4 + h) * 128;
        u16 uv[4][8]; float bias[4];
#pragma unroll
        for (int j = 0; j < 4; ++j) { const int t = wid * 16 + fq * 4 + j; bias[j] = bsp[t];
#pragma unroll
            for (int n = 0; n < 8; ++n) uv[j][n] = U[(size_t)(row0 + t) * 512 + h * 128 + n * 16 + fr]; }
        f32x4 acc[8];
#pragma unroll
        for (int n = 0; n < 8; ++n) acc[n] = (f32x4){0.f, 0.f, 0.f, 0.f};
        const int kmax = (wid * 16 + 15) / 32 + 1;
        for (int ks = 0; ks < kmax; ++ks) { const bf16x8 a = ldsfrag(Wl, wid * 16 + fr, LD, ks * 32 + fq * 8);
#pragma unroll
            for (int n = 0; n < 8; ++n) acc[n] = MFMA16(a, ldsfrag(Vt, n * 16 + fr, LD, ks * 32 + fq * 8), acc[n]); }
#pragma unroll
        for (int j = 0; j < 4; ++j) { const int t = wid * 16 + fq * 4 + j;
#pragma unroll
            for (int n = 0; n < 8; ++n) { const u16 ov = f2bf(bf2f(uv[j][n]) * (acc[n][j] + bias[j])); if (wrf) U[(size_t)(row0 + t) * 512 + h * 128 + n * 16 + fr] = ov; } }
    }
    __syncthreads();
}

__device__ __forceinline__ float hgrn_lb(const float* lbp, int l, int c) {
    const float x0 = lbp[c], x1 = lbp[512 + c], x2 = lbp[1024 + c], x3 = lbp[1536 + c];
    const float m = fmaxf(fmaxf(x0, x1), fmaxf(x2, x3));
    const float e0 = __expf(x0 - m), e1 = __expf(x1 - m), e2 = __expf(x2 - m), e3 = __expf(x3 - m);
    float num = 0.f; if (l >= 1) num += e1; if (l >= 2) num += e2; if (l >= 3) num += e3;
    return num / (e0 + e1 + e2 + e3);
}
__device__ __forceinline__ int chunk_row0(int cq) { return cq < 512 ? cq * 64 : MP + (cq - 512) * 64; }

struct HaIn { u16 z[16]; u32x4 v[2]; float lbx[4]; };
__device__ __forceinline__ void ha_load(const Ctx p, int unit, HaIn& L) {
    const int tid = otid();
    const int cq = unit >> 2, h = unit & 3, row0 = chunk_row0(cq);
    const u16* F = (const u16*)(p.ws() + RB + 4 * COLB); const u16* I = (const u16*)(p.ws() + RB + 5 * COLB);
    const int k = tid & 127, seg = tid >> 7;
    { const float* lbp = p.in(13) + h * 128 + k; L.lbx[0] = lbp[0]; L.lbx[1] = lbp[512]; L.lbx[2] = lbp[1024]; L.lbx[3] = lbp[1536]; }
#pragma unroll
    for (int i = 0; i < 16; ++i) L.z[i] = F[(size_t)(row0 + seg * 16 + i) * 512 + h * 128 + k];
    { const int s = tid & 63, cg = tid >> 6;
#pragma unroll
        for (int i = 0; i < 2; ++i) L.v[i] = *(const u32x4*)(I + (size_t)(row0 + s) * 512 + h * 128 + cg * 16 + i * 8); }
}
__device__ __forceinline__ void hgrn_a_unit(const Ctx p, LAS unsigned char* lds, int l, int unit, int next_unit, HaIn& L) {
    const int tid = otid(), wid = tid >> 6, lane = tid & 63, fr = lane & 15, fq = lane >> 4;
    u16* St = (u16*)(p.ws() + RA) + (size_t)unit * 16384; float* dcy = (float*)(p.ws() + RSM) + (size_t)unit * 128;
    LAS float* segtot = (LAS float*)lds; LAS u16* Kt = (LAS u16*)(lds + 4096); LAS u16* Vt = (LAS u16*)(lds + 22528);
    constexpr int LD = 72;
    const int k = tid & 127, seg = tid >> 7;
    float lb;
    { const float x0 = L.lbx[0], x1 = L.lbx[1], x2 = L.lbx[2], x3 = L.lbx[3]; const float m = fmaxf(fmaxf(x0, x1), fmaxf(x2, x3));
      const float e0 = __expf(x0 - m), e1 = __expf(x1 - m), e2 = __expf(x2 - m), e3 = __expf(x3 - m);
      float num = 0.f; if (l >= 1) num += e1; if (l >= 2) num += e2; if (l >= 3) num += e3; lb = num / (e0 + e1 + e2 + e3); }
    float lf[16], kk[16]; float run = 0.f;
#pragma unroll
    for (int i = 0; i < 16; ++i) { const float z = (float)__builtin_bit_cast(_Float16, L.z[i]);
        const float sg = fsig(z); const float f = lb + (1.0f - lb) * sg; kk[i] = 1.0f - f; run += __logf(fmaxf(f, 1e-30f)); lf[i] = run; }
    segtot[seg * 128 + k] = run;
    { const int s = tid & 63, cg = tid >> 6;
#pragma unroll
        for (int i = 0; i < 2; ++i) { const u32x4 w = L.v[i]; LAS u16* vp = Vt + (cg * 16 + i * 8) * LD + s;
            vp[0] = (u16)(w.x & 0xffff); vp[LD] = (u16)(w.x >> 16); vp[2 * LD] = (u16)(w.y & 0xffff); vp[3 * LD] = (u16)(w.y >> 16);
            vp[4 * LD] = (u16)(w.z & 0xffff); vp[5 * LD] = (u16)(w.z >> 16); vp[6 * LD] = (u16)(w.w & 0xffff); vp[7 * LD] = (u16)(w.w >> 16); } }
    if (next_unit < 2080) ha_load(p, next_unit, L);
    __syncthreads();
    { const float t0 = segtot[k], t1 = segtot[128 + k], t2 = segtot[256 + k], t3 = segtot[384 + k];
        const float off = seg == 0 ? 0.f : (seg == 1 ? t0 : (seg == 2 ? t0 + t1 : t0 + t1 + t2)); const float blast = t0 + t1 + t2 + t3;
#pragma unroll
        for (int i = 0; i < 16; ++i) Kt[k * LD + seg * 16 + i] = f2bf(kk[i] * __expf(blast - (off + lf[i])));
        if (seg == 0) dcy[k] = __expf(blast); }
    __syncthreads();
    { f32x4 acc[8];
#pragma unroll
        for (int n = 0; n < 8; ++n) acc[n] = (f32x4){0.f, 0.f, 0.f, 0.f};
#pragma unroll
        for (int ks = 0; ks < 2; ++ks) { const bf16x8 a = ldsfrag(Kt, wid * 16 + fr, LD, ks * 32 + fq * 8);
#pragma unroll
            for (int n = 0; n < 8; ++n) acc[n] = MFMA16(a, ldsfrag(Vt, n * 16 + fr, LD, ks * 32 + fq * 8), acc[n]); }
#pragma unroll
        for (int n = 0; n < 8; ++n) { u32x2 w; w.x = cvt_pk_bf16(acc[n][0], acc[n][1]); w.y = cvt_pk_bf16(acc[n][2], acc[n][3]);
            *(u32x2*)(St + (size_t)(n * 16 + fr) * 128 + wid * 16 + fq * 4) = w; } }
    __syncthreads();
}

__device__ __forceinline__ void hgrn_scan_phase(const Ctx p, int l, int wrf = 1) {
    u16* SR = (u16*)(p.ws() + RA); const float* dcy = (const float*)(p.ws() + RSM);
    const int gtid = obid() * 512 + otid(), gsz = ogdim() * 512;
    for (int e = gtid; e < 8 * 16384; e += gsz) {
        const int seq = e >> 14, el = e & 16383, b = seq >> 2, h = seq & 3, k = el & 127, v = el >> 7;
        u16* sp = SR + ((size_t)(b * 256) * 4 + h) * 16384 + el; const float* dp = dcy + ((size_t)(b * 256) * 4 + h) * 128 + k;
        float st = 0.f;
        for (int n0 = 0; n0 < 256; n0 += 16) {
            float uu[16], dd[16];
#pragma unroll
            for (int j = 0; j < 16; ++j) { uu[j] = bf2f(sp[(size_t)(n0 + j) * 65536]); dd[j] = dp[(size_t)(n0 + j) * 512]; }
#pragma unroll
            for (int j = 0; j < 16; ++j) { if (wrf) sp[(size_t)(n0 + j) * 65536] = f2bf(st); st = dd[j] * st + uu[j]; }
        }
        if (wrf) p.out()[O_HGP + ((size_t)(l * 2 + b) * 4 + h) * 16384 + k * 128 + v] = st;
    }
    for (int e = gtid; e < 32 * 16384; e += gsz) {
        const int bh = e >> 14, el = e & 16383, k = el & 127, v = el >> 7;
        u16* sp = SR + ((size_t)(512 * 4) + bh) * 16384 + el;
        const float s0 = p.in(3)[((size_t)l * 32 + bh) * 16384 + k * 128 + v];
        const float uu = bf2f(*sp), dd = dcy[((size_t)(512 * 4) + bh) * 128 + k];
        if (wrf) *sp = f2bf(s0);
        if (wrf) p.out()[O_HGS + ((size_t)l * 32 + bh) * 16384 + k * 128 + v] = dd * s0 + uu;
    }
}

struct HcIn { u16 z[16]; u32x4 v[2], st[4]; float lbx[4]; };
__device__ __forceinline__ void hc_load(const Ctx p, int l, int unit, HcIn& L) {
    const int tid = otid();
    const int cq = unit >> 2, h = unit & 3, row0 = chunk_row0(cq);
    const u16* F = (const u16*)(p.ws() + RB + 4 * COLB); const u16* I = (const u16*)(p.ws() + RB + 5 * COLB);
    const u16* St = (const u16*)(p.ws() + RA) + (size_t)unit * 16384;
    const int k = tid & 127, seg = tid >> 7;
    { const float* lbp = p.in(13) + h * 128 + k; L.lbx[0] = lbp[0]; L.lbx[1] = lbp[512]; L.lbx[2] = lbp[1024]; L.lbx[3] = lbp[1536]; }
#pragma unroll
    for (int i = 0; i < 16; ++i) L.z[i] = F[(size_t)(row0 + seg * 16 + i) * 512 + h * 128 + k];
    { const int s = tid & 63, cg = tid >> 6;
#pragma unroll
        for (int i = 0; i < 2; ++i) L.v[i] = *(const u32x4*)(I + (size_t)(row0 + s) * 512 + h * 128 + cg * 16 + i * 8); }
#pragma unroll
    for (int i = 0; i < 4; ++i) { const int c = tid + i * 512, r = c >> 4, cc = (c & 15) * 8; L.st[i] = *(const u32x4*)(St + r * 128 + cc); }
}
__device__ __forceinline__ void hgrn_c_unit(const Ctx p, LAS unsigned char* lds, int l, int unit, int next_unit, HcIn& L, int wrf = 1) {
    const int tid = otid(), wid = tid >> 6, lane = tid & 63, fr = lane & 15, fq = lane >> 4;
    const int cq = unit >> 2, h = unit & 3, row0 = chunk_row0(cq);
    u16* Q = (u16*)(p.ws() + RB + 3 * COLB); const u16* GG = (const u16*)(p.ws() + RB + 6 * COLB);
    u16 qv[16], gg[4][4]; float ogv[4];
#pragma unroll
    for (int i = 0; i < 16; ++i) qv[i] = Q[(size_t)(row0 + (tid >> 7) * 16 + i) * 512 + h * 128 + (tid & 127)];
    { const int tt = wid & 3, nh = wid >> 2; const float* og = p.in(14) + l * 128;
#pragma unroll
        for (int n = 0; n < 4; ++n) { const int v = (nh * 4 + n) * 16 + fr; ogv[n] = og[v];
#pragma unroll
            for (int j = 0; j < 4; ++j) gg[j][n] = GG[(size_t)(row0 + tt * 16 + fq * 4 + j) * 512 + h * 128 + v]; } }
    LAS float* segtot = (LAS float*)lds; LAS float* red = (LAS float*)(lds + 2560);
    LAS u16* Qi = (LAS u16*)(lds + 4096); LAS u16* Qh = (LAS u16*)(lds + 21504); LAS u16* Kh = (LAS u16*)(lds + 38912);
    LAS u16* Vt = (LAS u16*)(lds + 56320); LAS u16* Sl = (LAS u16*)(lds + 74752); LAS u16* P = (LAS u16*)(lds + 109568);
    constexpr int LDK = 136, LDS_ = 72;
    const int k = tid & 127, seg = tid >> 7;
    float lb;
    { const float x0 = L.lbx[0], x1 = L.lbx[1], x2 = L.lbx[2], x3 = L.lbx[3]; const float m = fmaxf(fmaxf(x0, x1), fmaxf(x2, x3));
      const float e0 = __expf(x0 - m), e1 = __expf(x1 - m), e2 = __expf(x2 - m), e3 = __expf(x3 - m);
      float num = 0.f; if (l >= 1) num += e1; if (l >= 2) num += e2; if (l >= 3) num += e3; lb = num / (e0 + e1 + e2 + e3); }
    float lf[16], kk[16]; float run = 0.f;
#pragma unroll
    for (int i = 0; i < 16; ++i) { const float z = (float)__builtin_bit_cast(_Float16, L.z[i]);
        const float sg = fsig(z); const float f = lb + (1.0f - lb) * sg; kk[i] = 1.0f - f; run += __logf(fmaxf(f, 1e-30f)); lf[i] = run; }
    segtot[seg * 128 + k] = run;
    { const int s = tid & 63, cg = tid >> 6;
#pragma unroll
        for (int i = 0; i < 2; ++i) { const u32x4 w = L.v[i]; LAS u16* vp = Vt + (cg * 16 + i * 8) * LDS_ + s;
            vp[0] = (u16)(w.x & 0xffff); vp[LDS_] = (u16)(w.x >> 16); vp[2 * LDS_] = (u16)(w.y & 0xffff); vp[3 * LDS_] = (u16)(w.y >> 16);
            vp[4 * LDS_] = (u16)(w.z & 0xffff); vp[5 * LDS_] = (u16)(w.z >> 16); vp[6 * LDS_] = (u16)(w.w & 0xffff); vp[7 * LDS_] = (u16)(w.w >> 16); } }
#pragma unroll
    for (int i = 0; i < 4; ++i) { const int c = tid + i * 512, r = c >> 4, cc = (c & 15) * 8; *(LAS u32x4*)(Sl + r * LDK + cc) = L.st[i]; }
    if (next_unit < 2080) hc_load(p, l, next_unit, L);
    __syncthreads();
    { const float t0 = segtot[k], t1 = segtot[128 + k], t2 = segtot[256 + k];
        const float off = seg == 0 ? 0.f : (seg == 1 ? t0 : (seg == 2 ? t0 + t1 : t0 + t1 + t2)); const float bref = t0 + t1;
#pragma unroll
        for (int i = 0; i < 16; ++i) { const int s = seg * 16 + i; const float b = off + lf[i]; const float q = bf2f(qv[i]);
            Qi[s * LDK + k] = f2bf(q * __expf(b)); Qh[s * LDK + k] = f2bf(q * __expf(b - bref)); Kh[s * LDK + k] = f2bf(kk[i] * __expf(bref - b)); } }
    __syncthreads();
    {
        const int tt = wid >> 1;
#pragma unroll
        for (int q2 = 0; q2 < 2; ++q2) { const int stl = (wid & 1) * 2 + q2; f32x4 acc = (f32x4){0.f, 0.f, 0.f, 0.f};
            if (stl <= tt) {
#pragma unroll
                for (int ks = 0; ks < 4; ++ks) acc = MFMA16(ldsfrag(Qh, tt * 16 + fr, LDK, ks * 32 + fq * 8), ldsfrag(Kh, stl * 16 + fr, LDK, ks * 32 + fq * 8), acc); }
#pragma unroll
            for (int j = 0; j < 4; ++j) { const int t = tt * 16 + fq * 4 + j, s = stl * 16 + fr; P[t * LDS_ + s] = (stl <= tt && s <= t) ? f2bf(acc[j]) : (u16)0; } }
    }
    __syncthreads();
    { const int tt = wid & 3, nh = wid >> 2; f32x4 acc[4];
#pragma unroll
        for (int n = 0; n < 4; ++n) acc[n] = (f32x4){0.f, 0.f, 0.f, 0.f};
#pragma unroll
        for (int ks = 0; ks < 4; ++ks) { const bf16x8 a = ldsfrag(Qi, tt * 16 + fr, LDK, ks * 32 + fq * 8);
#pragma unroll
            for (int n = 0; n < 4; ++n) acc[n] = MFMA16(a, ldsfrag(Sl, (nh * 4 + n) * 16 + fr, LDK, ks * 32 + fq * 8), acc[n]); }
#pragma unroll
        for (int ks = 0; ks < 2; ++ks) { const bf16x8 a = ldsfrag(P, tt * 16 + fr, LDS_, ks * 32 + fq * 8);
#pragma unroll
            for (int n = 0; n < 4; ++n) acc[n] = MFMA16(a, ldsfrag(Vt, (nh * 4 + n) * 16 + fr, LDS_, ks * 32 + fq * 8), acc[n]); }
        float ssq[4];
#pragma unroll
        for (int j = 0; j < 4; ++j) { float s = 0.f;
#pragma unroll
            for (int n = 0; n < 4; ++n) s += acc[n][j] * acc[n][j];
            s += __shfl_xor(s, 1); s += __shfl_xor(s, 2); s += __shfl_xor(s, 4); s += __shfl_xor(s, 8); ssq[j] = s; }
        if (fr == 0) {
#pragma unroll
            for (int j = 0; j < 4; ++j) red[nh * 64 + tt * 16 + fq * 4 + j] = ssq[j]; }
        __syncthreads();
#pragma unroll
        for (int j = 0; j < 4; ++j) { const int t = tt * 16 + fq * 4 + j; const float r = rsqrtf((red[t] + red[64 + t]) * (1.0f / 128.0f) + EPS);
#pragma unroll
            for (int n = 0; n < 4; ++n) { const int v = (nh * 4 + n) * 16 + fr; const size_t idx = (size_t)(row0 + t) * 512 + h * 128 + v;
                const u16 ov = f2bf(acc[n][j] * r * ogv[n] * bf2f(gg[j][n])); if (wrf) Q[idx] = ov; } }
    }
    __syncthreads();
}

template <int W> __device__ __forceinline__ void pool_rows(const u32x4 (&x)[31], int t0q, int nvalid, u16* ob) {
    float s[8];
#pragma unroll
    for (int e = 0; e < 8; ++e) s[e] = 0.f;
#pragma unroll
    for (int j = 16 - W; j < 15; ++j) { const u32x4 v = x[j]; s[0] += bflo(v.x); s[1] += bfhi(v.x); s[2] += bflo(v.y); s[3] += bfhi(v.y); s[4] += bflo(v.z); s[5] += bfhi(v.z); s[6] += bflo(v.w); s[7] += bfhi(v.w); }
#pragma unroll
    for (int i = 0; i < 16; ++i) { const u32x4 v = x[15 + i]; const float xv[8] = {bflo(v.x), bfhi(v.x), bflo(v.y), bfhi(v.y), bflo(v.z), bfhi(v.z), bflo(v.w), bfhi(v.w)};
        const int avail = t0q + i + 1 + nvalid; const float rc = 1.0f / (float)(avail < W ? avail : W);
        float o[8];
#pragma unroll
        for (int e = 0; e < 8; ++e) { s[e] += xv[e]; o[e] = s[e] * rc - xv[e]; }
        u32x4 w; w.x = cvt_pk_bf16(o[0], o[1]); w.y = cvt_pk_bf16(o[2], o[3]); w.z = cvt_pk_bf16(o[4], o[5]); w.w = cvt_pk_bf16(o[6], o[7]);
        *(u32x4*)(ob + (size_t)i * 512) = w;
        const u32x4 r = x[15 + i - (W - 1)];
        s[0] -= bflo(r.x); s[1] -= bfhi(r.x); s[2] -= bflo(r.y); s[3] -= bfhi(r.y); s[4] -= bflo(r.z); s[5] -= bfhi(r.z); s[6] -= bflo(r.w); s[7] -= bfhi(r.w); }
}
__device__ __forceinline__ void pool_pass(const Ctx p, int l) {
    const int tid = otid(), lane = tid & 63, cgp = lane & 15, rq = lane >> 4;
    const u16* XB = (const u16*)(p.ws() + RB + 2 * COLB); u16* OB = (u16*)(p.ws() + RB + COLB);
    const int u0 = obid() * 8 + (tid >> 6), ustride = ogdim() * 8;
    for (int unit = u0; unit < NCH64 * 4; unit += ustride) {
        const int cq = unit >> 2, g = unit & 3, row0 = chunk_row0(cq);
        const bool samp = cq >= 512; const int bs = cq - 512; const int t0 = samp ? 0 : (cq & 255) * 64;
        const int t0q = t0 + rq * 16;
        const int col = g * 128 + cgp * 8;
        u32x4 x[31];
#pragma unroll
        for (int j = 0; j < 31; ++j) { const int tk = t0q - 15 + j;
            if (tk >= 0) x[j] = *(const u32x4*)(XB + (size_t)(row0 + rq * 16 - 15 + j) * 512 + col);
            else if (samp) { const float* sp = p.in(2) + ((size_t)(l * 8 + bs) * 15 + (15 + tk)) * 512 + col; const float4 a = *(const float4*)sp, b = *(const float4*)(sp + 4);
                x[j].x = cvt_pk_bf16(a.x, a.y); x[j].y = cvt_pk_bf16(a.z, a.w); x[j].z = cvt_pk_bf16(b.x, b.y); x[j].w = cvt_pk_bf16(b.z, b.w); }
            else x[j] = (u32x4){0u, 0u, 0u, 0u}; }
        u16* ob = OB + (size_t)(row0 + rq * 16) * 512 + col; const int nvalid = samp ? 15 : 0;
        if (g == 0) pool_rows<2>(x, t0q, nvalid, ob); else if (g == 1) pool_rows<4>(x, t0q, nvalid, ob); else if (g == 2) pool_rows<8>(x, t0q, nvalid, ob); else pool_rows<16>(x, t0q, nvalid, ob);
        if ((samp || t0 == 16320) && rq == 3) { float* po = (samp ? p.out() + O_POOLS + ((size_t)(l * 8 + bs) * 15) * 512 : p.out() + O_POOLP + ((size_t)(l * 2 + (cq >> 8)) * 15) * 512) + col;
#pragma unroll
            for (int j = 0; j < 15; ++j) { const u32x4 v = x[16 + j]; float* q = po + (size_t)j * 512;
                *(float4*)q = (float4){bflo(v.x), bfhi(v.x), bflo(v.y), bfhi(v.y)}; *(float4*)(q + 4) = (float4){bflo(v.z), bfhi(v.z), bflo(v.w), bfhi(v.w)}; } }
    }
}

#define XB_TMO      128
#define XB_XCNT(j)  (256  + 64 * (j))
#define XB_XSUB(j)  (1280 + 64 * (j))
#define XB_XGEN(j)  (2304 + 64 * (j))
#define XB_TOP      3328
#define XB_TOPGEN   3392
#define XCD_BAR_WORDS 3456
#define XB_SPIN_CAP (1u << 20)
__device__ __forceinline__ unsigned xb_ld(unsigned* p)              { return __hip_atomic_load(p, __ATOMIC_RELAXED, __HIP_MEMORY_SCOPE_AGENT); }
__device__ __forceinline__ unsigned xb_add(unsigned* p, unsigned v) { return __hip_atomic_fetch_add(p, v, __ATOMIC_RELAXED, __HIP_MEMORY_SCOPE_AGENT); }
__device__ __forceinline__ unsigned xb_xcc_id() { return (unsigned)__builtin_amdgcn_s_getreg((3 << 11) | 20) & 0xFu; }
#define XB_SPIN(cond, bar) do { unsigned _sp = 0; while (cond) { __builtin_amdgcn_s_sleep(1); \
    if ((++_sp & 255u) == 0u) { if (xb_ld(&(bar)[XB_TMO])) break; if (_sp > XB_SPIN_CAP) { atomicAdd(&(bar)[XB_TMO], 1u); break; } } } } while (0)
__device__ __forceinline__ void xcd_barrier_complete(unsigned* bar, unsigned x, unsigned& nloc, unsigned& nx) {
    const unsigned G = gridDim.x;
    unsigned sum, cnt, mine, sp = 0u;
    for (;;) {
        sum = 0u; cnt = 0u; mine = 0u;
#pragma unroll
        for (unsigned j = 0; j < 16; ++j) { const unsigned c = xb_ld(&bar[XB_XCNT(j)]); sum += c; cnt += (c > 0u) ? 1u : 0u; mine = (j == x) ? c : mine; }
        if (sum == G) break;
        __builtin_amdgcn_s_sleep(1);
        if ((++sp & 255u) == 0u) { if (xb_ld(&bar[XB_TMO])) break; if (sp > XB_SPIN_CAP) { atomicAdd(&bar[XB_TMO], 1u); break; } }
    }
    nloc = mine > 0u ? mine : 1u; nx = cnt > 0u ? cnt : 1u;
}
__device__ __forceinline__ void xcd_barrier(unsigned* bar, volatile LAS unsigned* st) {
    asm volatile("s_waitcnt vmcnt(0)" ::: "memory");
    __syncthreads();
    if (threadIdx.x == 0) {
        const unsigned x = xb_xcc_id();
        __builtin_amdgcn_s_waitcnt(0);
        unsigned nloc = st[0], nx = st[1];
        if (nloc == 0u) { xcd_barrier_complete(bar, x, nloc, nx); st[0] = nloc; st[1] = nx; }
        const unsigned old = xb_add(&bar[XB_XSUB(x)], 1u);
        const unsigned gen = old / nloc;
        if (old + 1u == (gen + 1u) * nloc) {
            __builtin_amdgcn_fence(__ATOMIC_RELEASE, "agent");
            asm volatile("s_waitcnt vmcnt(0)" ::: "memory");
            const unsigned og = xb_add(&bar[XB_TOP], 1u);
            const unsigned tg = og / nx;
            if (og + 1u == (tg + 1u) * nx) xb_add(&bar[XB_TOPGEN], 1u);
            else XB_SPIN(xb_ld(&bar[XB_TOPGEN]) == tg, bar);
            __builtin_amdgcn_fence(__ATOMIC_ACQUIRE, "agent");
            xb_add(&bar[XB_XGEN(x)], 1u);
            asm volatile("s_waitcnt vmcnt(0)" ::: "memory");
        } else {
            XB_SPIN(xb_ld(&bar[XB_XGEN(x)]) == gen, bar);
            __builtin_amdgcn_fence(__ATOMIC_ACQUIRE, "agent");
            asm volatile("s_waitcnt vmcnt(0)" ::: "memory");
        }
    }
    __syncthreads();
}

__global__ void __launch_bounds__(512, 2) fwd_mega(Params kp) {
    extern __shared__ __attribute__((aligned(16))) unsigned char lds_raw[];
    LAS unsigned char* lds = (LAS unsigned char*)lds_raw;
    cg::grid_group grid = cg::this_grid();
    { LAS unsigned* pw = (LAS unsigned*)(lds + 131072); const unsigned* src = (const unsigned*)&kp; if (threadIdx.x < sizeof(Params) / 4) pw[threadIdx.x] = src[threadIdx.x];
      if (threadIdx.x >= 128 && threadIdx.x < 132) pw[threadIdx.x] = 0u; }
    __syncthreads();
    volatile LAS unsigned* bst = (volatile LAS unsigned*)(lds + 131072 + 512);
    if (threadIdx.x == 0) (void)xb_add(&((unsigned*)(kp.ws + RBAR))[XB_XCNT(xb_xcc_id())], 1u);
    Ctx p; p.pl = (LAS const unsigned*)(lds + 131072);
    const int ph_lo = __builtin_amdgcn_readfirstlane(p.pl[42]), ph_hi = __builtin_amdgcn_readfirstlane(p.pl[43]);
    unsigned long long tp_prev = 0, tp_acc = 0; int tp_sel = 0;
    for (int ph = ph_lo; ph < ph_hi; ++ph) {
        if (ph > ph_lo) { if (ph == ph_lo + 1) grid.sync(); else xcd_barrier((unsigned*)(p.ws() + RBAR), bst); }
        if (TPM) { const unsigned long long now = __builtin_amdgcn_s_memrealtime(); if (tp_sel) tp_acc += now - tp_prev; tp_prev = now; tp_sel = ph == 0 ? (TPM & 1) : ((TPM >> ((ph - 1) % 13 + 1)) & 1); }
        const int G = osgpr((int)gridDim.x), c = osgpr((int)blockIdx.x);
        if (ph == 0) {
            rownorm_phase(p, true, 0.f, nullptr, p.in(4), true, 0);
            convert_ffn(p, lds, c, G, p.in(5), p.in(6), RWF);
            convert_mix(p, lds, c, G, 0);
            continue;
        }
        const int l = (ph - 1) / 13, s = (ph - 1) % 13 + 1;
        unsigned char* ws = p.ws();
        switch (s) {
        case 1: case 11: if (PHM & 1) {
            const size_t wf = s == 1 ? RWF : RWF2;
            pg8::SchedPlain S; S.o.init(MROWS / 256, NGU / 256, G, c); S.A = (const char*)(ws + RA); S.B = (const char*)(ws + wf); S.at = (size_t)256 * 1024 * 2; S.bt = (size_t)256 * 1024 * 2; S.nt = 16; S.ns = 0; S.nseg = 0; S.Asplit = nullptr;
            pg8::EpiGU E{(u16*)(ws + RB)};
            REP(0) pg8::gemm_phase(lds, 1024, 1024, 1024, S, E);
            const int extra = S.o.nwg % G;
            if (c >= extra) {
                if (s == 1) convert_ffn(p, lds, c - extra, G - extra, p.in(17) + (size_t)l * 1024 * NGU, p.in(18) + (size_t)l * DFF * 1024, RWF2);
                else if (l < DEPTH - 1) convert_mix(p, lds, c - extra, G - extra, l + 1);
            }
        } break;
        case 2: case 12: if (PHM & 2) {
            pg8::SchedPlain S; S.o.init(MP / 256, 4, G, c); S.A = (const char*)(ws + RB); S.B = (const char*)(ws + (s == 2 ? RWF : RWF2) + (RWF_DN - RWF)); S.at = (size_t)256 * DFF * 2; S.bt = (size_t)256 * DFF * 2; S.nt = DFF / 64; S.ns = 11; S.nseg = 0; S.Asplit = nullptr;
            pg8::EpiF32 E{(u16*)(ws + RC), 1024, (float*)(ws + RYP)};
            REP(1) pg8::gemm_phase(lds, DFF, DFF, DFF, S, E);
        } break;
        case 3: if (PHM & 4) { const float* gains = p.in(4) + (size_t)l * 6 * 1024; REP(11) rownorm_phase(p, false, rep_ ? 0.f : 0.5f, gains + 1024, gains + 2048, true, 11); } break;
        case 4: if (PHM & 8) {
            pg8::SchedPlain S; S.o.init(MROWS / 256, NIN / 256, G, c); S.A = (const char*)(ws + RA); S.B = (const char*)(ws + RWM); S.at = (size_t)256 * 1024 * 2; S.bt = (size_t)256 * 1024 * 2; S.nt = 16; S.ns = 0; S.nseg = 0; S.Asplit = nullptr;
            pg8::EpiIN E{(u16*)(ws + RB), (u16*)(ws + RC)};
            REP(2) pg8::gemm_phase(lds, 1024, 1024, 1024, S, E);
            const int extra = S.o.nwg % G;
            if (c >= extra && l < DEPTH - 1) convert_ffn(p, lds, c - extra, G - extra, p.in(5) + (size_t)(l + 1) * 1024 * NGU, p.in(6) + (size_t)(l + 1) * DFF * 1024, RWF);
        } break;
        case 5: { int it = c;
                    for (; it < 1056; it += G) { if (PHM & 16) REP(8) gmlp_unit(p, lds, l, it, osgpr(rep_ == 0 ? 1 : 0)); }
                    if (PHM & 32) { HaIn A; ha_load(p, it - 1056 < 2080 ? it - 1056 : 0, A);
                        for (; it < 1056 + 2080; it += G) hgrn_a_unit(p, lds, l, it - 1056, it + G - 1056, A); } } break;
        case 6: if (PHM & 64) REP(9) hgrn_scan_phase(p, l, osgpr(rep_ == 0 ? 1 : 0)); break;
        case 7: if (PHM & 128) { int it = c; HcIn A; hc_load(p, l, it < 2080 ? it : 0, A);
                    for (; it < 2080; it += G) hgrn_c_unit(p, lds, l, it, it + G, A, 1); }
                if (PHM & 256) REP(6) pool_pass(p, l); break;
        case 8: if (PHM & 512) {
            pg8::SchedPlain S; S.o.init(MP / 256, 4, G, c); S.A = (const char*)(ws + RB); S.B = (const char*)(ws + RWM_BR); S.at = (size_t)256 * 512 * 2; S.bt = (size_t)256 * 1536 * 2; S.nt = 24; S.ns = 0; S.nseg = 3; S.Asplit = nullptr;
            pg8::EpiBranch E{(const u16*)(ws + RC), (u16*)(ws + RA), (float*)(ws + RB + 2 * COLB)};
            REP(3) pg8::gemm_phase(lds, 1536, 512, 1536, S, E);
        } break;
        case 9: if (PHM & 1024) {
            if (c < 32) {
                const int tile = c >> 2, j = c & 3, pms = tile >> 2; const int tid = otid();
                const float* Pp = (const float*)(ws + RB + 2 * COLB); u16* blk = (u16*)(ws + RB + 4 * COLB + (size_t)c * (512 * 1024));
#pragma unroll 4
                for (int e = tid; e < 8192; e += 512) { const int r = e >> 5, col = j * 256 + (e & 31) * 8; const float* sp = Pp + (size_t)(pms * 256 + r) * 1024 + col;
                    float4 a = *(const float4*)sp, b = *(const float4*)(sp + 4);
#pragma unroll
                    for (int q = 1; q < 3; ++q) { const float4 a2 = *(const float4*)(sp + (size_t)q * 512 * 1024), b2 = *(const float4*)(sp + (size_t)q * 512 * 1024 + 4);
                        a.x += a2.x; a.y += a2.y; a.z += a2.z; a.w += a2.w; b.x += b2.x; b.y += b2.y; b.z += b2.z; b.w += b2.w; }
                    u32x4 w; w.x = cvt_pk_bf16(a.x, a.y); w.y = cvt_pk_bf16(a.z, a.w); w.z = cvt_pk_bf16(b.x, b.y); w.w = cvt_pk_bf16(b.z, b.w);
                    *(u32x4*)(blk + (size_t)r * 1024 + col) = w; }
                asm volatile("s_waitcnt vmcnt(0)" ::: "memory");
            }
            __syncthreads();
            pg8::SchedPlain S; S.o.init(MP / 256, 4, G, c); S.A = (const char*)(ws + RA); S.B = (const char*)(ws + RWM_OUT); S.at = (size_t)256 * 1024 * 2; S.bt = (size_t)256 * 1024 * 2; S.nt = 16; S.ns = 4; S.nseg = 0; S.Asplit = (const char*)(ws + RB + 4 * COLB);
            pg8::EpiF32 E{(u16*)(ws + RC), 1024, (float*)(ws + RYP)};
            REP(4) pg8::gemm_phase(lds, 1024, 1024, 1024, S, E);
        } break;
        case 10: { const float* gains = p.in(4) + (size_t)l * 6 * 1024; REP(11) rownorm_phase(p, false, rep_ ? 0.f : 1.0f, gains + 3 * 1024, gains + 4 * 1024, true, 4); } break;
        case 13: { const float* gains = p.in(4) + (size_t)l * 6 * 1024; REP(11) rownorm_phase(p, false, rep_ ? 0.f : 0.5f, gains + 5 * 1024, gains + (l < DEPTH - 1 ? 6 * 1024 : 0), l < DEPTH - 1, 11); } break;
        }
    }
    if (TPM) { unsigned long long now = __builtin_amdgcn_s_memrealtime(); if (tp_sel) tp_acc += now - tp_prev;
        if (blockIdx.x == 0 && threadIdx.x == 0) { const unsigned long long t0 = now; while (__builtin_amdgcn_s_memrealtime() - t0 < TMULT * tp_acc) __builtin_amdgcn_s_sleep(8); } }
}

constexpr int N_PHASES = 1 + 13 * DEPTH;

extern "C" void kernel_launch(void* const* d_in, const int* in_sizes, int n_in, void* d_out, int out_size, void* d_ws, size_t ws_size, hipStream_t stream) {
    static int grid = 0;
    if (grid == 0) {
        if (n_in != 19 || ws_size < WS_END) { fprintf(stderr, "kernel_launch: need 19 inputs and %zu bytes of workspace (got %d, %zu)\n", (size_t)WS_END, n_in, ws_size); grid = -1; return; }
        int dev = 0, cus = 0, per_cu = 0;
        hipGetDevice(&dev); hipDeviceGetAttribute(&cus, hipDeviceAttributeMultiprocessorCount, dev);
        hipFuncSetAttribute((const void*)fwd_mega, hipFuncAttributeMaxDynamicSharedMemorySize, LDS_BYTES);
        hipOccupancyMaxActiveBlocksPerMultiprocessor(&per_cu, (const void*)fwd_mega, 512, LDS_BYTES);
        if (per_cu < 1) { fprintf(stderr, "kernel_launch: occupancy query says %d blocks per CU\n", per_cu); per_cu = 1; }
        (void)hipGetLastError();
        grid = cus * per_cu;
    }
    if (grid < 0) return;
    Params p{};
    for (int i = 0; i < 19; ++i) p.in[i] = (const float*)d_in[i];
    p.out = (float*)d_out; p.ws = (unsigned char*)d_ws;
    (void)hipMemsetAsync((unsigned char*)d_ws + RBAR, 0, 3456 * 4, stream);
#if MULTI_LAUNCH
    for (int ph = 0; ph < N_PHASES; ++ph) { p.ph_lo = ph; p.ph_hi = ph + 1; hipLaunchKernelGGL(fwd_mega, dim3(grid), dim3(512), LDS_BYTES, stream, p); }
#else
    p.ph_lo = 0; p.ph_hi = N_PHASES;
    void* args[] = {&p};
    hipError_t e = hipLaunchCooperativeKernel((const void*)fwd_mega, dim3(grid), dim3(512), args, LDS_BYTES, stream);
    if (e != hipSuccess) fprintf(stderr, "cooperative launch failed: %s (grid %d)\n", hipGetErrorString(e), grid);
#endif
}
```

```cpp
#include <hip/hip_runtime.h>
#include <hip/hip_cooperative_groups.h>
#include <cstdio>
namespace cg = cooperative_groups;

#define LAS __attribute__((address_space(3)))
typedef unsigned short u16;
typedef short bf16x8 __attribute__((ext_vector_type(8)));
typedef float f32x4 __attribute__((ext_vector_type(4)));
typedef unsigned u32x4 __attribute__((ext_vector_type(4)));
typedef unsigned u32x2 __attribute__((ext_vector_type(2)));
typedef _Float16 h16x2 __attribute__((ext_vector_type(2)));

#ifndef PHM
#define PHM 0xffff
#endif
#ifndef DUP
#define DUP 0x0
#endif
#define REP(bit) for (int rep_ = 0; rep_ <= ((DUP >> (bit)) & 1); ++rep_)
#ifndef TPM
#define TPM 0
#endif
#define TMULT 4
#ifndef SPLITK
#define SPLITK 1
#endif
#ifndef USE_SP2
#define USE_SP2 1
#endif
#ifndef USE_ALIGN
#define USE_ALIGN 1
#endif
#ifndef MULTI_LAUNCH
#define MULTI_LAUNCH 0
#endif

constexpr int MROWS = 33280, MP = 32768, DM = 1024, DFF = 2816, NGU = 5632, NIN = 6656, DEPTH = 4;
constexpr int NCH64 = MROWS / 64;
constexpr float EPS = 1e-6f;
constexpr size_t O_POOLP = 34078720, O_POOLS = 34140160, O_HGP = 34385920, O_HGS = 34910208, O_VS = 37007360;
constexpr size_t COLB = (size_t)MROWS * 512 * 2;
constexpr size_t RA = 0;
constexpr size_t RB = RA + (size_t)MROWS * 1024 * 2;
constexpr size_t RC = RB + 7 * COLB;
constexpr size_t RYP = RC + (size_t)MROWS * 1024 * 4;
constexpr size_t RWF = RC + (size_t)MROWS * 3072 * 2;
constexpr size_t RWF_DN = RWF + (size_t)NGU * 1024 * 2;
constexpr size_t RWM = RWF_DN + (size_t)1024 * DFF * 2;
constexpr size_t RWM_BR = RWM + (size_t)NIN * 1024 * 2;
constexpr size_t RWM_OUT = RWM_BR + (size_t)1024 * 1536 * 2;
constexpr size_t RWM_POOL = RWM_OUT + (size_t)1024 * 1024 * 2;
constexpr size_t RSM = RWM_POOL + (size_t)4 * 128 * 128 * 2;
constexpr size_t RBAR = RSM + (size_t)NCH64 * 4 * 128 * 4;
constexpr size_t RWF2 = RBAR + 3456 * 4 + 256;
constexpr size_t WS_END = RWF2 + (RWF_DN - RWF) + (size_t)1024 * DFF * 2;
constexpr int LDS_BYTES = 131072 + 2048;

struct Params { const float* in[19]; float* out; unsigned char* ws; int ph_lo, ph_hi; };
struct Ctx {
    LAS const unsigned* pl;
    __device__ __forceinline__ unsigned long long q(int k) const { const unsigned lo = __builtin_amdgcn_readfirstlane(pl[2 * k]), hi = __builtin_amdgcn_readfirstlane(pl[2 * k + 1]); return ((unsigned long long)hi << 32) | lo; }
    __device__ __forceinline__ const float* in(int k) const { return (const float*)(const __attribute__((address_space(1))) float*)q(k); }
    __device__ __forceinline__ float* out() const { return (float*)(__attribute__((address_space(1))) float*)q(19); }
    __device__ __forceinline__ unsigned char* ws() const { return (unsigned char*)(__attribute__((address_space(1))) unsigned char*)q(20); }
    __device__ __forceinline__ unsigned char* ws_flat() const { return (unsigned char*)q(20); }
};

__device__ __forceinline__ float bf2f(unsigned b) { return __uint_as_float(b << 16); }
__device__ __forceinline__ float bflo(unsigned w) { return __uint_as_float(w << 16); }
__device__ __forceinline__ float bfhi(unsigned w) { return __uint_as_float(w & 0xffff0000u); }
__device__ __forceinline__ u16 f2bf(float f) { unsigned u = __float_as_uint(f); u += 0x7FFFu + ((u >> 16) & 1u); return (u16)(u >> 16); }
typedef __bf16 bf16x2_t __attribute__((ext_vector_type(2)));
typedef float f32x2_t __attribute__((ext_vector_type(2)));
__device__ __forceinline__ unsigned cvt_pk_bf16(float lo, float hi) { const f32x2_t v = {lo, hi}; const bf16x2_t r = __builtin_convertvector(v, bf16x2_t); return __builtin_bit_cast(unsigned, r); }
__device__ __forceinline__ float fsig(float x) { return __builtin_amdgcn_rcpf(1.0f + __expf(-x)); }
__device__ __forceinline__ float fsilu(float x) { return x * fsig(x); }
__device__ __forceinline__ float fgelu(float x) { return x * fsig(1.5957691216f * (x + 0.044715f * x * x * x)); }
__device__ __forceinline__ float wave_sum(float v) {
#pragma unroll
    for (int o = 32; o >= 1; o >>= 1) v += __shfl_xor(v, o);
    return v;
}

__device__ __forceinline__ int otid() { int t = threadIdx.x; asm volatile("" : "+v"(t)); return t; }
template <class T> __device__ __forceinline__ T osgpr(T x) { asm volatile("" : "+s"(x)); return x; }
__device__ __forceinline__ int obid() { return osgpr((int)blockIdx.x); }
__device__ __forceinline__ int ogdim() { return osgpr((int)gridDim.x); }

namespace pg8 {
constexpr int BM = 256, BK = 64, HALF = 128, HTB = HALF * BK * 2, STAGE_BYTES = 8 * HTB, NXCD = 8, WGM = 8;
__device__ __forceinline__ int lds_byte(int r, int c) { const int st = (r >> 4) * 2 + (c >> 5), rr = r & 15, cc = c & 31, ob = rr * 64 + cc * 2; return st * 1024 + (ob ^ (((ob >> 9) & 1) << 5)); }
__device__ __forceinline__ void stage_rc(int b, int& R, int& C) { const int st = b / 1024, sb = b % 1024, swz = sb ^ (((sb >> 9) & 1) << 5); R = (st >> 1) * 16 + swz / 64; C = (st & 1) * 32 + (swz % 64) / 2; }
__device__ __forceinline__ int perm32(int rho) { const int n = rho >> 4, i = rho & 15; return 8 * (i >> 2) + 4 * n + (i & 3); }

struct Unit { const char* a; const char* b; int pm, pn, aux, nt; };

struct TileOrder {
    int nM, nN, nwg, G, c;
    __device__ void init(int nM_, int nN_, int G_, int c_) { nM = nM_; nN = nN_; nwg = nM * nN; G = G_; c = c_; }
    __device__ bool tile(int i, int& pm, int& pn) const {
        const long L = (long)i * G + c; if (L >= nwg) return false;
        int wgid = (int)L; { const int q = nwg / NXCD, r = nwg % NXCD, xcd = wgid % NXCD, off = wgid / NXCD; wgid = (xcd < r ? xcd * (q + 1) : r * (q + 1) + (xcd - r) * q) + off; }
        const int nig = WGM * nN, gid = wgid / nig, fm = gid * WGM, gsz = (nM - fm) < WGM ? (nM - fm) : WGM;
        pm = fm + ((wgid % nig) % gsz); pn = (wgid % nig) / gsz; return true;
    }
};
struct SchedPlain {
    TileOrder o; const char* A; const char* B; size_t at, bt;
    int nt;
    int ns;
    int nseg;
    const char* Asplit;
    __device__ bool next(int i, Unit& u) const {
        int pm, pn;
        if (o.tile(i, pm, pn)) { u.a = A + (size_t)pm * at; u.b = B + (size_t)pn * bt; u.pm = pm; u.pn = pn; u.aux = 0; u.nt = nt; return true; }
        const int nfull = (o.nwg - o.c + o.G - 1) / o.G;
        if (i != nfull) return false;
        if (nseg) { if (o.c >= 24) return false;
            const int tile = o.c / 3, sg = o.c - tile * 3, pms = tile >> 2; pn = tile & 3;
            u.a = A + (sg == 0 ? (size_t)0 : (sg == 1 ? COLB : 3 * COLB)) + (size_t)(128 + pms) * at; u.b = B + (size_t)pn * bt + (size_t)sg * 1024; u.pm = pms; u.pn = pn; u.aux = sg + 1; u.nt = 8; return true; }
        if (ns == 0 || o.c >= 8 * ns) return false;
        const int tile = o.c / ns, j = o.c - tile * ns, pms = tile >> 2; pn = tile & 3;
        u.a = (Asplit ? Asplit + (size_t)o.c * (512 * 1024) : A + (size_t)(128 + pms) * at) + (size_t)j * 512; u.b = B + (size_t)pn * bt + (size_t)j * 512; u.pm = pms; u.pn = pn; u.aux = j + 1; u.nt = 4; return true;
    }
};

template <class Epi, class Sched>
__device__ __forceinline__ void gemm_phase(LAS unsigned char* lds, const int K, const int lda, const int ldb, const Sched& S, const Epi& E) {
    const int tid = otid(), wid = __builtin_amdgcn_readfirstlane(tid >> 6), lane = tid & 63, wr = wid >> 2, wc = wid & 3, fr = lane & 15, fq = lane >> 4;
    unsigned voffA[2], voffB[2];
#pragma unroll
    for (int i = 0; i < 2; ++i) { int R, C; stage_rc(tid * 16 + i * 8192, R, C); const int Rb = Epi::PERM ? ((R & ~31) + perm32(R & 31)) : R;
        voffA[i] = (unsigned)(R * lda + C) * 2u; voffB[i] = (unsigned)(Rb * ldb + C) * 2u; }
    const size_t kstep = (size_t)(BK * 2);
    const size_t hstepA = (size_t)HALF * lda * 2, hstepB = (size_t)HALF * ldb * 2;
    const unsigned ldsw = (unsigned)wid * 1024u;
    const int aoff = lds_byte(wr * 64 + fr, fq * 8), boff = lds_byte(wc * 32 + fr, fq * 8);
#define PG8_SA(b, h) (((b) * 2 + (h)) * HTB)
#define PG8_SB(b, h) ((4 + (b) * 2 + (h)) * HTB)
#define PG8_STAGE(bufoff, gbase, voff) do { _Pragma("unroll") for (int _i = 0; _i < 2; ++_i) \
        __builtin_amdgcn_global_load_lds((const unsigned*)((const char*)(gbase) + (voff)[_i]), (LAS unsigned*)(lds + (bufoff) + ldsw + _i * 8192), 16, 0, 0); } while (0)
#define PG8_LDA(dst, b, h) do { _Pragma("unroll") for (int m = 0; m < 4; ++m) _Pragma("unroll") for (int k = 0; k < 2; ++k) dst[m][k] = *(const LAS bf16x8*)(lds + PG8_SA(b, h) + aoff + m * 2048 + k * 1024); } while (0)
#define PG8_LDB(dst, b, h) do { _Pragma("unroll") for (int n = 0; n < 2; ++n) _Pragma("unroll") for (int k = 0; k < 2; ++k) dst[n][k] = *(const LAS bf16x8*)(lds + PG8_SB(b, h) + boff + n * 2048 + k * 1024); } while (0)
#define PG8_MMA(ai, bj, At, Bt) do { __builtin_amdgcn_s_setprio(1); _Pragma("unroll") for (int m = 0; m < 4; ++m) _Pragma("unroll") for (int n = 0; n < 2; ++n) _Pragma("unroll") for (int k = 0; k < 2; ++k) \
        acc[ai][bj][m][n] = __builtin_amdgcn_mfma_f32_16x16x32_bf16(Bt[n][k], At[m][k], acc[ai][bj][m][n], 0, 0, 0); __builtin_amdgcn_s_setprio(0); } while (0)
#define PG8_WAIT_V(n) asm volatile("s_waitcnt vmcnt(" #n ")" ::: "memory")
#define PG8_WAIT_L(n) asm volatile("s_waitcnt lgkmcnt(" #n ")" ::: "memory")
#define PG8_BAR __builtin_amdgcn_s_barrier()
#define PG8_SCHED __builtin_amdgcn_sched_barrier(0)
    Unit cur, nxt; int ui = 0;
    if (!S.next(0, cur)) return;
    f32x4 acc[2][2][4][2];
#pragma unroll
    for (int a = 0; a < 2; ++a)
#pragma unroll
        for (int b = 0; b < 2; ++b)
#pragma unroll
            for (int m = 0; m < 4; ++m)
#pragma unroll
                for (int n = 0; n < 2; ++n) acc[a][b][m][n] = (f32x4){0.f, 0.f, 0.f, 0.f};
    bf16x8 At[4][2], B0[2][2], B1[2][2];
    const char* cA = cur.a; const char* cB = cur.b;
    if constexpr (USE_SP2) {
        PG8_STAGE(PG8_SB(0, 0), cB, voffB); PG8_STAGE(PG8_SB(0, 1), cB + hstepB, voffB); PG8_STAGE(PG8_SA(0, 0), cA, voffA); PG8_STAGE(PG8_SA(0, 1), cA + hstepA, voffA);
        if (wr == 1) PG8_BAR;
        PG8_WAIT_V(2); PG8_BAR;
        PG8_STAGE(PG8_SB(1, 0), cB + kstep, voffB); PG8_STAGE(PG8_SA(1, 0), cA + kstep, voffA); PG8_STAGE(PG8_SB(1, 1), cB + hstepB + kstep, voffB);
        PG8_WAIT_V(6); PG8_BAR;
    } else {
    PG8_STAGE(PG8_SB(0, 0), cB, voffB); PG8_STAGE(PG8_SA(0, 0), cA, voffA); PG8_STAGE(PG8_SB(0, 1), cB + hstepB, voffB); PG8_STAGE(PG8_SA(0, 1), cA + hstepA, voffA);
    if (wr == 1) PG8_BAR;
    PG8_WAIT_V(4); PG8_BAR;
    PG8_STAGE(PG8_SB(1, 0), cB + kstep, voffB); PG8_STAGE(PG8_SA(1, 0), cA + kstep, voffA); PG8_STAGE(PG8_SB(1, 1), cB + hstepB + kstep, voffB);
    PG8_WAIT_V(6); PG8_BAR;
    }
    for (;;) {
        const bool has_next = S.next(ui + 1, nxt);
        const char* nA = has_next ? nxt.a : cA; const char* nB = has_next ? nxt.b : cB;
        const int nt = cur.nt;
        for (int t = 0; t < nt; t += 2) {
            const bool last = (t == nt - 2);
            if constexpr (Epi::SEG) { if (t == 8 || t == 16) E.rescale(acc, cur, t >> 3, wr, wc, fr, fq); }
            const char* a1 = cA + (size_t)(t + 1) * kstep + (Epi::SEG ? Epi::segoff(t >> 3) : (size_t)0);
            const char* a2 = last ? nA : cA + (size_t)(t + 2) * kstep + (Epi::SEG ? Epi::segoff((t + 2) >> 3) : (size_t)0); const char* b2 = last ? nB : cB + (size_t)(t + 2) * kstep;
            const char* a3 = a2 + kstep; const char* b3 = b2 + kstep;
            if constexpr (USE_SP2) {
            PG8_LDB(B0, 0, 0); PG8_LDB(B1, 0, 1); PG8_SCHED; PG8_LDA(At, 0, 0); PG8_STAGE(PG8_SA(1, 1), a1 + hstepA, voffA);
            PG8_WAIT_V(8); PG8_WAIT_L(0); PG8_BAR; PG8_MMA(0, 0, At, B0); PG8_MMA(0, 1, At, B1); PG8_BAR; PG8_SCHED;
            PG8_LDA(At, 0, 1); PG8_STAGE(PG8_SB(0, 0), b2, voffB); PG8_STAGE(PG8_SB(0, 1), b2 + hstepB, voffB); PG8_STAGE(PG8_SA(0, 0), a2, voffA);
            PG8_WAIT_V(8); PG8_WAIT_L(0); PG8_BAR; PG8_MMA(1, 0, At, B0); PG8_MMA(1, 1, At, B1); PG8_BAR; PG8_SCHED;
            PG8_LDB(B0, 1, 0); PG8_LDB(B1, 1, 1); PG8_SCHED; PG8_LDA(At, 1, 0); PG8_STAGE(PG8_SA(0, 1), a2 + hstepA, voffA);
            PG8_WAIT_V(8); PG8_WAIT_L(0); PG8_BAR; PG8_MMA(0, 0, At, B0); PG8_MMA(0, 1, At, B1); PG8_BAR; PG8_SCHED;
            PG8_LDA(At, 1, 1); PG8_STAGE(PG8_SB(1, 0), b3, voffB); PG8_STAGE(PG8_SB(1, 1), b3 + hstepB, voffB); PG8_STAGE(PG8_SA(1, 0), a3, voffA);
            PG8_WAIT_V(8); PG8_WAIT_L(0); PG8_BAR; PG8_MMA(1, 0, At, B0); PG8_MMA(1, 1, At, B1); PG8_BAR; PG8_SCHED;
            } else {
            PG8_LDB(B0, 0, 0); PG8_SCHED; PG8_LDA(At, 0, 0); PG8_STAGE(PG8_SA(1, 1), a1 + hstepA, voffA);
            PG8_WAIT_L(8); PG8_BAR; PG8_WAIT_L(0); PG8_MMA(0, 0, At, B0); PG8_BAR; PG8_SCHED;
            PG8_LDB(B1, 0, 1); PG8_STAGE(PG8_SB(0, 0), b2, voffB);
            PG8_BAR; PG8_WAIT_L(0); PG8_MMA(0, 1, At, B1); PG8_BAR;
            PG8_LDA(At, 0, 1); PG8_STAGE(PG8_SA(0, 0), a2, voffA);
            PG8_BAR; PG8_WAIT_L(0); PG8_MMA(1, 0, At, B0); PG8_BAR; PG8_SCHED;
            PG8_STAGE(PG8_SB(0, 1), b2 + hstepB, voffB);
            PG8_WAIT_V(6); PG8_BAR; PG8_MMA(1, 1, At, B1); PG8_BAR;
            PG8_LDB(B0, 1, 0); PG8_SCHED; PG8_LDA(At, 1, 0); PG8_STAGE(PG8_SA(0, 1), a2 + hstepA, voffA);
            PG8_WAIT_L(8); PG8_BAR; PG8_WAIT_L(0); PG8_MMA(0, 0, At, B0); PG8_BAR; PG8_SCHED;
            PG8_LDB(B1, 1, 1); PG8_STAGE(PG8_SB(1, 0), b3, voffB);
            PG8_BAR; PG8_WAIT_L(0); PG8_MMA(0, 1, At, B1); PG8_BAR;
            PG8_LDA(At, 1, 1); PG8_STAGE(PG8_SA(1, 0), a3, voffA);
            PG8_BAR; PG8_WAIT_L(0); PG8_MMA(1, 0, At, B0); PG8_BAR; PG8_SCHED;
            PG8_STAGE(PG8_SB(1, 1), b3 + hstepB, voffB);
            PG8_WAIT_V(6); PG8_BAR; PG8_MMA(1, 1, At, B1); PG8_BAR;
            }
        }
        if constexpr (USE_ALIGN) { if (wr == 0) PG8_BAR; }
        E(acc, cur, wr, wc, fr, fq);
        if (!has_next) break;
#pragma unroll
        for (int a = 0; a < 2; ++a)
#pragma unroll
            for (int b = 0; b < 2; ++b)
#pragma unroll
                for (int m = 0; m < 4; ++m)
#pragma unroll
                    for (int n = 0; n < 2; ++n) acc[a][b][m][n] = (f32x4){0.f, 0.f, 0.f, 0.f};
        cur = nxt; cA = nA; cB = nB; ++ui;
        if constexpr (USE_ALIGN) { if (wr == 1) PG8_BAR; }
    }
    PG8_WAIT_V(0);
    if constexpr (!USE_ALIGN) { if (wr == 0) PG8_BAR; }
    PG8_BAR;
    asm volatile("" ::: "memory");
#undef PG8_SA
#undef PG8_SB
#undef PG8_STAGE
#undef PG8_LDA
#undef PG8_LDB
#undef PG8_MMA
#undef PG8_WAIT_V
#undef PG8_WAIT_L
#undef PG8_BAR
#undef PG8_SCHED
}

struct EpiF32 {
    static constexpr bool PERM = true;
    static constexpr bool SEG = false; static __device__ __forceinline__ size_t segoff(int) { return 0; }
    u16* C; int ldc; float* P;
    __device__ __forceinline__ void operator()(const f32x4 (&acc)[2][2][4][2], const Unit& u, int wr, int wc, int fr, int fq) const {
        const int row0 = u.pm * BM + wr * 64 + fr, col0 = u.pn * BM + wc * 32 + 8 * fq;
        if (u.aux == 0) {
            const unsigned o0 = (unsigned)(row0 * ldc + col0) * 2u;
#pragma unroll
            for (int ai = 0; ai < 2; ++ai)
#pragma unroll
                for (int m = 0; m < 4; ++m) { const unsigned ro = o0 + (unsigned)((ai * HALF + m * 16) * ldc) * 2u;
#pragma unroll
                    for (int bj = 0; bj < 2; ++bj) { const f32x4 v0 = acc[ai][bj][m][0], v1 = acc[ai][bj][m][1]; u32x4 w;
                        w.x = cvt_pk_bf16(v0[0], v0[1]); w.y = cvt_pk_bf16(v0[2], v0[3]); w.z = cvt_pk_bf16(v1[0], v1[1]); w.w = cvt_pk_bf16(v1[2], v1[3]);
                        *(u32x4*)((char*)C + (ro + (unsigned)(bj * HALF) * 2u)) = w; } }
        } else {
            char* Cb = (char*)(P + (size_t)(u.aux - 1) * ((size_t)512 * 1024)); const unsigned o0 = (unsigned)(row0 * ldc + col0) * 4u;
#pragma unroll
            for (int ai = 0; ai < 2; ++ai)
#pragma unroll
                for (int m = 0; m < 4; ++m) { const unsigned ro = o0 + (unsigned)((ai * HALF + m * 16) * ldc) * 4u;
#pragma unroll
                    for (int bj = 0; bj < 2; ++bj)
#pragma unroll
                        for (int n = 0; n < 2; ++n) *(f32x4*)(Cb + (ro + (unsigned)(bj * HALF + n * 4) * 4u)) = acc[ai][bj][m][n]; }
        }
    }
};
struct EpiGU {
    static constexpr bool SEG = false; static __device__ __forceinline__ size_t segoff(int) { return 0; }
    static constexpr bool PERM = true;
    u16* H;
    __device__ __forceinline__ void operator()(const f32x4 (&acc)[2][2][4][2], const Unit& u, int wr, int wc, int fr, int fq) const {
        const int row0 = u.pm * BM + wr * 64 + fr, col0 = u.pn * 128 + wc * 32 + 8 * fq;
#pragma unroll
        for (int ai = 0; ai < 2; ++ai)
#pragma unroll
            for (int m = 0; m < 4; ++m) { u16* rowp = (u16*)((char*)H + (unsigned)((row0 + ai * HALF + m * 16) * DFF + col0) * 2u);
                const f32x4 g0 = acc[ai][0][m][0], g1 = acc[ai][0][m][1], u0 = acc[ai][1][m][0], u1 = acc[ai][1][m][1];
                u32x4 w; w.x = cvt_pk_bf16(fsilu(g0[0]) * u0[0], fsilu(g0[1]) * u0[1]); w.y = cvt_pk_bf16(fsilu(g0[2]) * u0[2], fsilu(g0[3]) * u0[3]);
                w.z = cvt_pk_bf16(fsilu(g1[0]) * u1[0], fsilu(g1[1]) * u1[1]); w.w = cvt_pk_bf16(fsilu(g1[2]) * u1[2], fsilu(g1[3]) * u1[3]);
                *(u32x4*)rowp = w; }
    }
};
struct EpiIN {
    static constexpr bool PERM = true;
    static constexpr bool SEG = false; static __device__ __forceinline__ size_t segoff(int) { return 0; }
    u16* cols; u16* G;
    static __device__ __forceinline__ float act(float x, float k1, float k3, float px, float p1) {
        const float e = __builtin_amdgcn_exp2f(x * (k3 * (x * x) + k1));
        return (px * x + p1) * __builtin_amdgcn_rcpf(1.0f + e);
    }
    __device__ __forceinline__ void operator()(const f32x4 (&acc)[2][2][4][2], const Unit& u, int wr, int wc, int fr, int fq) const {
        const int pn = u.pn; const int mode = pn < 14 ? (pn >> 1) : 7;
        u16* base = pn < 14 ? cols + (size_t)(pn >> 1) * ((size_t)MROWS * 512) : G;
        const int ldc = pn < 14 ? 512 : 3072; const int colt = pn < 14 ? (pn & 1) * 256 : (pn - 14) * 256;
        const int row0 = u.pm * BM + wr * 64 + fr, col0 = colt + wc * 32 + 8 * fq;
        const bool isg = mode <= 1, ident = (mode == 2 || mode == 4 || mode == 5);
        const float L2E = 1.4426950408889634f;
        const float k1 = ident ? 0.f : (isg ? -1.5957691216f * L2E : -L2E), k3 = isg ? -1.5957691216f * 0.044715f * L2E : 0.f;
        const float px = ident ? 2.0f : (mode == 3 ? 0.08838834764831845f : (mode == 7 ? 0.f : 1.0f)), p1 = mode == 7 ? 1.0f : 0.f;
#pragma unroll
        for (int ai = 0; ai < 2; ++ai)
#pragma unroll
            for (int m = 0; m < 4; ++m) { u16* rowp = (u16*)((char*)base + (unsigned)((row0 + ai * HALF + m * 16) * ldc + col0) * 2u);
#pragma unroll
                for (int bj = 0; bj < 2; ++bj) { const f32x4 v0 = acc[ai][bj][m][0], v1 = acc[ai][bj][m][1]; u32x4 w;
                    if (mode == 4) {
                        w.x = __builtin_bit_cast(unsigned, (h16x2){(_Float16)v0[0], (_Float16)v0[1]}); w.y = __builtin_bit_cast(unsigned, (h16x2){(_Float16)v0[2], (_Float16)v0[3]});
                        w.z = __builtin_bit_cast(unsigned, (h16x2){(_Float16)v1[0], (_Float16)v1[1]}); w.w = __builtin_bit_cast(unsigned, (h16x2){(_Float16)v1[2], (_Float16)v1[3]});
                    } else {
                        w.x = cvt_pk_bf16(act(v0[0], k1, k3, px, p1), act(v0[1], k1, k3, px, p1)); w.y = cvt_pk_bf16(act(v0[2], k1, k3, px, p1), act(v0[3], k1, k3, px, p1));
                        w.z = cvt_pk_bf16(act(v1[0], k1, k3, px, p1), act(v1[1], k1, k3, px, p1)); w.w = cvt_pk_bf16(act(v1[2], k1, k3, px, p1), act(v1[3], k1, k3, px, p1));
                    }
                    *(u32x4*)(rowp + bj * HALF) = w; } }
    }
};
struct EpiBranch {
    static constexpr bool PERM = true, SEG = true;
    const u16* G; u16* O; float* P;
    static __device__ __forceinline__ size_t segoff(int sgi) { return sgi == 0 ? (size_t)0 : (sgi == 1 ? COLB - 1024 : 3 * COLB - 2048); }
    __device__ __forceinline__ void rescale(f32x4 (&acc)[2][2][4][2], const Unit& u, int j, int wr, int wc, int fr, int fq) const {
        const int row0 = u.pm * BM + wr * 64 + fr, col0 = u.pn * BM + wc * 32 + 8 * fq;
        const char* Gb = (const char*)G; const unsigned goff = (unsigned)((row0 * 3072 + (j - 1) * 1024 + col0) * 2);
#pragma unroll
        for (int am = 0; am < 4; ++am) { const int ai = am >> 1, m0 = (am & 1) * 2;
            u32x4 na[2][2], nb[2][2];
#pragma unroll
            for (int m = 0; m < 2; ++m)
#pragma unroll
                for (int bj = 0; bj < 2; ++bj) { const unsigned go = goff + (unsigned)(((ai * HALF + (m0 + m) * 16) * 3072 + bj * HALF) * 2);
                    na[m][bj] = *(const u32x4*)(Gb + go); nb[m][bj] = *(const u32x4*)(Gb + go + 2048u); }
#pragma unroll
            for (int m = 0; m < 2; ++m)
#pragma unroll
                for (int bj = 0; bj < 2; ++bj) { const u32x4 a = na[m][bj], b = nb[m][bj]; f32x4& v0 = acc[ai][bj][m0 + m][0]; f32x4& v1 = acc[ai][bj][m0 + m][1];
                    v0[0] *= bflo(a.x) * __builtin_amdgcn_rcpf(bflo(b.x)); v0[1] *= bfhi(a.x) * __builtin_amdgcn_rcpf(bfhi(b.x));
                    v0[2] *= bflo(a.y) * __builtin_amdgcn_rcpf(bflo(b.y)); v0[3] *= bfhi(a.y) * __builtin_amdgcn_rcpf(bfhi(b.y));
                    v1[0] *= bflo(a.z) * __builtin_amdgcn_rcpf(bflo(b.z)); v1[1] *= bfhi(a.z) * __builtin_amdgcn_rcpf(bfhi(b.z));
                    v1[2] *= bflo(a.w) * __builtin_amdgcn_rcpf(bflo(b.w)); v1[3] *= bfhi(a.w) * __builtin_amdgcn_rcpf(bfhi(b.w)); }
            asm volatile("" ::: "memory");
        }
    }
    __device__ __forceinline__ void operator()(const f32x4 (&acc)[2][2][4][2], const Unit& u, int wr, int wc, int fr, int fq) const {
        if (u.aux > 0) {
            const int sg = u.aux - 1; const int rrel = u.pm * BM + wr * 64 + fr, col0 = u.pn * BM + wc * 32 + 8 * fq;
            const unsigned g0 = (unsigned)(((MP + rrel) * 3072 + sg * 1024 + col0) * 2), p0 = (unsigned)((sg * 512 * 1024 + rrel * 1024 + col0) * 4);
#pragma unroll
            for (int ai = 0; ai < 2; ++ai) {
                u32x4 gw[4][2];
#pragma unroll
                for (int m = 0; m < 4; ++m)
#pragma unroll
                    for (int bj = 0; bj < 2; ++bj) gw[m][bj] = *(const u32x4*)((const char*)G + (g0 + (unsigned)(((ai * HALF + m * 16) * 3072 + bj * HALF) * 2)));
#pragma unroll
                for (int m = 0; m < 4; ++m)
#pragma unroll
                    for (int bj = 0; bj < 2; ++bj) { const u32x4 g = gw[m][bj]; const f32x4 v0 = acc[ai][bj][m][0], v1 = acc[ai][bj][m][1];
                        char* pp = (char*)P + (p0 + (unsigned)(((ai * HALF + m * 16) * 1024 + bj * HALF) * 4));
                        *(f32x4*)pp = (f32x4){v0[0] * bflo(g.x), v0[1] * bfhi(g.x), v0[2] * bflo(g.y), v0[3] * bfhi(g.y)};
                        *(f32x4*)(pp + 16) = (f32x4){v1[0] * bflo(g.z), v1[1] * bfhi(g.z), v1[2] * bflo(g.w), v1[3] * bfhi(g.w)}; }
            }
            return;
        }
        const int row0 = u.pm * BM + wr * 64 + fr, col0 = u.pn * BM + wc * 32 + 8 * fq;
#pragma unroll
        for (int ai = 0; ai < 2; ++ai) {
            u32x4 gw[4][2];
#pragma unroll
            for (int m = 0; m < 4; ++m)
#pragma unroll
                for (int bj = 0; bj < 2; ++bj) gw[m][bj] = *(const u32x4*)((const char*)G + (unsigned)((row0 + ai * HALF + m * 16) * 3072 + 2048 + col0 + bj * HALF) * 2u);
#pragma unroll
            for (int m = 0; m < 4; ++m)
#pragma unroll
                for (int bj = 0; bj < 2; ++bj) { const u32x4 g = gw[m][bj]; const f32x4 v0 = acc[ai][bj][m][0], v1 = acc[ai][bj][m][1]; u32x4 w;
                    w.x = cvt_pk_bf16(v0[0] * bflo(g.x), v0[1] * bfhi(g.x)); w.y = cvt_pk_bf16(v0[2] * bflo(g.y), v0[3] * bfhi(g.y));
                    w.z = cvt_pk_bf16(v1[0] * bflo(g.z), v1[1] * bfhi(g.z)); w.w = cvt_pk_bf16(v1[2] * bflo(g.w), v1[3] * bfhi(g.w));
                    *(u32x4*)((char*)O + (unsigned)((row0 + ai * HALF + m * 16) * 1024 + col0 + bj * HALF) * 2u) = w; }
        }
    }
};
}

__device__ __forceinline__ void rn_load(const Ctx p, bool first, int row, int lane, int ns, float4 (&x)[4], float4 (&y)[4]) {
    const float* src = first ? (row < MP ? p.in(0) + (size_t)row * DM : p.in(1) + (size_t)(row - MP) * DM) : p.out() + (size_t)row * DM;
#pragma unroll
    for (int j = 0; j < 4; ++j) x[j] = *(const float4*)(src + lane * 4 + 256 * j);
    if (!first) {
#pragma unroll
        for (int j = 0; j < 4; ++j) {
            if (row < MP) { const u32x2 yw = *(const u32x2*)((const u16*)(p.ws() + RC) + (size_t)row * DM + lane * 4 + 256 * j); y[j].x = bflo(yw.x); y[j].y = bfhi(yw.x); y[j].z = bflo(yw.y); y[j].w = bfhi(yw.y); }
            else { const float* yp = (const float*)(p.ws() + RYP) + (size_t)(row - MP) * DM + lane * 4 + 256 * j; y[j] = *(const float4*)yp;
                for (int q = 1; q < ns; ++q) { const float4 t = *(const float4*)(yp + (size_t)q * 512 * 1024); y[j].x += t.x; y[j].y += t.y; y[j].z += t.z; y[j].w += t.w; } } }
    }
}
__device__ __forceinline__ void rownorm_phase(const Ctx p, bool first, float coef, const float* gpost, const float* gpre, bool write_xn, int ns) {
    float* X = p.out(); u16* XN = (u16*)(p.ws() + RA);
    const int tid_ = otid(); const int lane = tid_ & 63, wid = tid_ >> 6;
    float4 gp[4], gq[4];
#pragma unroll
    for (int j = 0; j < 4; ++j) { gq[j] = *(const float4*)(gpre + lane * 4 + 256 * j); gp[j] = first ? gq[j] : *(const float4*)(gpost + lane * 4 + 256 * j); }
    const int stride = ogdim() * 8;
    int row = obid() * 8 + wid;
    float4 x[4], y[4];
    if (row < MROWS) rn_load(p, first, row, lane, ns, x, y);
    for (; row < MROWS; row += stride) {
        float4 xn[4], yn[4];
        if (row + stride < MROWS) rn_load(p, first, row + stride, lane, ns, xn, yn);
        if (!first) {
            float ss = 0.f;
#pragma unroll
            for (int j = 0; j < 4; ++j) ss += y[j].x * y[j].x + y[j].y * y[j].y + y[j].z * y[j].z + y[j].w * y[j].w;
            ss = wave_sum(ss);
            const float r = coef * rsqrtf(ss * (1.0f / DM) + EPS);
#pragma unroll
            for (int j = 0; j < 4; ++j) { x[j].x += r * y[j].x * gp[j].x; x[j].y += r * y[j].y * gp[j].y; x[j].z += r * y[j].z * gp[j].z; x[j].w += r * y[j].w * gp[j].w; }
        }
#pragma unroll
        for (int j = 0; j < 4; ++j) *(float4*)(X + (size_t)row * DM + lane * 4 + 256 * j) = x[j];
        if (write_xn) {
            float ss = 0.f;
#pragma unroll
            for (int j = 0; j < 4; ++j) ss += x[j].x * x[j].x + x[j].y * x[j].y + x[j].z * x[j].z + x[j].w * x[j].w;
            ss = wave_sum(ss);
            const float r = rsqrtf(ss * (1.0f / DM) + EPS);
#pragma unroll
            for (int j = 0; j < 4; ++j) { u32x2 w; w.x = cvt_pk_bf16(x[j].x * r * gq[j].x, x[j].y * r * gq[j].y); w.y = cvt_pk_bf16(x[j].z * r * gq[j].z, x[j].w * r * gq[j].w);
                *(u32x2*)(XN + (size_t)row * DM + lane * 4 + 256 * j) = w; }
        }
#pragma unroll
        for (int j = 0; j < 4; ++j) { x[j] = xn[j]; y[j] = yn[j]; }
    }
}

#define MFMA16(a, b, c) __builtin_amdgcn_mfma_f32_16x16x32_bf16((a), (b), (c), 0, 0, 0)
__device__ __forceinline__ bf16x8 ldsfrag(const LAS u16* base, int row, int ld, int k) { return *(const LAS bf16x8*)(base + row * ld + k); }

__device__ __forceinline__ void convert_mat(LAS unsigned char* lds, int rank, int nwork, const float* src, int ld, u16* dst, int K, int N, bool gu_map, int dld = 0) {
    if (dld == 0) dld = K;
    LAS float* tile = (LAS float*)lds;
    const int tid = otid(), nkt = K >> 6, ntiles = nkt * (N >> 6);
    const int kk = tid >> 4, c4 = (tid & 15) * 4, n = tid >> 3, ks = (tid & 7) * 8;
    float4 v0, v1;
    auto tile_src = [&](int t) -> const float* { const int kt = t % nkt, nd0 = (t / nkt) * 64; int sc0 = nd0;
        if (gu_map) { const int pb = nd0 >> 8, h = (nd0 >> 7) & 1, j = nd0 & 127; sc0 = h * DFF + 128 * pb + j; }
        return src + (size_t)(kt * 64 + kk) * ld + sc0 + c4; };
    int t = rank, it = 0;
    if (t < ntiles) { const float* sp = tile_src(t); v0 = *(const float4*)sp; v1 = *(const float4*)(sp + (size_t)32 * ld); }
    for (; t < ntiles; t += nwork, ++it) {
        LAS float* tb = tile + (it & 1) * 4160;
        { LAS float* tp = tb + kk * 65 + c4; tp[0] = v0.x; tp[1] = v0.y; tp[2] = v0.z; tp[3] = v0.w; tp += 32 * 65; tp[0] = v1.x; tp[1] = v1.y; tp[2] = v1.z; tp[3] = v1.w; }
        if (t + nwork < ntiles) { const float* sp = tile_src(t + nwork); v0 = *(const float4*)sp; v1 = *(const float4*)(sp + (size_t)32 * ld); }
        __syncthreads();
        const int kt = t % nkt, nd0 = (t / nkt) * 64;
        float e[8];
#pragma unroll
        for (int i = 0; i < 8; ++i) e[i] = tb[(ks + i) * 65 + n];
        u32x4 w; w.x = cvt_pk_bf16(e[0], e[1]); w.y = cvt_pk_bf16(e[2], e[3]); w.z = cvt_pk_bf16(e[4], e[5]); w.w = cvt_pk_bf16(e[6], e[7]);
        *(u32x4*)(dst + (size_t)(nd0 + n) * dld + kt * 64 + ks) = w;
    }
    __syncthreads();
}
__device__ __forceinline__ void convert_ffn(const Ctx p, LAS unsigned char* lds, int rank, int nwork, const float* wgu, const float* wdn, size_t dstoff) {
    convert_mat(lds, rank, nwork, wgu, NGU, (u16*)(p.ws() + dstoff), 1024, NGU, true);
    convert_mat(lds, rank, nwork, wdn, 1024, (u16*)(p.ws() + dstoff + (RWF_DN - RWF)), DFF, 1024, false);
}
__device__ __forceinline__ void fuse_pool_unit(const Ctx p, LAS unsigned char* lds, int l, int unit) {
    const int tid = otid(), wid = tid >> 6, lane = tid & 63, fr = lane & 15, fq = lane >> 4;
    const int g = unit >> 3, nb = unit & 7;
    LAS u16* Xt = (LAS u16*)lds; LAS u16* Yl = (LAS u16*)(lds + 34816);
    constexpr int LD = 136;
    const float* wb = p.in(15) + (size_t)l * 1536 * 1024 + (size_t)(512 + g * 128) * 1024 + nb * 128;
    const float* pw = p.in(11) + ((size_t)l * 4 + g) * 16384;
    const float* sc = p.in(12) + l * 512 + g * 128;
#pragma unroll
    for (int i = 0; i < 8; ++i) { const int e = tid + i * 512, d = e >> 5, n4 = (e & 31) * 4; const float4 v = *(const float4*)(wb + (size_t)d * 1024 + n4);
        Xt[(n4 + 0) * LD + d] = f2bf(v.x); Xt[(n4 + 1) * LD + d] = f2bf(v.y); Xt[(n4 + 2) * LD + d] = f2bf(v.z); Xt[(n4 + 3) * LD + d] = f2bf(v.w); }
#pragma unroll
    for (int i = 0; i < 8; ++i) { const int e = tid + i * 512, c = e >> 5, d4 = (e & 31) * 4; const float4 v = *(const float4*)(pw + c * 128 + d4); const float4 s4 = *(const float4*)(sc + d4);
        u32x2 w; w.x = cvt_pk_bf16(v.x * s4.x, v.y * s4.y); w.y = cvt_pk_bf16(v.z * s4.z, v.w * s4.w); *(LAS u32x2*)(Yl + c * LD + d4) = w; }
    __syncthreads();
    f32x4 acc[8];
#pragma unroll
    for (int n = 0; n < 8; ++n) acc[n] = (f32x4){0.f, 0.f, 0.f, 0.f};
#pragma unroll
    for (int ks = 0; ks < 4; ++ks) { const bf16x8 a = ldsfrag(Xt, wid * 16 + fr, LD, ks * 32 + fq * 8);
#pragma unroll
        for (int n = 0; n < 8; ++n) acc[n] = MFMA16(a, ldsfrag(Yl, n * 16 + fr, LD, ks * 32 + fq * 8), acc[n]); }
    u16* dst = (u16*)(p.ws() + RWM_BR);
#pragma unroll
    for (int j = 0; j < 4; ++j) { const int n = nb * 128 + wid * 16 + fq * 4 + j;
#pragma unroll
        for (int c8 = 0; c8 < 8; ++c8) dst[(size_t)n * 1536 + 512 + g * 128 + c8 * 16 + fr] = f2bf(acc[c8][j]); }
    __syncthreads();
}
__device__ __forceinline__ void convert_mix(const Ctx p, LAS unsigned char* lds, int rank, int nwork, int l) {
    convert_mat(lds, rank, nwork, p.in(7) + (size_t)l * 1024 * NIN, NIN, (u16*)(p.ws() + RWM), 1024, NIN, false);
    convert_mat(lds, rank, nwork, p.in(15) + (size_t)l * 1536 * 1024, 1024, (u16*)(p.ws() + RWM_BR), 512, 1024, false, 1536);
    convert_mat(lds, rank, nwork, p.in(15) + (size_t)l * 1536 * 1024 + (size_t)1024 * 1024, 1024, (u16*)(p.ws() + RWM_BR) + 1024, 512, 1024, false, 1536);
    convert_mat(lds, rank, nwork, p.in(16) + (size_t)l * 1024 * 1024, 1024, (u16*)(p.ws() + RWM_OUT), 1024, 1024, false);
    { const int c2 = nwork - 1 - rank; if (c2 < 32) fuse_pool_unit(p, lds, l, c2); }
}


__device__ __forceinline__ void gmlp_unit(const Ctx p, LAS unsigned char* lds, int l, int unit, int wrf = 1) {
    const int tid = otid(), wid = tid >> 6, lane = tid & 63, fr = lane & 15, fq = lane >> 4;
    int row0, L, h, bs = -1;
    if (unit < 1024) { row0 = (unit >> 2) * 128; h = unit & 3; L = 128; } else { const int s = unit - 1024; bs = s >> 2; h = s & 3; row0 = MP + bs * 64; L = 64; }
    u16* U = (u16*)(p.ws() + RB); const u16* V = (const u16*)(p.ws() + RB + COLB);
    LAS float* rs = (LAS float*)lds; LAS u16* Vt = (LAS u16*)(lds + 1024); LAS u16* Wl = (LAS u16*)(lds + 35840);
    constexpr int LD = 136;
    const int srow = tid >> 2, part = tid & 3;
    u32x4 sv[16];
    if (srow < L) {
#pragma unroll
        for (int i = 0; i < 16; ++i) sv[i] = *(const u32x4*)(V + (size_t)(row0 + srow) * 512 + part * 128 + i * 8);
    }
    const int vs = tid & 127, cg4 = tid >> 7;
    u32x4 hv[4]; float4 vgv[8];
    if (vs < L) {
#pragma unroll
        for (int i = 0; i < 4; ++i) hv[i] = *(const u32x4*)(V + (size_t)(row0 + vs) * 512 + h * 128 + cg4 * 32 + i * 8);
    }
    { const float* vg = p.in(8) + l * 512 + h * 128 + cg4 * 32;
#pragma unroll
        for (int i = 0; i < 8; ++i) vgv[i] = *(const float4*)(vg + i * 4); }
    const int wt = tid >> 2, sq = (tid & 3) * 32;
    float4 wv[8];
    if (wt < L) { const float* wp = p.in(9) + ((size_t)(l * 4 + h) * 128 + wt) * 128 + sq;
#pragma unroll
        for (int i = 0; i < 8; ++i) wv[i] = *(const float4*)(wp + i * 4); }
    {
        float ss = 0.f;
        if (srow < L) {
#pragma unroll
            for (int i = 0; i < 16; ++i) { const u32x4 w = sv[i];
                float a; a = bflo(w.x); ss += a * a; a = bfhi(w.x); ss += a * a; a = bflo(w.y); ss += a * a; a = bfhi(w.y); ss += a * a;
                a = bflo(w.z); ss += a * a; a = bfhi(w.z); ss += a * a; a = bflo(w.w); ss += a * a; a = bfhi(w.w); ss += a * a; }
        }
        ss += __shfl_xor(ss, 1); ss += __shfl_xor(ss, 2);
        if (part == 0 && srow < L) rs[srow] = rsqrtf(ss * (1.0f / 512.0f) + EPS);
    }
    {
        if (wt < L) {
#pragma unroll
            for (int i = 0; i < 4; ++i) { const float4 a = wv[2 * i], b = wv[2 * i + 1]; const int s0 = sq + i * 8, t = wt;
                u32x4 w; w.x = cvt_pk_bf16(s0 + 0 <= t ? a.x : 0.f, s0 + 1 <= t ? a.y : 0.f); w.y = cvt_pk_bf16(s0 + 2 <= t ? a.z : 0.f, s0 + 3 <= t ? a.w : 0.f);
                w.z = cvt_pk_bf16(s0 + 4 <= t ? b.x : 0.f, s0 + 5 <= t ? b.y : 0.f); w.w = cvt_pk_bf16(s0 + 6 <= t ? b.z : 0.f, s0 + 7 <= t ? b.w : 0.f);
                *(LAS u32x4*)(Wl + t * LD + s0) = w; } }
    }
    __syncthreads();
    {
        if (vs < L) {
            const float r = rs[vs];
            float* vout = bs >= 0 ? p.out() + O_VS + ((size_t)(l * 8 + bs) * 64 + vs) * 512 + h * 128 + cg4 * 32 : nullptr;
#pragma unroll
            for (int i = 0; i < 4; ++i) { const u32x4 w = hv[i];
                const float e[8] = {bflo(w.x), bfhi(w.x), bflo(w.y), bfhi(w.y), bflo(w.z), bfhi(w.z), bflo(w.w), bfhi(w.w)};
                const float gz[8] = {vgv[2 * i].x, vgv[2 * i].y, vgv[2 * i].z, vgv[2 * i].w, vgv[2 * i + 1].x, vgv[2 * i + 1].y, vgv[2 * i + 1].z, vgv[2 * i + 1].w};
                float vv[8];
#pragma unroll
                for (int j = 0; j < 8; ++j) { vv[j] = e[j] * r * gz[j]; Vt[(cg4 * 32 + i * 8 + j) * LD + vs] = f2bf(vv[j]); }
                if (vout) { *(float4*)(vout + i * 8) = (float4){vv[0], vv[1], vv[2], vv[3]}; *(float4*)(vout + i * 8 + 4) = (float4){vv[4], vv[5], vv[6], vv[7]}; } }
        }
    }
    __syncthreads();
    if (wid * 16 < L) {
        const float* bsp = p.in(10) + (l * 4 + h) * 128;
        u16 uv[4][8]; float bias[4];
#pragma unroll
        for (int j = 0; j < 4; ++j) { const int t = wid * 16 + fq * 4 + j; bias[j] = bsp[t];
#pragma unroll
            for (int n = 0; n < 8; ++n) uv[j][n] = U[(size_t)(row0 + t) * 512 + h * 128 + n * 16 + fr]; }
        f32x4 acc[8];
#pragma unroll
        for (int n = 0; n < 8; ++n) acc[n] = (f32x4){0.f, 0.f, 0.f, 0.f};
        const int kmax = (wid * 16 + 15) / 32 + 1;
        for (int ks = 0; ks < kmax; ++ks) { const bf16x8 a = ldsfrag(Wl, wid * 16 + fr, LD, ks * 32 + fq * 8);
#pragma unroll
            for (int n = 0; n < 8; ++n) acc[n] = MFMA16(a, ldsfrag(Vt, n * 16 + fr, LD, ks * 32 + fq * 8), acc[n]); }
#pragma unroll
        for (int j = 0; j < 4; ++j) { const int t = wid * 16 + fq * 4 + j;
#pragma unroll
            for (int n = 0; n < 8; ++n) { const u16 ov = f2bf(bf2f(uv[j][n]) * (acc[n][j] + bias[j])); if (wrf) U[(size_t)(row0 + t) * 512 + h * 128 + n * 16 + fr] = ov; } }
    }
    __syncthreads();
}

__device__ __forceinline__ float hgrn_lb(const float* lbp, int l, int c) {
    const float x0 = lbp[c], x1 = lbp[512 + c], x2 = lbp[1024 + c], x3 = lbp[1536 + c];
    const float m = fmaxf(fmaxf(x0, x1), fmaxf(x2, x3));
    const float e0 = __expf(x0 - m), e1 = __expf(x1 - m), e2 = __expf(x2 - m), e3 = __expf(x3 - m);
    float num = 0.f; if (l >= 1) num += e1; if (l >= 2) num += e2; if (l >= 3) num += e3;
    return num / (e0 + e1 + e2 + e3);
}
__device__ __forceinline__ int chunk_row0(int cq) { return cq < 512 ? cq * 64 : MP + (cq - 512) * 64; }

struct HaIn { u16 z[16]; u32x4 v[2]; float lbx[4]; };
__device__ __forceinline__ void ha_load(const Ctx p, int unit, HaIn& L) {
    const int tid = otid();
    const int cq = unit >> 2, h = unit & 3, row0 = chunk_row0(cq);
    const u16* F = (const u16*)(p.ws() + RB + 4 * COLB); const u16* I = (const u16*)(p.ws() + RB + 5 * COLB);
    const int k = tid & 127, seg = tid >> 7;
    { const float* lbp = p.in(13) + h * 128 + k; L.lbx[0] = lbp[0]; L.lbx[1] = lbp[512]; L.lbx[2] = lbp[1024]; L.lbx[3] = lbp[1536]; }
#pragma unroll
    for (int i = 0; i < 16; ++i) L.z[i] = F[(size_t)(row0 + seg * 16 + i) * 512 + h * 128 + k];
    { const int s = tid & 63, cg = tid >> 6;
#pragma unroll
        for (int i = 0; i < 2; ++i) L.v[i] = *(const u32x4*)(I + (size_t)(row0 + s) * 512 + h * 128 + cg * 16 + i * 8); }
}
__device__ __forceinline__ void hgrn_a_unit(const Ctx p, LAS unsigned char* lds, int l, int unit, int next_unit, HaIn& L) {
    const int tid = otid(), wid = tid >> 6, lane = tid & 63, fr = lane & 15, fq = lane >> 4;
    u16* St = (u16*)(p.ws() + RA) + (size_t)unit * 16384; float* dcy = (float*)(p.ws() + RSM) + (size_t)unit * 128;
    LAS float* segtot = (LAS float*)lds; LAS u16* Kt = (LAS u16*)(lds + 4096); LAS u16* Vt = (LAS u16*)(lds + 22528);
    constexpr int LD = 72;
    const int k = tid & 127, seg = tid >> 7;
    float lb;
    { const float x0 = L.lbx[0], x1 = L.lbx[1], x2 = L.lbx[2], x3 = L.lbx[3]; const float m = fmaxf(fmaxf(x0, x1), fmaxf(x2, x3));
      const float e0 = __expf(x0 - m), e1 = __expf(x1 - m), e2 = __expf(x2 - m), e3 = __expf(x3 - m);
      float num = 0.f; if (l >= 1) num += e1; if (l >= 2) num += e2; if (l >= 3) num += e3; lb = num / (e0 + e1 + e2 + e3); }
    float lf[16], kk[16]; float run = 0.f;
#pragma unroll
    for (int i = 0; i < 16; ++i) { const float z = (float)__builtin_bit_cast(_Float16, L.z[i]);
        const float sg = fsig(z); const float f = lb + (1.0f - lb) * sg; kk[i] = 1.0f - f; run += __logf(fmaxf(f, 1e-30f)); lf[i] = run; }
    segtot[seg * 128 + k] = run;
    { const int s = tid & 63, cg = tid >> 6;
#pragma unroll
        for (int i = 0; i < 2; ++i) { const u32x4 w = L.v[i]; LAS u16* vp = Vt + (cg * 16 + i * 8) * LD + s;
            vp[0] = (u16)(w.x & 0xffff); vp[LD] = (u16)(w.x >> 16); vp[2 * LD] = (u16)(w.y & 0xffff); vp[3 * LD] = (u16)(w.y >> 16);
            vp[4 * LD] = (u16)(w.z & 0xffff); vp[5 * LD] = (u16)(w.z >> 16); vp[6 * LD] = (u16)(w.w & 0xffff); vp[7 * LD] = (u16)(w.w >> 16); } }
    if (next_unit < 2080) ha_load(p, next_unit, L);
    __syncthreads();
    { const float t0 = segtot[k], t1 = segtot[128 + k], t2 = segtot[256 + k], t3 = segtot[384 + k];
        const float off = seg == 0 ? 0.f : (seg == 1 ? t0 : (seg == 2 ? t0 + t1 : t0 + t1 + t2)); const float blast = t0 + t1 + t2 + t3;
#pragma unroll
        for (int i = 0; i < 16; ++i) Kt[k * LD + seg * 16 + i] = f2bf(kk[i] * __expf(blast - (off + lf[i])));
        if (seg == 0) dcy[k] = __expf(blast); }
    __syncthreads();
    { f32x4 acc[8];
#pragma unroll
        for (int n = 0; n < 8; ++n) acc[n] = (f32x4){0.f, 0.f, 0.f, 0.f};
#pragma unroll
        for (int ks = 0; ks < 2; ++ks) { const bf16x8 a = ldsfrag(Kt, wid * 16 + fr, LD, ks * 32 + fq * 8);
#pragma unroll
            for (int n = 0; n < 8; ++n) acc[n] = MFMA16(a, ldsfrag(Vt, n * 16 + fr, LD, ks * 32 + fq * 8), acc[n]); }
#pragma unroll
        for (int n = 0; n < 8; ++n) { u32x2 w; w.x = cvt_pk_bf16(acc[n][0], acc[n][1]); w.y = cvt_pk_bf16(acc[n][2], acc[n][3]);
            *(u32x2*)(St + (size_t)(n * 16 + fr) * 128 + wid * 16 + fq * 4) = w; } }
    __syncthreads();
}

__device__ __forceinline__ void hgrn_scan_phase(const Ctx p, int l, int wrf = 1) {
    u16* SR = (u16*)(p.ws() + RA); const float* dcy = (const float*)(p.ws() + RSM);
    const int gtid = obid() * 512 + otid(), gsz = ogdim() * 512;
    for (int e = gtid; e < 8 * 16384; e += gsz) {
        const int seq = e >> 14, el = e & 16383, b = seq >> 2, h = seq & 3, k = el & 127, v = el >> 7;
        u16* sp = SR + ((size_t)(b * 256) * 4 + h) * 16384 + el; const float* dp = dcy + ((size_t)(b * 256) * 4 + h) * 128 + k;
        float st = 0.f;
        for (int n0 = 0; n0 < 256; n0 += 16) {
            float uu[16], dd[16];
#pragma unroll
            for (int j = 0; j < 16; ++j) { uu[j] = bf2f(sp[(size_t)(n0 + j) * 65536]); dd[j] = dp[(size_t)(n0 + j) * 512]; }
#pragma unroll
            for (int j = 0; j < 16; ++j) { if (wrf) sp[(size_t)(n0 + j) * 65536] = f2bf(st); st = dd[j] * st + uu[j]; }
        }
        if (wrf) p.out()[O_HGP + ((size_t)(l * 2 + b) * 4 + h) * 16384 + k * 128 + v] = st;
    }
    for (int e = gtid; e < 32 * 16384; e += gsz) {
        const int bh = e >> 14, el = e & 16383, k = el & 127, v = el >> 7;
        u16* sp = SR + ((size_t)(512 * 4) + bh) * 16384 + el;
        const float s0 = p.in(3)[((size_t)l * 32 + bh) * 16384 + k * 128 + v];
        const float uu = bf2f(*sp), dd = dcy[((size_t)(512 * 4) + bh) * 128 + k];
        if (wrf) *sp = f2bf(s0);
        if (wrf) p.out()[O_HGS + ((size_t)l * 32 + bh) * 16384 + k * 128 + v] = dd * s0 + uu;
    }
}

struct HcIn { u16 z[16]; u32x4 v[2], st[4]; float lbx[4]; };
__device__ __forceinline__ void hc_load(const Ctx p, int l, int unit, HcIn& L) {
    const int tid = otid();
    const int cq = unit >> 2, h = unit & 3, row0 = chunk_row0(cq);
    const u16* F = (const u16*)(p.ws() + RB + 4 * COLB); const u16* I = (const u16*)(p.ws() + RB + 5 * COLB);
    const u16* St = (const u16*)(p.ws() + RA) + (size_t)unit * 16384;
    const int k = tid & 127, seg = tid >> 7;
    { const float* lbp = p.in(13) + h * 128 + k; L.lbx[0] = lbp[0]; L.lbx[1] = lbp[512]; L.lbx[2] = lbp[1024]; L.lbx[3] = lbp[1536]; }
#pragma unroll
    for (int i = 0; i < 16; ++i) L.z[i] = F[(size_t)(row0 + seg * 16 + i) * 512 + h * 128 + k];
    { const int s = tid & 63, cg = tid >> 6;
#pragma unroll
        for (int i = 0; i < 2; ++i) L.v[i] = *(const u32x4*)(I + (size_t)(row0 + s) * 512 + h * 128 + cg * 16 + i * 8); }
#pragma unroll
    for (int i = 0; i < 4; ++i) { const int c = tid + i * 512, r = c >> 4, cc = (c & 15) * 8; L.st[i] = *(const u32x4*)(St + r * 128 + cc); }
}
__device__ __forceinline__ void hgrn_c_unit(const Ctx p, LAS unsigned char* lds, int l, int unit, int next_unit, HcIn& L, int wrf = 1) {
    const int tid = otid(), wid = tid >> 6, lane = tid & 63, fr = lane & 15, fq = lane >> 4;
    const int cq = unit >> 2, h = unit & 3, row0 = chunk_row0(cq);
    u16* Q = (u16*)(p.ws() + RB + 3 * COLB); const u16* GG = (const u16*)(p.ws() + RB + 6 * COLB);
    u16 qv[16], gg[4][4]; float ogv[4];
#pragma unroll
    for (int i = 0; i < 16; ++i) qv[i] = Q[(size_t)(row0 + (tid >> 7) * 16 + i) * 512 + h * 128 + (tid & 127)];
    { const int tt = wid & 3, nh = wid >> 2; const float* og = p.in(14) + l * 128;
#pragma unroll
        for (int n = 0; n < 4; ++n) { const int v = (nh * 4 + n) * 16 + fr; ogv[n] = og[v];
#pragma unroll
            for (int j = 0; j < 4; ++j) gg[j][n] = GG[(size_t)(row0 + tt * 16 + fq * 4 + j) * 512 + h * 128 + v]; } }
    LAS float* segtot = (LAS float*)lds; LAS float* red = (LAS float*)(lds + 2560);
    LAS u16* Qi = (LAS u16*)(lds + 4096); LAS u16* Qh = (LAS u16*)(lds + 21504); LAS u16* Kh = (LAS u16*)(lds + 38912);
    LAS u16* Vt = (LAS u16*)(lds + 56320); LAS u16* Sl = (LAS u16*)(lds + 74752); LAS u16* P = (LAS u16*)(lds + 109568);
    constexpr int LDK = 136, LDS_ = 72;
    const int k = tid & 127, seg = tid >> 7;
    float lb;
    { const float x0 = L.lbx[0], x1 = L.lbx[1], x2 = L.lbx[2], x3 = L.lbx[3]; const float m = fmaxf(fmaxf(x0, x1), fmaxf(x2, x3));
      const float e0 = __expf(x0 - m), e1 = __expf(x1 - m), e2 = __expf(x2 - m), e3 = __expf(x3 - m);
      float num = 0.f; if (l >= 1) num += e1; if (l >= 2) num += e2; if (l >= 3) num += e3; lb = num / (e0 + e1 + e2 + e3); }
    float lf[16], kk[16]; float run = 0.f;
#pragma unroll
    for (int i = 0; i < 16; ++i) { const float z = (float)__builtin_bit_cast(_Float16, L.z[i]);
        const float sg = fsig(z); const float f = lb + (1.0f - lb) * sg; kk[i] = 1.0f - f; run += __logf(fmaxf(f, 1e-30f)); lf[i] = run; }
    segtot[seg * 128 + k] = run;
    { const int s = tid & 63, cg = tid >> 6;
#pragma unroll
        for (int i = 0; i < 2; ++i) { const u32x4 w = L.v[i]; LAS u16* vp = Vt + (cg * 16 + i * 8) * LDS_ + s;
            vp[0] = (u16)(w.x & 0xffff); vp[LDS_] = (u16)(w.x >> 16); vp[2 * LDS_] = (u16)(w.y & 0xffff); vp[3 * LDS_] = (u16)(w.y >> 16);
            vp[4 * LDS_] = (u16)(w.z & 0xffff); vp[5 * LDS_] = (u16)(w.z >> 16); vp[6 * LDS_] = (u16)(w.w & 0xffff); vp[7 * LDS_] = (u16)(w.w >> 16); } }
#pragma unroll
    for (int i = 0; i < 4; ++i) { const int c = tid + i * 512, r = c >> 4, cc = (c & 15) * 8; *(LAS u32x4*)(Sl + r * LDK + cc) = L.st[i]; }
    if (next_unit < 2080) hc_load(p, l, next_unit, L);
    __syncthreads();
    { const float t0 = segtot[k], t1 = segtot[128 + k], t2 = segtot[256 + k];
        const float off = seg == 0 ? 0.f : (seg == 1 ? t0 : (seg == 2 ? t0 + t1 : t0 + t1 + t2)); const float bref = t0 + t1;
#pragma unroll
        for (int i = 0; i < 16; ++i) { const int s = seg * 16 + i; const float b = off + lf[i]; const float q = bf2f(qv[i]);
            Qi[s * LDK + k] = f2bf(q * __expf(b)); Qh[s * LDK + k] = f2bf(q * __expf(b - bref)); Kh[s * LDK + k] = f2bf(kk[i] * __expf(bref - b)); } }
    __syncthreads();
    {
        const int tt = wid >> 1;
#pragma unroll
        for (int q2 = 0; q2 < 2; ++q2) { const int stl = (wid & 1) * 2 + q2; f32x4 acc = (f32x4){0.f, 0.f, 0.f, 0.f};
            if (stl <= tt) {
#pragma unroll
                for (int ks = 0; ks < 4; ++ks) acc = MFMA16(ldsfrag(Qh, tt * 16 + fr, LDK, ks * 32 + fq * 8), ldsfrag(Kh, stl * 16 + fr, LDK, ks * 32 + fq * 8), acc); }
#pragma unroll
            for (int j = 0; j < 4; ++j) { const int t = tt * 16 + fq * 4 + j, s = stl * 16 + fr; P[t * LDS_ + s] = (stl <= tt && s <= t) ? f2bf(acc[j]) : (u16)0; } }
    }
    __syncthreads();
    { const int tt = wid & 3, nh = wid >> 2; f32x4 acc[4];
#pragma unroll
        for (int n = 0; n < 4; ++n) acc[n] = (f32x4){0.f, 0.f, 0.f, 0.f};
#pragma unroll
        for (int ks = 0; ks < 4; ++ks) { const bf16x8 a = ldsfrag(Qi, tt * 16 + fr, LDK, ks * 32 + fq * 8);
#pragma unroll
            for (int n = 0; n < 4; ++n) acc[n] = MFMA16(a, ldsfrag(Sl, (nh * 4 + n) * 16 + fr, LDK, ks * 32 + fq * 8), acc[n]); }
#pragma unroll
        for (int ks = 0; ks < 2; ++ks) { const bf16x8 a = ldsfrag(P, tt * 16 + fr, LDS_, ks * 32 + fq * 8);
#pragma unroll
            for (int n = 0; n < 4; ++n) acc[n] = MFMA16(a, ldsfrag(Vt, (nh * 4 + n) * 16 + fr, LDS_, ks * 32 + fq * 8), acc[n]); }
        float ssq[4];
#pragma unroll
        for (int j = 0; j < 4; ++j) { float s = 0.f;
#pragma unroll
            for (int n = 0; n < 4; ++n) s += acc[n][j] * acc[n][j];
            s += __shfl_xor(s, 1); s += __shfl_xor(s, 2); s += __shfl_xor(s, 4); s += __shfl_xor(s, 8); ssq[j] = s; }
        if (fr == 0) {
#pragma unroll
            for (int j = 0; j < 4; ++j) red[nh * 64 + tt * 16 + fq * 4 + j] = ssq[j]; }
        __syncthreads();
#pragma unroll
        for (int j = 0; j < 4; ++j) { const int t = tt * 16 + fq * 4 + j; const float r = rsqrtf((red[t] + red[64 + t]) * (1.0f / 128.0f) + EPS);
#pragma unroll
            for (int n = 0; n < 4; ++n) { const int v = (nh * 4 + n) * 16 + fr; const size_t idx = (size_t)(row0 + t) * 512 + h * 128 + v;
                const u16 ov = f2bf(acc[n][j] * r * ogv[n] * bf2f(gg[j][n])); if (wrf) Q[idx] = ov; } }
    }
    __syncthreads();
}

template <int W> __device__ __forceinline__ void pool_rows(const u32x4 (&x)[31], int t0q, int nvalid, u16* ob) {
    float s[8];
#pragma unroll
    for (int e = 0; e < 8; ++e) s[e] = 0.f;
#pragma unroll
    for (int j = 16 - W; j < 15; ++j) { const u32x4 v = x[j]; s[0] += bflo(v.x); s[1] += bfhi(v.x); s[2] += bflo(v.y); s[3] += bfhi(v.y); s[4] += bflo(v.z); s[5] += bfhi(v.z); s[6] += bflo(v.w); s[7] += bfhi(v.w); }
#pragma unroll
    for (int i = 0; i < 16; ++i) { const u32x4 v = x[15 + i]; const float xv[8] = {bflo(v.x), bfhi(v.x), bflo(v.y), bfhi(v.y), bflo(v.z), bfhi(v.z), bflo(v.w), bfhi(v.w)};
        const int avail = t0q + i + 1 + nvalid; const float rc = 1.0f / (float)(avail < W ? avail : W);
        float o[8];
#pragma unroll
        for (int e = 0; e < 8; ++e) { s[e] += xv[e]; o[e] = s[e] * rc - xv[e]; }
        u32x4 w; w.x = cvt_pk_bf16(o[0], o[1]); w.y = cvt_pk_bf16(o[2], o[3]); w.z = cvt_pk_bf16(o[4], o[5]); w.w = cvt_pk_bf16(o[6], o[7]);
        *(u32x4*)(ob + (size_t)i * 512) = w;
        const u32x4 r = x[15 + i - (W - 1)];
        s[0] -= bflo(r.x); s[1] -= bfhi(r.x); s[2] -= bflo(r.y); s[3] -= bfhi(r.y); s[4] -= bflo(r.z); s[5] -= bfhi(r.z); s[6] -= bflo(r.w); s[7] -= bfhi(r.w); }
}
__device__ __forceinline__ void pool_pass(const Ctx p, int l) {
    const int tid = otid(), lane = tid & 63, cgp = lane & 15, rq = lane >> 4;
    const u16* XB = (const u16*)(p.ws() + RB + 2 * COLB); u16* OB = (u16*)(p.ws() + RB + COLB);
    const int u0 = obid() * 8 + (tid >> 6), ustride = ogdim() * 8;
    for (int unit = u0; unit < NCH64 * 4; unit += ustride) {
        const int cq = unit >> 2, g = unit & 3, row0 = chunk_row0(cq);
        const bool samp = cq >= 512; const int bs = cq - 512; const int t0 = samp ? 0 : (cq & 255) * 64;
        const int t0q = t0 + rq * 16;
        const int col = g * 128 + cgp * 8;
        u32x4 x[31];
#pragma unroll
        for (int j = 0; j < 31; ++j) { const int tk = t0q - 15 + j;
            if (tk >= 0) x[j] = *(const u32x4*)(XB + (size_t)(row0 + rq * 16 - 15 + j) * 512 + col);
            else if (samp) { const float* sp = p.in(2) + ((size_t)(l * 8 + bs) * 15 + (15 + tk)) * 512 + col; const float4 a = *(const float4*)sp, b = *(const float4*)(sp + 4);
                x[j].x = cvt_pk_bf16(a.x, a.y); x[j].y = cvt_pk_bf16(a.z, a.w); x[j].z = cvt_pk_bf16(b.x, b.y); x[j].w = cvt_pk_bf16(b.z, b.w); }
            else x[j] = (u32x4){0u, 0u, 0u, 0u}; }
        u16* ob = OB + (size_t)(row0 + rq * 16) * 512 + col; const int nvalid = samp ? 15 : 0;
        if (g == 0) pool_rows<2>(x, t0q, nvalid, ob); else if (g == 1) pool_rows<4>(x, t0q, nvalid, ob); else if (g == 2) pool_rows<8>(x, t0q, nvalid, ob); else pool_rows<16>(x, t0q, nvalid, ob);
        if ((samp || t0 == 16320) && rq == 3) { float* po = (samp ? p.out() + O_POOLS + ((size_t)(l * 8 + bs) * 15) * 512 : p.out() + O_POOLP + ((size_t)(l * 2 + (cq >> 8)) * 15) * 512) + col;
#pragma unroll
            for (int j = 0; j < 15; ++j) { const u32x4 v = x[16 + j]; float* q = po + (size_t)j * 512;
                *(float4*)q = (float4){bflo(v.x), bfhi(v.x), bflo(v.y), bfhi(v.y)}; *(float4*)(q + 4) = (float4){bflo(v.z), bfhi(v.z), bflo(v.w), bfhi(v.w)}; } }
    }
}

#define XB_TMO      128
#define XB_XCNT(j)  (256  + 64 * (j))
#define XB_XSUB(j)  (1280 + 64 * (j))
#define XB_XGEN(j)  (2304 + 64 * (j))
#define XB_TOP      3328
#define XB_TOPGEN   3392
#define XCD_BAR_WORDS 3456
#define XB_SPIN_CAP (1u << 20)
__device__ __forceinline__ unsigned xb_ld(unsigned* p)              { return __hip_atomic_load(p, __ATOMIC_RELAXED, __HIP_MEMORY_SCOPE_AGENT); }
__device__ __forceinline__ unsigned xb_add(unsigned* p, unsigned v) { return __hip_atomic_fetch_add(p, v, __ATOMIC_RELAXED, __HIP_MEMORY_SCOPE_AGENT); }
__device__ __forceinline__ unsigned xb_xcc_id() { return (unsigned)__builtin_amdgcn_s_getreg((3 << 11) | 20) & 0xFu; }
#define XB_SPIN(cond, bar) do { unsigned _sp = 0; while (cond) { __builtin_amdgcn_s_sleep(1); \
    if ((++_sp & 255u) == 0u) { if (xb_ld(&(bar)[XB_TMO])) break; if (_sp > XB_SPIN_CAP) { atomicAdd(&(bar)[XB_TMO], 1u); break; } } } } while (0)
__device__ __forceinline__ void xcd_barrier_complete(unsigned* bar, unsigned x, unsigned& nloc, unsigned& nx) {
    const unsigned G = gridDim.x;
    unsigned sum, cnt, mine, sp = 0u;
    for (;;) {
        sum = 0u; cnt = 0u; mine = 0u;
#pragma unroll
        for (unsigned j = 0; j < 16; ++j) { const unsigned c = xb_ld(&bar[XB_XCNT(j)]); sum += c; cnt += (c > 0u) ? 1u : 0u; mine = (j == x) ? c : mine; }
        if (sum == G) break;
        __builtin_amdgcn_s_sleep(1);
        if ((++sp & 255u) == 0u) { if (xb_ld(&bar[XB_TMO])) break; if (sp > XB_SPIN_CAP) { atomicAdd(&bar[XB_TMO], 1u); break; } }
    }
    nloc = mine > 0u ? mine : 1u; nx = cnt > 0u ? cnt : 1u;
}
__device__ __forceinline__ void xcd_barrier(unsigned* bar, volatile LAS unsigned* st) {
    asm volatile("s_waitcnt vmcnt(0)" ::: "memory");
    __syncthreads();
    if (threadIdx.x == 0) {
        const unsigned x = xb_xcc_id();
        __builtin_amdgcn_s_waitcnt(0);
        unsigned nloc = st[0], nx = st[1];
        if (nloc == 0u) { xcd_barrier_complete(bar, x, nloc, nx); st[0] = nloc; st[1] = nx; }
        const unsigned old = xb_add(&bar[XB_XSUB(x)], 1u);
        const unsigned gen = old / nloc;
        if (old + 1u == (gen + 1u) * nloc) {
            __builtin_amdgcn_fence(__ATOMIC_RELEASE, "agent");
            asm volatile("s_waitcnt vmcnt(0)" ::: "memory");
            const unsigned og = xb_add(&bar[XB_TOP], 1u);
            const unsigned tg = og / nx;
            if (og + 1u == (tg + 1u) * nx) xb_add(&bar[XB_TOPGEN], 1u);
            else XB_SPIN(xb_ld(&bar[XB_TOPGEN]) == tg, bar);
            __builtin_amdgcn_fence(__ATOMIC_ACQUIRE, "agent");
            xb_add(&bar[XB_XGEN(x)], 1u);
            asm volatile("s_waitcnt vmcnt(0)" ::: "memory");
        } else {
            XB_SPIN(xb_ld(&bar[XB_XGEN(x)]) == gen, bar);
            __builtin_amdgcn_fence(__ATOMIC_ACQUIRE, "agent");
            asm volatile("s_waitcnt vmcnt(0)" ::: "memory");
        }
    }
    __syncthreads();
}

__global__ void __launch_bounds__(512, 2) fwd_mega(Params kp) {
    extern __shared__ __attribute__((aligned(16))) unsigned char lds_raw[];
    LAS unsigned char* lds = (LAS unsigned char*)lds_raw;
    cg::grid_group grid = cg::this_grid();
    { LAS unsigned* pw = (LAS unsigned*)(lds + 131072); const unsigned* src = (const unsigned*)&kp; if (threadIdx.x < sizeof(Params) / 4) pw[threadIdx.x] = src[threadIdx.x];
      if (threadIdx.x >= 128 && threadIdx.x < 132) pw[threadIdx.x] = 0u; }
    __syncthreads();
    volatile LAS unsigned* bst = (volatile LAS unsigned*)(lds + 131072 + 512);
    if (threadIdx.x == 0) (void)xb_add(&((unsigned*)(kp.ws + RBAR))[XB_XCNT(xb_xcc_id())], 1u);
    Ctx p; p.pl = (LAS const unsigned*)(lds + 131072);
    const int ph_lo = __builtin_amdgcn_readfirstlane(p.pl[42]), ph_hi = __builtin_amdgcn_readfirstlane(p.pl[43]);
    unsigned long long tp_prev = 0, tp_acc = 0; int tp_sel = 0;
    for (int ph = ph_lo; ph < ph_hi; ++ph) {
        if (ph > ph_lo) { if (ph == ph_lo + 1) grid.sync(); else xcd_barrier((unsigned*)(p.ws() + RBAR), bst); }
        if (TPM) { const unsigned long long now = __builtin_amdgcn_s_memrealtime(); if (tp_sel) tp_acc += now - tp_prev; tp_prev = now; tp_sel = ph == 0 ? (TPM & 1) : ((TPM >> ((ph - 1) % 13 + 1)) & 1); }
        const int G = osgpr((int)gridDim.x), c = osgpr((int)blockIdx.x);
        if (ph == 0) {
            rownorm_phase(p, true, 0.f, nullptr, p.in(4), true, 0);
            convert_ffn(p, lds, c, G, p.in(5), p.in(6), RWF);
            convert_mix(p, lds, c, G, 0);
            continue;
        }
        const int l = (ph - 1) / 13, s = (ph - 1) % 13 + 1;
        unsigned char* ws = p.ws_flat();
        switch (s) {
        case 1: case 11: if (PHM & 1) {
            const size_t wf = s == 1 ? RWF : RWF2;
            pg8::SchedPlain S; S.o.init(MROWS / 256, NGU / 256, G, c); S.A = (const char*)(ws + RA); S.B = (const char*)(ws + wf); S.at = (size_t)256 * 1024 * 2; S.bt = (size_t)256 * 1024 * 2; S.nt = 16; S.ns = 0; S.nseg = 0; S.Asplit = nullptr;
            pg8::EpiGU E{(u16*)(ws + RB)};
            REP(0) pg8::gemm_phase(lds, 1024, 1024, 1024, S, E);
            const int extra = S.o.nwg % G;
            if (c >= extra) {
                if (s == 1) convert_ffn(p, lds, c - extra, G - extra, p.in(17) + (size_t)l * 1024 * NGU, p.in(18) + (size_t)l * DFF * 1024, RWF2);
                else if (l < DEPTH - 1) convert_mix(p, lds, c - extra, G - extra, l + 1);
            }
        } break;
        case 2: case 12: if (PHM & 2) {
            pg8::SchedPlain S; S.o.init(MP / 256, 4, G, c); S.A = (const char*)(ws + RB); S.B = (const char*)(ws + (s == 2 ? RWF : RWF2) + (RWF_DN - RWF)); S.at = (size_t)256 * DFF * 2; S.bt = (size_t)256 * DFF * 2; S.nt = DFF / 64; S.ns = 11; S.nseg = 0; S.Asplit = nullptr;
            pg8::EpiF32 E{(u16*)(ws + RC), 1024, (float*)(ws + RYP)};
            REP(1) pg8::gemm_phase(lds, DFF, DFF, DFF, S, E);
        } break;
        case 3: if (PHM & 4) { const float* gains = p.in(4) + (size_t)l * 6 * 1024; REP(11) rownorm_phase(p, false, rep_ ? 0.f : 0.5f, gains + 1024, gains + 2048, true, 11); } break;
        case 4: if (PHM & 8) {
            pg8::SchedPlain S; S.o.init(MROWS / 256, NIN / 256, G, c); S.A = (const char*)(ws + RA); S.B = (const char*)(ws + RWM); S.at = (size_t)256 * 1024 * 2; S.bt = (size_t)256 * 1024 * 2; S.nt = 16; S.ns = 0; S.nseg = 0; S.Asplit = nullptr;
            pg8::EpiIN E{(u16*)(ws + RB), (u16*)(ws + RC)};
            REP(2) pg8::gemm_phase(lds, 1024, 1024, 1024, S, E);
            const int extra = S.o.nwg % G;
            if (c >= extra && l < DEPTH - 1) convert_ffn(p, lds, c - extra, G - extra, p.in(5) + (size_t)(l + 1) * 1024 * NGU, p.in(6) + (size_t)(l + 1) * DFF * 1024, RWF);
        } break;
        case 5: { int it = c;
                    for (; it < 1056; it += G) { if (PHM & 16) REP(8) gmlp_unit(p, lds, l, it, osgpr(rep_ == 0 ? 1 : 0)); }
                    if (PHM & 32) { HaIn A; ha_load(p, it - 1056 < 2080 ? it - 1056 : 0, A);
                        for (; it < 1056 + 2080; it += G) hgrn_a_unit(p, lds, l, it - 1056, it + G - 1056, A); } } break;
        case 6: if (PHM & 64) REP(9) hgrn_scan_phase(p, l, osgpr(rep_ == 0 ? 1 : 0)); break;
        case 7: if (PHM & 128) { int it = c; HcIn A; hc_load(p, l, it < 2080 ? it : 0, A);
                    for (; it < 2080; it += G) hgrn_c_unit(p, lds, l, it, it + G, A, 1); }
                if (PHM & 256) REP(6) pool_pass(p, l); break;
        case 8: if (PHM & 512) {
            pg8::SchedPlain S; S.o.init(MP / 256, 4, G, c); S.A = (const char*)(ws + RB); S.B = (const char*)(ws + RWM_BR); S.at = (size_t)256 * 512 * 2; S.bt = (size_t)256 * 1536 * 2; S.nt = 24; S.ns = 0; S.nseg = 3; S.Asplit = nullptr;
            pg8::EpiBranch E{(const u16*)(ws + RC), (u16*)(ws + RA), (float*)(ws + RB + 2 * COLB)};
            REP(3) pg8::gemm_phase(lds, 1536, 512, 1536, S, E);
        } break;
        case 9: if (PHM & 1024) {
            if (c < 32) {
                const int tile = c >> 2, j = c & 3, pms = tile >> 2; const int tid = otid();
                const float* Pp = (const float*)(ws + RB + 2 * COLB); u16* blk = (u16*)(ws + RB + 4 * COLB + (size_t)c * (512 * 1024));
#pragma unroll 4
                for (int e = tid; e < 8192; e += 512) { const int r = e >> 5, col = j * 256 + (e & 31) * 8; const float* sp = Pp + (size_t)(pms * 256 + r) * 1024 + col;
                    float4 a = *(const float4*)sp, b = *(const float4*)(sp + 4);
#pragma unroll
                    for (int q = 1; q < 3; ++q) { const float4 a2 = *(const float4*)(sp + (size_t)q * 512 * 1024), b2 = *(const float4*)(sp + (size_t)q * 512 * 1024 + 4);
                        a.x += a2.x; a.y += a2.y; a.z += a2.z; a.w += a2.w; b.x += b2.x; b.y += b2.y; b.z += b2.z; b.w += b2.w; }
                    u32x4 w; w.x = cvt_pk_bf16(a.x, a.y); w.y = cvt_pk_bf16(a.z, a.w); w.z = cvt_pk_bf16(b.x, b.y); w.w = cvt_pk_bf16(b.z, b.w);
                    *(u32x4*)(blk + (size_t)r * 1024 + col) = w; }
                asm volatile("s_waitcnt vmcnt(0)" ::: "memory");
            }
            __syncthreads();
            pg8::SchedPlain S; S.o.init(MP / 256, 4, G, c); S.A = (const char*)(ws + RA); S.B = (const char*)(ws + RWM_OUT); S.at = (size_t)256 * 1024 * 2; S.bt = (size_t)256 * 1024 * 2; S.nt = 16; S.ns = 4; S.nseg = 0; S.Asplit = (const char*)(ws + RB + 4 * COLB);
            pg8::EpiF32 E{(u16*)(ws + RC), 1024, (float*)(ws + RYP)};
            REP(4) pg8::gemm_phase(lds, 1024, 1024, 1024, S, E);
        } break;
        case 10: { const float* gains = p.in(4) + (size_t)l * 6 * 1024; REP(11) rownorm_phase(p, false, rep_ ? 0.f : 1.0f, gains + 3 * 1024, gains + 4 * 1024, true, 4); } break;
        case 13: { const float* gains = p.in(4) + (size_t)l * 6 * 1024; REP(11) rownorm_phase(p, false, rep_ ? 0.f : 0.5f, gains + 5 * 1024, gains + (l < DEPTH - 1 ? 6 * 1024 : 0), l < DEPTH - 1, 11); } break;
        }
    }
    if (TPM) { unsigned long long now = __builtin_amdgcn_s_memrealtime(); if (tp_sel) tp_acc += now - tp_prev;
        if (blockIdx.x == 0 && threadIdx.x == 0) { const unsigned long long t0 = now; while (__builtin_amdgcn_s_memrealtime() - t0 < TMULT * tp_acc) __builtin_amdgcn_s_sleep(8); } }
}

constexpr int N_PHASES = 1 + 13 * DEPTH;

extern "C" void kernel_launch(void* const* d_in, const int* in_sizes, int n_in, void* d_out, int out_size, void* d_ws, size_t ws_size, hipStream_t stream) {
    static int grid = 0;
    if (grid == 0) {
        if (n_in != 19 || ws_size < WS_END) { fprintf(stderr, "kernel_launch: need 19 inputs and %zu bytes of workspace (got %d, %zu)\n", (size_t)WS_END, n_in, ws_size); grid = -1; return; }
        int dev = 0, cus = 0, per_cu = 0;
        hipGetDevice(&dev); hipDeviceGetAttribute(&cus, hipDeviceAttributeMultiprocessorCount, dev);
        hipFuncSetAttribute((const void*)fwd_mega, hipFuncAttributeMaxDynamicSharedMemorySize, LDS_BYTES);
        hipOccupancyMaxActiveBlocksPerMultiprocessor(&per_cu, (const void*)fwd_mega, 512, LDS_BYTES);
        if (per_cu < 1) { fprintf(stderr, "kernel_launch: occupancy query says %d blocks per CU\n", per_cu); per_cu = 1; }
        (void)hipGetLastError();
        grid = cus * per_cu;
    }
    if (grid < 0) return;
    Params p{};
    for (int i = 0; i < 19; ++i) p.in[i] = (const float*)d_in[i];
    p.out = (float*)d_out; p.ws = (unsigned char*)d_ws;
    (void)hipMemsetAsync((unsigned char*)d_ws + RBAR, 0, 3456 * 4, stream);
#if MULTI_LAUNCH
    for (int ph = 0; ph < N_PHASES; ++ph) { p.ph_lo = ph; p.ph_hi = ph + 1; hipLaunchKernelGGL(fwd_mega, dim3(grid), dim3(512), LDS_BYTES, stream, p); }
#else
    p.ph_lo = 0; p.ph_hi = N_PHASES;
    void* args[] = {&p};
    hipError_t e = hipLaunchCooperativeKernel((const void*)fwd_mega, dim3(grid), dim3(512), args, LDS_BYTES, stream);
    if (e != hipSuccess) fprintf(stderr, "cooperative launch failed: %s (grid %d)\n", hipGetErrorString(e), grid);
#endif
}
```

```cpp
#include <hip/hip_runtime.h>
#include <hip/hip_cooperative_groups.h>
#include <cstdio>
namespace cg = cooperative_groups;

#define LAS __attribute__((address_space(3)))
typedef unsigned short u16;
typedef short bf16x8 __attribute__((ext_vector_type(8)));
typedef float f32x4 __attribute__((ext_vector_type(4)));
typedef unsigned u32x4 __attribute__((ext_vector_type(4)));
typedef unsigned u32x2 __attribute__((ext_vector_type(2)));
typedef _Float16 h16x2 __attribute__((ext_vector_type(2)));

#ifndef PHM
#define PHM 0xffff
#endif
#ifndef DUP
#define DUP 0x0
#endif
#define REP(bit) for (int rep_ = 0; rep_ <= ((DUP >> (bit)) & 1); ++rep_)
#ifndef TPM
#define TPM 0
#endif
#define TMULT 4
#ifndef SPLITK
#define SPLITK 1
#endif
#ifndef USE_SP2
#define USE_SP2 1
#endif
#ifndef USE_ALIGN
#define USE_ALIGN 1
#endif
#ifndef MULTI_LAUNCH
#define MULTI_LAUNCH 0
#endif

constexpr int MROWS = 33280, MP = 32768, DM = 1024, DFF = 2816, NGU = 5632, NIN = 6656, DEPTH = 4;
constexpr int NCH64 = MROWS / 64;
constexpr float EPS = 1e-6f;
constexpr size_t O_POOLP = 34078720, O_POOLS = 34140160, O_HGP = 34385920, O_HGS = 34910208, O_VS = 37007360;
constexpr size_t COLB = (size_t)MROWS * 512 * 2;
constexpr size_t RA = 0;
constexpr size_t RB = RA + (size_t)MROWS * 1024 * 2;
constexpr size_t RC = RB + 7 * COLB;
constexpr size_t RYP = RC + (size_t)MROWS * 1024 * 4;
constexpr size_t RWF = RC + (size_t)MROWS * 3072 * 2;
constexpr size_t RWF_DN = RWF + (size_t)NGU * 1024 * 2;
constexpr size_t RWM = RWF_DN + (size_t)1024 * DFF * 2;
constexpr size_t RWM_BR = RWM + (size_t)NIN * 1024 * 2;
constexpr size_t RWM_OUT = RWM_BR + (size_t)1024 * 1536 * 2;
constexpr size_t RWM_POOL = RWM_OUT + (size_t)1024 * 1024 * 2;
constexpr size_t RSM = RWM_POOL + (size_t)4 * 128 * 128 * 2;
constexpr size_t RBAR = RSM + (size_t)NCH64 * 4 * 128 * 4;
constexpr size_t RWF2 = RBAR + 3456 * 4 + 256;
constexpr size_t WS_END = RWF2 + (RWF_DN - RWF) + (size_t)1024 * DFF * 2;
constexpr int LDS_BYTES = 131072 + 2048;

struct Params { const float* in[19]; float* out; unsigned char* ws; int ph_lo, ph_hi; };
struct Ctx {
    LAS const unsigned* pl;
    __device__ __forceinline__ unsigned long long q(int k) const { const unsigned lo = __builtin_amdgcn_readfirstlane(pl[2 * k]), hi = __builtin_amdgcn_readfirstlane(pl[2 * k + 1]); return ((unsigned long long)hi << 32) | lo; }
    __device__ __forceinline__ const float* in(int k) const { return (const float*)(const __attribute__((address_space(1))) float*)q(k); }
    __device__ __forceinline__ float* out() const { return (float*)(__attribute__((address_space(1))) float*)q(19); }
    __device__ __forceinline__ unsigned char* ws() const { return (unsigned char*)(__attribute__((address_space(1))) unsigned char*)q(20); }
    __device__ __forceinline__ unsigned char* ws_flat() const { return (unsigned char*)q(20); }
};

__device__ __forceinline__ float bf2f(unsigned b) { return __uint_as_float(b << 16); }
__device__ __forceinline__ float bflo(unsigned w) { return __uint_as_float(w << 16); }
__device__ __forceinline__ float bfhi(unsigned w) { return __uint_as_float(w & 0xffff0000u); }
__device__ __forceinline__ u16 f2bf(float f) { unsigned u = __float_as_uint(f); u += 0x7FFFu + ((u >> 16) & 1u); return (u16)(u >> 16); }
typedef __bf16 bf16x2_t __attribute__((ext_vector_type(2)));
typedef float f32x2_t __attribute__((ext_vector_type(2)));
__device__ __forceinline__ unsigned cvt_pk_bf16(float lo, float hi) { const f32x2_t v = {lo, hi}; const bf16x2_t r = __builtin_convertvector(v, bf16x2_t); return __builtin_bit_cast(unsigned, r); }
__device__ __forceinline__ float fsig(float x) { return __builtin_amdgcn_rcpf(1.0f + __expf(-x)); }
__device__ __forceinline__ float fsilu(float x) { return x * fsig(x); }
__device__ __forceinline__ float fgelu(float x) { return x * fsig(1.5957691216f * (x + 0.044715f * x * x * x)); }
__device__ __forceinline__ float wave_sum(float v) {
#pragma unroll
    for (int o = 32; o >= 1; o >>= 1) v += __shfl_xor(v, o);
    return v;
}

__device__ __forceinline__ int otid() { int t = threadIdx.x; asm volatile("" : "+v"(t)); return t; }
template <class T> __device__ __forceinline__ T osgpr(T x) { asm volatile("" : "+s"(x)); return x; }
__device__ __forceinline__ int obid() { return osgpr((int)blockIdx.x); }
__device__ __forceinline__ int ogdim() { return osgpr((int)gridDim.x); }

namespace pg8 {
constexpr int BM = 256, BK = 64, HALF = 128, HTB = HALF * BK * 2, STAGE_BYTES = 8 * HTB, NXCD = 8, WGM = 8;
__device__ __forceinline__ int lds_byte(int r, int c) { const int st = (r >> 4) * 2 + (c >> 5), rr = r & 15, cc = c & 31, ob = rr * 64 + cc * 2; return st * 1024 + (ob ^ (((ob >> 9) & 1) << 5)); }
__device__ __forceinline__ void stage_rc(int b, int& R, int& C) { const int st = b / 1024, sb = b % 1024, swz = sb ^ (((sb >> 9) & 1) << 5); R = (st >> 1) * 16 + swz / 64; C = (st & 1) * 32 + (swz % 64) / 2; }
__device__ __forceinline__ int perm32(int rho) { const int n = rho >> 4, i = rho & 15; return 8 * (i >> 2) + 4 * n + (i & 3); }

struct Unit { const char* a; const char* b; int pm, pn, aux, nt; };

struct TileOrder {
    int nM, nN, nwg, G, c;
    __device__ void init(int nM_, int nN_, int G_, int c_) { nM = nM_; nN = nN_; nwg = nM * nN; G = G_; c = c_; }
    __device__ bool tile(int i, int& pm, int& pn) const {
        const long L = (long)i * G + c; if (L >= nwg) return false;
        int wgid = (int)L; { const int q = nwg / NXCD, r = nwg % NXCD, xcd = wgid % NXCD, off = wgid / NXCD; wgid = (xcd < r ? xcd * (q + 1) : r * (q + 1) + (xcd - r) * q) + off; }
        const int nig = WGM * nN, gid = wgid / nig, fm = gid * WGM, gsz = (nM - fm) < WGM ? (nM - fm) : WGM;
        pm = fm + ((wgid % nig) % gsz); pn = (wgid % nig) / gsz; return true;
    }
};
struct SchedPlain {
    TileOrder o; const char* A; const char* B; size_t at, bt;
    int nt;
    int ns;
    int nseg;
    const char* Asplit;
    __device__ bool next(int i, Unit& u) const {
        int pm, pn;
        if (o.tile(i, pm, pn)) { u.a = A + (size_t)pm * at; u.b = B + (size_t)pn * bt; u.pm = pm; u.pn = pn; u.aux = 0; u.nt = nt; return true; }
        const int nfull = (o.nwg - o.c + o.G - 1) / o.G;
        if (i != nfull) return false;
        if (nseg) { if (o.c >= 24) return false;
            const int tile = o.c / 3, sg = o.c - tile * 3, pms = tile >> 2; pn = tile & 3;
            u.a = A + (sg == 0 ? (size_t)0 : (sg == 1 ? COLB : 3 * COLB)) + (size_t)(128 + pms) * at; u.b = B + (size_t)pn * bt + (size_t)sg * 1024; u.pm = pms; u.pn = pn; u.aux = sg + 1; u.nt = 8; return true; }
        if (ns == 0 || o.c >= 8 * ns) return false;
        const int tile = o.c / ns, j = o.c - tile * ns, pms = tile >> 2; pn = tile & 3;
        u.a = (Asplit ? Asplit + (size_t)o.c * (512 * 1024) : A + (size_t)(128 + pms) * at) + (size_t)j * 512; u.b = B + (size_t)pn * bt + (size_t)j * 512; u.pm = pms; u.pn = pn; u.aux = j + 1; u.nt = 4; return true;
    }
};

template <class Epi, class Sched>
__device__ __forceinline__ void gemm_phase(LAS unsigned char* lds, const int K, const int lda, const int ldb, const Sched& S, const Epi& E) {
    const int tid = otid(), wid = __builtin_amdgcn_readfirstlane(tid >> 6), lane = tid & 63, wr = wid >> 2, wc = wid & 3, fr = lane & 15, fq = lane >> 4;
    unsigned voffA[2], voffB[2];
#pragma unroll
    for (int i = 0; i < 2; ++i) { int R, C; stage_rc(tid * 16 + i * 8192, R, C); const int Rb = Epi::PERM ? ((R & ~31) + perm32(R & 31)) : R;
        voffA[i] = (unsigned)(R * lda + C) * 2u; voffB[i] = (unsigned)(Rb * ldb + C) * 2u; }
    const size_t kstep = (size_t)(BK * 2);
    const size_t hstepA = (size_t)HALF * lda * 2, hstepB = (size_t)HALF * ldb * 2;
    const unsigned ldsw = (unsigned)wid * 1024u;
    const int aoff = lds_byte(wr * 64 + fr, fq * 8), boff = lds_byte(wc * 32 + fr, fq * 8);
#define PG8_SA(b, h) (((b) * 2 + (h)) * HTB)
#define PG8_SB(b, h) ((4 + (b) * 2 + (h)) * HTB)
#define PG8_STAGE(bufoff, gbase, voff) do { _Pragma("unroll") for (int _i = 0; _i < 2; ++_i) \
        __builtin_amdgcn_global_load_lds((const unsigned*)((const char*)(gbase) + (voff)[_i]), (LAS unsigned*)(lds + (bufoff) + ldsw + _i * 8192), 16, 0, 0); } while (0)
#define PG8_LDA(dst, b, h) do { _Pragma("unroll") for (int m = 0; m < 4; ++m) _Pragma("unroll") for (int k = 0; k < 2; ++k) dst[m][k] = *(const LAS bf16x8*)(lds + PG8_SA(b, h) + aoff + m * 2048 + k * 1024); } while (0)
#define PG8_LDB(dst, b, h) do { _Pragma("unroll") for (int n = 0; n < 2; ++n) _Pragma("unroll") for (int k = 0; k < 2; ++k) dst[n][k] = *(const LAS bf16x8*)(lds + PG8_SB(b, h) + boff + n * 2048 + k * 1024); } while (0)
#define PG8_MMA(ai, bj, At, Bt) do { __builtin_amdgcn_s_setprio(1); _Pragma("unroll") for (int m = 0; m < 4; ++m) _Pragma("unroll") for (int n = 0; n < 2; ++n) _Pragma("unroll") for (int k = 0; k < 2; ++k) \
        acc[ai][bj][m][n] = __builtin_amdgcn_mfma_f32_16x16x32_bf16(Bt[n][k], At[m][k], acc[ai][bj][m][n], 0, 0, 0); __builtin_amdgcn_s_setprio(0); } while (0)
#define PG8_WAIT_V(n) asm volatile("s_waitcnt vmcnt(" #n ")" ::: "memory")
#define PG8_WAIT_L(n) asm volatile("s_waitcnt lgkmcnt(" #n ")" ::: "memory")
#define PG8_BAR __builtin_amdgcn_s_barrier()
#define PG8_SCHED __builtin_amdgcn_sched_barrier(0)
    Unit cur, nxt; int ui = 0;
    if (!S.next(0, cur)) return;
    f32x4 acc[2][2][4][2];
#pragma unroll
    for (int a = 0; a < 2; ++a)
#pragma unroll
        for (int b = 0; b < 2; ++b)
#pragma unroll
            for (int m = 0; m < 4; ++m)
#pragma unroll
                for (int n = 0; n < 2; ++n) acc[a][b][m][n] = (f32x4){0.f, 0.f, 0.f, 0.f};
    bf16x8 At[4][2], B0[2][2], B1[2][2];
    const char* cA = cur.a; const char* cB = cur.b;
    if constexpr (USE_SP2) {
        PG8_STAGE(PG8_SB(0, 0), cB, voffB); PG8_STAGE(PG8_SB(0, 1), cB + hstepB, voffB); PG8_STAGE(PG8_SA(0, 0), cA, voffA); PG8_STAGE(PG8_SA(0, 1), cA + hstepA, voffA);
        if (wr == 1) PG8_BAR;
        PG8_WAIT_V(2); PG8_BAR;
        PG8_STAGE(PG8_SB(1, 0), cB + kstep, voffB); PG8_STAGE(PG8_SA(1, 0), cA + kstep, voffA); PG8_STAGE(PG8_SB(1, 1), cB + hstepB + kstep, voffB);
        PG8_WAIT_V(6); PG8_BAR;
    } else {
    PG8_STAGE(PG8_SB(0, 0), cB, voffB); PG8_STAGE(PG8_SA(0, 0), cA, voffA); PG8_STAGE(PG8_SB(0, 1), cB + hstepB, voffB); PG8_STAGE(PG8_SA(0, 1), cA + hstepA, voffA);
    if (wr == 1) PG8_BAR;
    PG8_WAIT_V(4); PG8_BAR;
    PG8_STAGE(PG8_SB(1, 0), cB + kstep, voffB); PG8_STAGE(PG8_SA(1, 0), cA + kstep, voffA); PG8_STAGE(PG8_SB(1, 1), cB + hstepB + kstep, voffB);
    PG8_WAIT_V(6); PG8_BAR;
    }
    for (;;) {
        const bool has_next = S.next(ui + 1, nxt);
        const char* nA = has_next ? nxt.a : cA; const char* nB = has_next ? nxt.b : cB;
        const int nt = cur.nt;
        for (int t = 0; t < nt; t += 2) {
            const bool last = (t == nt - 2);
            if constexpr (Epi::SEG) { if (t == 8 || t == 16) E.rescale(acc, cur, t >> 3, wr, wc, fr, fq); }
            const char* a1 = cA + (size_t)(t + 1) * kstep + (Epi::SEG ? Epi::segoff(t >> 3) : (size_t)0);
            const char* a2 = last ? nA : cA + (size_t)(t + 2) * kstep + (Epi::SEG ? Epi::segoff((t + 2) >> 3) : (size_t)0); const char* b2 = last ? nB : cB + (size_t)(t + 2) * kstep;
            const char* a3 = a2 + kstep; const char* b3 = b2 + kstep;
            if constexpr (USE_SP2) {
            PG8_LDB(B0, 0, 0); PG8_LDB(B1, 0, 1); PG8_SCHED; PG8_LDA(At, 0, 0); PG8_STAGE(PG8_SA(1, 1), a1 + hstepA, voffA);
            PG8_WAIT_V(8); PG8_WAIT_L(0); PG8_BAR; PG8_MMA(0, 0, At, B0); PG8_MMA(0, 1, At, B1); PG8_BAR; PG8_SCHED;
            PG8_LDA(At, 0, 1); PG8_STAGE(PG8_SB(0, 0), b2, voffB); PG8_STAGE(PG8_SB(0, 1), b2 + hstepB, voffB); PG8_STAGE(PG8_SA(0, 0), a2, voffA);
            PG8_WAIT_V(8); PG8_WAIT_L(0); PG8_BAR; PG8_MMA(1, 0, At, B0); PG8_MMA(1, 1, At, B1); PG8_BAR; PG8_SCHED;
            PG8_LDB(B0, 1, 0); PG8_LDB(B1, 1, 1); PG8_SCHED; PG8_LDA(At, 1, 0); PG8_STAGE(PG8_SA(0, 1), a2 + hstepA, voffA);
            PG8_WAIT_V(8); PG8_WAIT_L(0); PG8_BAR; PG8_MMA(0, 0, At, B0); PG8_MMA(0, 1, At, B1); PG8_BAR; PG8_SCHED;
            PG8_LDA(At, 1, 1); PG8_STAGE(PG8_SB(1, 0), b3, voffB); PG8_STAGE(PG8_SB(1, 1), b3 + hstepB, voffB); PG8_STAGE(PG8_SA(1, 0), a3, voffA);
            PG8_WAIT_V(8); PG8_WAIT_L(0); PG8_BAR; PG8_MMA(1, 0, At, B0); PG8_MMA(1, 1, At, B1); PG8_BAR; PG8_SCHED;
            } else {
            PG8_LDB(B0, 0, 0); PG8_SCHED; PG8_LDA(At, 0, 0); PG8_STAGE(PG8_SA(1, 1), a1 + hstepA, voffA);
            PG8_WAIT_L(8); PG8_BAR; PG8_WAIT_L(0); PG8_MMA(0, 0, At, B0); PG8_BAR; PG8_SCHED;
            PG8_LDB(B1, 0, 1); PG8_STAGE(PG8_SB(0, 0), b2, voffB);
            PG8_BAR; PG8_WAIT_L(0); PG8_MMA(0, 1, At, B1); PG8_BAR;
            PG8_LDA(At, 0, 1); PG8_STAGE(PG8_SA(0, 0), a2, voffA);
            PG8_BAR; PG8_WAIT_L(0); PG8_MMA(1, 0, At, B0); PG8_BAR; PG8_SCHED;
            PG8_STAGE(PG8_SB(0, 1), b2 + hstepB, voffB);
            PG8_WAIT_V(6); PG8_BAR; PG8_MMA(1, 1, At, B1); PG8_BAR;
            PG8_LDB(B0, 1, 0); PG8_SCHED; PG8_LDA(At, 1, 0); PG8_STAGE(PG8_SA(0, 1), a2 + hstepA, voffA);
            PG8_WAIT_L(8); PG8_BAR; PG8_WAIT_L(0); PG8_MMA(0, 0, At, B0); PG8_BAR; PG8_SCHED;
            PG8_LDB(B1, 1, 1); PG8_STAGE(PG8_SB(1, 0), b3, voffB);
            PG8_BAR; PG8_WAIT_L(0); PG8_MMA(0, 1, At, B1); PG8_BAR;
            PG8_LDA(At, 1, 1); PG8_STAGE(PG8_SA(1, 0), a3, voffA);
            PG8_BAR; PG8_WAIT_L(0); PG8_MMA(1, 0, At, B0); PG8_BAR; PG8_SCHED;
            PG8_STAGE(PG8_SB(1, 1), b3 + hstepB, voffB);
            PG8_WAIT_V(6); PG8_BAR; PG8_MMA(1, 1, At, B1); PG8_BAR;
            }
        }
        if constexpr (USE_ALIGN) { if (wr == 0) PG8_BAR; }
        E(acc, cur, wr, wc, fr, fq);
        if (!has_next) break;
#pragma unroll
        for (int a = 0; a < 2; ++a)
#pragma unroll
            for (int b = 0; b < 2; ++b)
#pragma unroll
                for (int m = 0; m < 4; ++m)
#pragma unroll
                    for (int n = 0; n < 2; ++n) acc[a][b][m][n] = (f32x4){0.f, 0.f, 0.f, 0.f};
        cur = nxt; cA = nA; cB = nB; ++ui;
        if constexpr (USE_ALIGN) { if (wr == 1) PG8_BAR; }
    }
    PG8_WAIT_V(0);
    if constexpr (!USE_ALIGN) { if (wr == 0) PG8_BAR; }
    PG8_BAR;
    asm volatile("" ::: "memory");
#undef PG8_SA
#undef PG8_SB
#undef PG8_STAGE
#undef PG8_LDA
#undef PG8_LDB
#undef PG8_MMA
#undef PG8_WAIT_V
#undef PG8_WAIT_L
#undef PG8_BAR
#undef PG8_SCHED
}

struct EpiF32 {
    static constexpr bool PERM = true;
    static constexpr bool SEG = false; static __device__ __forceinline__ size_t segoff(int) { return 0; }
    u16* C; int ldc; float* P;
    __device__ __forceinline__ void operator()(const f32x4 (&acc)[2][2][4][2], const Unit& u, int wr, int wc, int fr, int fq) const {
        const int row0 = u.pm * BM + wr * 64 + fr, col0 = u.pn * BM + wc * 32 + 8 * fq;
        if (u.aux == 0) {
            const unsigned o0 = (unsigned)(row0 * ldc + col0) * 2u;
#pragma unroll
            for (int ai = 0; ai < 2; ++ai)
#pragma unroll
                for (int m = 0; m < 4; ++m) { const unsigned ro = o0 + (unsigned)((ai * HALF + m * 16) * ldc) * 2u;
#pragma unroll
                    for (int bj = 0; bj < 2; ++bj) { const f32x4 v0 = acc[ai][bj][m][0], v1 = acc[ai][bj][m][1]; u32x4 w;
                        w.x = cvt_pk_bf16(v0[0], v0[1]); w.y = cvt_pk_bf16(v0[2], v0[3]); w.z = cvt_pk_bf16(v1[0], v1[1]); w.w = cvt_pk_bf16(v1[2], v1[3]);
                        *(u32x4*)((char*)C + (ro + (unsigned)(bj * HALF) * 2u)) = w; } }
        } else {
            char* Cb = (char*)(P + (size_t)(u.aux - 1) * ((size_t)512 * 1024)); const unsigned o0 = (unsigned)(row0 * ldc + col0) * 4u;
#pragma unroll
            for (int ai = 0; ai < 2; ++ai)
#pragma unroll
                for (int m = 0; m < 4; ++m) { const unsigned ro = o0 + (unsigned)((ai * HALF + m * 16) * ldc) * 4u;
#pragma unroll
                    for (int bj = 0; bj < 2; ++bj)
#pragma unroll
                        for (int n = 0; n < 2; ++n) *(f32x4*)(Cb + (ro + (unsigned)(bj * HALF + n * 4) * 4u)) = acc[ai][bj][m][n]; }
        }
    }
};
struct EpiGU {
    static constexpr bool SEG = false; static __device__ __forceinline__ size_t segoff(int) { return 0; }
    static constexpr bool PERM = true;
    u16* H;
    __device__ __forceinline__ void operator()(const f32x4 (&acc)[2][2][4][2], const Unit& u, int wr, int wc, int fr, int fq) const {
        const int row0 = u.pm * BM + wr * 64 + fr, col0 = u.pn * 128 + wc * 32 + 8 * fq;
#pragma unroll
        for (int ai = 0; ai < 2; ++ai)
#pragma unroll
            for (int m = 0; m < 4; ++m) { u16* rowp = (u16*)((char*)H + (unsigned)((row0 + ai * HALF + m * 16) * DFF + col0) * 2u);
                const f32x4 g0 = acc[ai][0][m][0], g1 = acc[ai][0][m][1], u0 = acc[ai][1][m][0], u1 = acc[ai][1][m][1];
                u32x4 w; w.x = cvt_pk_bf16(fsilu(g0[0]) * u0[0], fsilu(g0[1]) * u0[1]); w.y = cvt_pk_bf16(fsilu(g0[2]) * u0[2], fsilu(g0[3]) * u0[3]);
                w.z = cvt_pk_bf16(fsilu(g1[0]) * u1[0], fsilu(g1[1]) * u1[1]); w.w = cvt_pk_bf16(fsilu(g1[2]) * u1[2], fsilu(g1[3]) * u1[3]);
                *(u32x4*)rowp = w; }
    }
};
struct EpiIN {
    static constexpr bool PERM = true;
    static constexpr bool SEG = false; static __device__ __forceinline__ size_t segoff(int) { return 0; }
    u16* cols; u16* G;
    static __device__ __forceinline__ float act(float x, float k1, float k3, float px, float p1) {
        const float e = __builtin_amdgcn_exp2f(x * (k3 * (x * x) + k1));
        return (px * x + p1) * __builtin_amdgcn_rcpf(1.0f + e);
    }
    __device__ __forceinline__ void operator()(const f32x4 (&acc)[2][2][4][2], const Unit& u, int wr, int wc, int fr, int fq) const {
        const int pn = u.pn; const int mode = pn < 14 ? (pn >> 1) : 7;
        u16* base = pn < 14 ? cols + (size_t)(pn >> 1) * ((size_t)MROWS * 512) : G;
        const int ldc = pn < 14 ? 512 : 3072; const int colt = pn < 14 ? (pn & 1) * 256 : (pn - 14) * 256;
        const int row0 = u.pm * BM + wr * 64 + fr, col0 = colt + wc * 32 + 8 * fq;
        const bool isg = mode <= 1, ident = (mode == 2 || mode == 4 || mode == 5);
        const float L2E = 1.4426950408889634f;
        const float k1 = ident ? 0.f : (isg ? -1.5957691216f * L2E : -L2E), k3 = isg ? -1.5957691216f * 0.044715f * L2E : 0.f;
        const float px = ident ? 2.0f : (mode == 3 ? 0.08838834764831845f : (mode == 7 ? 0.f : 1.0f)), p1 = mode == 7 ? 1.0f : 0.f;
#pragma unroll
        for (int ai = 0; ai < 2; ++ai)
#pragma unroll
            for (int m = 0; m < 4; ++m) { u16* rowp = (u16*)((char*)base + (unsigned)((row0 + ai * HALF + m * 16) * ldc + col0) * 2u);
#pragma unroll
                for (int bj = 0; bj < 2; ++bj) { const f32x4 v0 = acc[ai][bj][m][0], v1 = acc[ai][bj][m][1]; u32x4 w;
                    if (mode == 4) {
                        w.x = __builtin_bit_cast(unsigned, (h16x2){(_Float16)v0[0], (_Float16)v0[1]}); w.y = __builtin_bit_cast(unsigned, (h16x2){(_Float16)v0[2], (_Float16)v0[3]});
                        w.z = __builtin_bit_cast(unsigned, (h16x2){(_Float16)v1[0], (_Float16)v1[1]}); w.w = __builtin_bit_cast(unsigned, (h16x2){(_Float16)v1[2], (_Float16)v1[3]});
                    } else {
                        w.x = cvt_pk_bf16(act(v0[0], k1, k3, px, p1), act(v0[1], k1, k3, px, p1)); w.y = cvt_pk_bf16(act(v0[2], k1, k3, px, p1), act(v0[3], k1, k3, px, p1));
                        w.z = cvt_pk_bf16(act(v1[0], k1, k3, px, p1), act(v1[1], k1, k3, px, p1)); w.w = cvt_pk_bf16(act(v1[2], k1, k3, px, p1), act(v1[3], k1, k3, px, p1));
                    }
                    *(u32x4*)(rowp + bj * HALF) = w; } }
    }
};
struct EpiBranch {
    static constexpr bool PERM = true, SEG = true;
    const u16* G; u16* O; float* P;
    static __device__ __forceinline__ size_t segoff(int sgi) { return sgi == 0 ? (size_t)0 : (sgi == 1 ? COLB - 1024 : 3 * COLB - 2048); }
    __device__ __forceinline__ void rescale(f32x4 (&acc)[2][2][4][2], const Unit& u, int j, int wr, int wc, int fr, int fq) const {
        const int row0 = u.pm * BM + wr * 64 + fr, col0 = u.pn * BM + wc * 32 + 8 * fq;
        const char* Gb = (const char*)G; const unsigned goff = (unsigned)((row0 * 3072 + (j - 1) * 1024 + col0) * 2);
#pragma unroll
        for (int am = 0; am < 4; ++am) { const int ai = am >> 1, m0 = (am & 1) * 2;
            u32x4 na[2][2], nb[2][2];
#pragma unroll
            for (int m = 0; m < 2; ++m)
#pragma unroll
                for (int bj = 0; bj < 2; ++bj) { const unsigned go = goff + (unsigned)(((ai * HALF + (m0 + m) * 16) * 3072 + bj * HALF) * 2);
                    na[m][bj] = *(const u32x4*)(Gb + go); nb[m][bj] = *(const u32x4*)(Gb + go + 2048u); }
#pragma unroll
            for (int m = 0; m < 2; ++m)
#pragma unroll
                for (int bj = 0; bj < 2; ++bj) { const u32x4 a = na[m][bj], b = nb[m][bj]; f32x4& v0 = acc[ai][bj][m0 + m][0]; f32x4& v1 = acc[ai][bj][m0 + m][1];
                    v0[0] *= bflo(a.x) * __builtin_amdgcn_rcpf(bflo(b.x)); v0[1] *= bfhi(a.x) * __builtin_amdgcn_rcpf(bfhi(b.x));
                    v0[2] *= bflo(a.y) * __builtin_amdgcn_rcpf(bflo(b.y)); v0[3] *= bfhi(a.y) * __builtin_amdgcn_rcpf(bfhi(b.y));
                    v1[0] *= bflo(a.z) * __builtin_amdgcn_rcpf(bflo(b.z)); v1[1] *= bfhi(a.z) * __builtin_amdgcn_rcpf(bfhi(b.z));
                    v1[2] *= bflo(a.w) * __builtin_amdgcn_rcpf(bflo(b.w)); v1[3] *= bfhi(a.w) * __builtin_amdgcn_rcpf(bfhi(b.w)); }
            asm volatile("" ::: "memory");
        }
    }
    __device__ __forceinline__ void operator()(const f32x4 (&acc)[2][2][4][2], const Unit& u, int wr, int wc, int fr, int fq) const {
        if (u.aux > 0) {
            const int sg = u.aux - 1; const int rrel = u.pm * BM + wr * 64 + fr, col0 = u.pn * BM + wc * 32 + 8 * fq;
            const unsigned g0 = (unsigned)(((MP + rrel) * 3072 + sg * 1024 + col0) * 2), p0 = (unsigned)((sg * 512 * 1024 + rrel * 1024 + col0) * 4);
#pragma unroll
            for (int ai = 0; ai < 2; ++ai) {
                u32x4 gw[4][2];
#pragma unroll
                for (int m = 0; m < 4; ++m)
#pragma unroll
                    for (int bj = 0; bj < 2; ++bj) gw[m][bj] = *(const u32x4*)((const char*)G + (g0 + (unsigned)(((ai * HALF + m * 16) * 3072 + bj * HALF) * 2)));
#pragma unroll
                for (int m = 0; m < 4; ++m)
#pragma unroll
                    for (int bj = 0; bj < 2; ++bj) { const u32x4 g = gw[m][bj]; const f32x4 v0 = acc[ai][bj][m][0], v1 = acc[ai][bj][m][1];
                        char* pp = (char*)P + (p0 + (unsigned)(((ai * HALF + m * 16) * 1024 + bj * HALF) * 4));
                        *(f32x4*)pp = (f32x4){v0[0] * bflo(g.x), v0[1] * bfhi(g.x), v0[2] * bflo(g.y), v0[3] * bfhi(g.y)};
                        *(f32x4*)(pp + 16) = (f32x4){v1[0] * bflo(g.z), v1[1] * bfhi(g.z), v1[2] * bflo(g.w), v1[3] * bfhi(g.w)}; }
            }
            return;
        }
        const int row0 = u.pm * BM + wr * 64 + fr, col0 = u.pn * BM + wc * 32 + 8 * fq;
#pragma unroll
        for (int ai = 0; ai < 2; ++ai) {
            u32x4 gw[4][2];
#pragma unroll
            for (int m = 0; m < 4; ++m)
#pragma unroll
                for (int bj = 0; bj < 2; ++bj) gw[m][bj] = *(const u32x4*)((const char*)G + (unsigned)((row0 + ai * HALF + m * 16) * 3072 + 2048 + col0 + bj * HALF) * 2u);
#pragma unroll
            for (int m = 0; m < 4; ++m)
#pragma unroll
                for (int bj = 0; bj < 2; ++bj) { const u32x4 g = gw[m][bj]; const f32x4 v0 = acc[ai][bj][m][0], v1 = acc[ai][bj][m][1]; u32x4 w;
                    w.x = cvt_pk_bf16(v0[0] * bflo(g.x), v0[1] * bfhi(g.x)); w.y = cvt_pk_bf16(v0[2] * bflo(g.y), v0[3] * bfhi(g.y));
                    w.z = cvt_pk_bf16(v1[0] * bflo(g.z), v1[1] * bfhi(g.z)); w.w = cvt_pk_bf16(v1[2] * bflo(g.w), v1[3] * bfhi(g.w));
                    *(u32x4*)((char*)O + (unsigned)((row0 + ai * HALF + m * 16) * 1024 + col0 + bj * HALF) * 2u) = w; }
        }
    }
};
}

__device__ __forceinline__ void rn_load(const Ctx p, bool first, bool xin, int row, int lane, int ns, float4 (&x)[4], float4 (&y)[4]) {
    const float* src = xin ? (row < MP ? p.in(0) + (size_t)row * DM : p.in(1) + (size_t)(row - MP) * DM) : p.out() + (size_t)row * DM;
#pragma unroll
    for (int j = 0; j < 4; ++j) x[j] = *(const float4*)(src + lane * 4 + 256 * j);
    if (!first) {
#pragma unroll
        for (int j = 0; j < 4; ++j) {
            if (row < MP) { const u32x2 yw = *(const u32x2*)((const u16*)(p.ws() + RC) + (size_t)row * DM + lane * 4 + 256 * j); y[j].x = bflo(yw.x); y[j].y = bfhi(yw.x); y[j].z = bflo(yw.y); y[j].w = bfhi(yw.y); }
            else { const float* yp = (const float*)(p.ws() + RYP) + (size_t)(row - MP) * DM + lane * 4 + 256 * j; y[j] = *(const float4*)yp;
                for (int q = 1; q < ns; ++q) { const float4 t = *(const float4*)(yp + (size_t)q * 512 * 1024); y[j].x += t.x; y[j].y += t.y; y[j].z += t.z; y[j].w += t.w; } } }
    }
}
__device__ __forceinline__ void rownorm_phase(const Ctx p, bool first, float coef, const float* gpost, const float* gpre, bool write_xn, int ns, bool xin = false) {
    float* X = p.out(); u16* XN = (u16*)(p.ws() + RA);
    const int tid_ = otid(); const int lane = tid_ & 63, wid = tid_ >> 6;
    float4 gp[4], gq[4];
#pragma unroll
    for (int j = 0; j < 4; ++j) { gq[j] = *(const float4*)(gpre + lane * 4 + 256 * j); gp[j] = first ? gq[j] : *(const float4*)(gpost + lane * 4 + 256 * j); }
    const int stride = ogdim() * 8;
    int row = obid() * 8 + wid;
    float4 x[4], y[4];
    if (row < MROWS) rn_load(p, first, xin, row, lane, ns, x, y);
    for (; row < MROWS; row += stride) {
        float4 xn[4], yn[4];
        if (row + stride < MROWS) rn_load(p, first, xin, row + stride, lane, ns, xn, yn);
        if (!first) {
            float ss = 0.f;
#pragma unroll
            for (int j = 0; j < 4; ++j) ss += y[j].x * y[j].x + y[j].y * y[j].y + y[j].z * y[j].z + y[j].w * y[j].w;
            ss = wave_sum(ss);
            const float r = coef * rsqrtf(ss * (1.0f / DM) + EPS);
#pragma unroll
            for (int j = 0; j < 4; ++j) { x[j].x += r * y[j].x * gp[j].x; x[j].y += r * y[j].y * gp[j].y; x[j].z += r * y[j].z * gp[j].z; x[j].w += r * y[j].w * gp[j].w; }
        }
        if (!first) {
#pragma unroll
            for (int j = 0; j < 4; ++j) *(float4*)(X + (size_t)row * DM + lane * 4 + 256 * j) = x[j]; }
        if (write_xn) {
            float ss = 0.f;
#pragma unroll
            for (int j = 0; j < 4; ++j) ss += x[j].x * x[j].x + x[j].y * x[j].y + x[j].z * x[j].z + x[j].w * x[j].w;
            ss = wave_sum(ss);
            const float r = rsqrtf(ss * (1.0f / DM) + EPS);
#pragma unroll
            for (int j = 0; j < 4; ++j) { u32x2 w; w.x = cvt_pk_bf16(x[j].x * r * gq[j].x, x[j].y * r * gq[j].y); w.y = cvt_pk_bf16(x[j].z * r * gq[j].z, x[j].w * r * gq[j].w);
                *(u32x2*)(XN + (size_t)row * DM + lane * 4 + 256 * j) = w; }
        }
#pragma unroll
        for (int j = 0; j < 4; ++j) { x[j] = xn[j]; y[j] = yn[j]; }
    }
}

#define MFMA16(a, b, c) __builtin_amdgcn_mfma_f32_16x16x32_bf16((a), (b), (c), 0, 0, 0)
__device__ __forceinline__ bf16x8 ldsfrag(const LAS u16* base, int row, int ld, int k) { return *(const LAS bf16x8*)(base + row * ld + k); }

__device__ __forceinline__ void convert_mat(LAS unsigned char* lds, int rank, int nwork, const float* src, int ld, u16* dst, int K, int N, bool gu_map, int dld = 0) {
    if (dld == 0) dld = K;
    LAS float* tile = (LAS float*)lds;
    const int tid = otid(), nkt = K >> 6, ntiles = nkt * (N >> 6);
    const int kk = tid >> 4, c4 = (tid & 15) * 4, n = tid >> 3, ks = (tid & 7) * 8;
    float4 v0, v1;
    auto tile_src = [&](int t) -> const float* { const int kt = t % nkt, nd0 = (t / nkt) * 64; int sc0 = nd0;
        if (gu_map) { const int pb = nd0 >> 8, h = (nd0 >> 7) & 1, j = nd0 & 127; sc0 = h * DFF + 128 * pb + j; }
        return src + (size_t)(kt * 64 + kk) * ld + sc0 + c4; };
    int t = rank, it = 0;
    if (t < ntiles) { const float* sp = tile_src(t); v0 = *(const float4*)sp; v1 = *(const float4*)(sp + (size_t)32 * ld); }
    for (; t < ntiles; t += nwork, ++it) {
        LAS float* tb = tile + (it & 1) * 4160;
        { LAS float* tp = tb + kk * 65 + c4; tp[0] = v0.x; tp[1] = v0.y; tp[2] = v0.z; tp[3] = v0.w; tp += 32 * 65; tp[0] = v1.x; tp[1] = v1.y; tp[2] = v1.z; tp[3] = v1.w; }
        if (t + nwork < ntiles) { const float* sp = tile_src(t + nwork); v0 = *(const float4*)sp; v1 = *(const float4*)(sp + (size_t)32 * ld); }
        __syncthreads();
        const int kt = t % nkt, nd0 = (t / nkt) * 64;
        float e[8];
#pragma unroll
        for (int i = 0; i < 8; ++i) e[i] = tb[(ks + i) * 65 + n];
        u32x4 w; w.x = cvt_pk_bf16(e[0], e[1]); w.y = cvt_pk_bf16(e[2], e[3]); w.z = cvt_pk_bf16(e[4], e[5]); w.w = cvt_pk_bf16(e[6], e[7]);
        *(u32x4*)(dst + (size_t)(nd0 + n) * dld + kt * 64 + ks) = w;
    }
    __syncthreads();
}
__device__ __forceinline__ void convert_ffn(const Ctx p, LAS unsigned char* lds, int rank, int nwork, const float* wgu, const float* wdn, size_t dstoff) {
    convert_mat(lds, rank, nwork, wgu, NGU, (u16*)(p.ws() + dstoff), 1024, NGU, true);
    convert_mat(lds, rank, nwork, wdn, 1024, (u16*)(p.ws() + dstoff + (RWF_DN - RWF)), DFF, 1024, false);
}
__device__ __forceinline__ void fuse_pool_unit(const Ctx p, LAS unsigned char* lds, int l, int unit) {
    const int tid = otid(), wid = tid >> 6, lane = tid & 63, fr = lane & 15, fq = lane >> 4;
    const int g = unit >> 3, nb = unit & 7;
    LAS u16* Xt = (LAS u16*)lds; LAS u16* Yl = (LAS u16*)(lds + 34816);
    constexpr int LD = 136;
    const float* wb = p.in(15) + (size_t)l * 1536 * 1024 + (size_t)(512 + g * 128) * 1024 + nb * 128;
    const float* pw = p.in(11) + ((size_t)l * 4 + g) * 16384;
    const float* sc = p.in(12) + l * 512 + g * 128;
#pragma unroll
    for (int i = 0; i < 8; ++i) { const int e = tid + i * 512, d = e >> 5, n4 = (e & 31) * 4; const float4 v = *(const float4*)(wb + (size_t)d * 1024 + n4);
        Xt[(n4 + 0) * LD + d] = f2bf(v.x); Xt[(n4 + 1) * LD + d] = f2bf(v.y); Xt[(n4 + 2) * LD + d] = f2bf(v.z); Xt[(n4 + 3) * LD + d] = f2bf(v.w); }
#pragma unroll
    for (int i = 0; i < 8; ++i) { const int e = tid + i * 512, c = e >> 5, d4 = (e & 31) * 4; const float4 v = *(const float4*)(pw + c * 128 + d4); const float4 s4 = *(const float4*)(sc + d4);
        u32x2 w; w.x = cvt_pk_bf16(v.x * s4.x, v.y * s4.y); w.y = cvt_pk_bf16(v.z * s4.z, v.w * s4.w); *(LAS u32x2*)(Yl + c * LD + d4) = w; }
    __syncthreads();
    f32x4 acc[8];
#pragma unroll
    for (int n = 0; n < 8; ++n) acc[n] = (f32x4){0.f, 0.f, 0.f, 0.f};
#pragma unroll
    for (int ks = 0; ks < 4; ++ks) { const bf16x8 a = ldsfrag(Xt, wid * 16 + fr, LD, ks * 32 + fq * 8);
#pragma unroll
        for (int n = 0; n < 8; ++n) acc[n] = MFMA16(a, ldsfrag(Yl, n * 16 + fr, LD, ks * 32 + fq * 8), acc[n]); }
    u16* dst = (u16*)(p.ws() + RWM_BR);
#pragma unroll
    for (int j = 0; j < 4; ++j) { const int n = nb * 128 + wid * 16 + fq * 4 + j;
#pragma unroll
        for (int c8 = 0; c8 < 8; ++c8) dst[(size_t)n * 1536 + 512 + g * 128 + c8 * 16 + fr] = f2bf(acc[c8][j]); }
    __syncthreads();
}
__device__ __forceinline__ void convert_mix(const Ctx p, LAS unsigned char* lds, int rank, int nwork, int l) {
    convert_mat(lds, rank, nwork, p.in(7) + (size_t)l * 1024 * NIN, NIN, (u16*)(p.ws() + RWM), 1024, NIN, false);
    convert_mat(lds, rank, nwork, p.in(15) + (size_t)l * 1536 * 1024, 1024, (u16*)(p.ws() + RWM_BR), 512, 1024, false, 1536);
    convert_mat(lds, rank, nwork, p.in(15) + (size_t)l * 1536 * 1024 + (size_t)1024 * 1024, 1024, (u16*)(p.ws() + RWM_BR) + 1024, 512, 1024, false, 1536);
    convert_mat(lds, rank, nwork, p.in(16) + (size_t)l * 1024 * 1024, 1024, (u16*)(p.ws() + RWM_OUT), 1024, 1024, false);
    { const int c2 = nwork - 1 - rank; if (c2 < 32) fuse_pool_unit(p, lds, l, c2); }
}


__device__ __forceinline__ void gmlp_unit(const Ctx p, LAS unsigned char* lds, int l, int unit, int wrf = 1) {
    const int tid = otid(), wid = tid >> 6, lane = tid & 63, fr = lane & 15, fq = lane >> 4;
    int row0, L, h, bs = -1;
    if (unit < 1024) { row0 = (unit >> 2) * 128; h = unit & 3; L = 128; } else { const int s = unit - 1024; bs = s >> 2; h = s & 3; row0 = MP + bs * 64; L = 64; }
    u16* U = (u16*)(p.ws() + RB); const u16* V = (const u16*)(p.ws() + RB + COLB);
    LAS float* rs = (LAS float*)lds; LAS u16* Vt = (LAS u16*)(lds + 1024); LAS u16* Wl = (LAS u16*)(lds + 35840);
    constexpr int LD = 136;
    const int srow = tid >> 2, part = tid & 3;
    u32x4 sv[16];
    if (srow < L) {
#pragma unroll
        for (int i = 0; i < 16; ++i) sv[i] = *(const u32x4*)(V + (size_t)(row0 + srow) * 512 + part * 128 + i * 8);
    }
    const int vs = tid & 127, cg4 = tid >> 7;
    u32x4 hv[4]; float4 vgv[8];
    if (vs < L) {
#pragma unroll
        for (int i = 0; i < 4; ++i) hv[i] = *(const u32x4*)(V + (size_t)(row0 + vs) * 512 + h * 128 + cg4 * 32 + i * 8);
    }
    { const float* vg = p.in(8) + l * 512 + h * 128 + cg4 * 32;
#pragma unroll
        for (int i = 0; i < 8; ++i) vgv[i] = *(const float4*)(vg + i * 4); }
    const int wt = tid >> 2, sq = (tid & 3) * 32;
    float4 wv[8];
    if (wt < L) { const float* wp = p.in(9) + ((size_t)(l * 4 + h) * 128 + wt) * 128 + sq;
#pragma unroll
        for (int i = 0; i < 8; ++i) wv[i] = *(const float4*)(wp + i * 4); }
    {
        float ss = 0.f;
        if (srow < L) {
#pragma unroll
            for (int i = 0; i < 16; ++i) { const u32x4 w = sv[i];
                float a; a = bflo(w.x); ss += a * a; a = bfhi(w.x); ss += a * a; a = bflo(w.y); ss += a * a; a = bfhi(w.y); ss += a * a;
                a = bflo(w.z); ss += a * a; a = bfhi(w.z); ss += a * a; a = bflo(w.w); ss += a * a; a = bfhi(w.w); ss += a * a; }
        }
        ss += __shfl_xor(ss, 1); ss += __shfl_xor(ss, 2);
        if (part == 0 && srow < L) rs[srow] = rsqrtf(ss * (1.0f / 512.0f) + EPS);
    }
    {
        if (wt < L) {
#pragma unroll
            for (int i = 0; i < 4; ++i) { const float4 a = wv[2 * i], b = wv[2 * i + 1]; const int s0 = sq + i * 8, t = wt;
                u32x4 w; w.x = cvt_pk_bf16(s0 + 0 <= t ? a.x : 0.f, s0 + 1 <= t ? a.y : 0.f); w.y = cvt_pk_bf16(s0 + 2 <= t ? a.z : 0.f, s0 + 3 <= t ? a.w : 0.f);
                w.z = cvt_pk_bf16(s0 + 4 <= t ? b.x : 0.f, s0 + 5 <= t ? b.y : 0.f); w.w = cvt_pk_bf16(s0 + 6 <= t ? b.z : 0.f, s0 + 7 <= t ? b.w : 0.f);
                *(LAS u32x4*)(Wl + t * LD + s0) = w; } }
    }
    __syncthreads();
    {
        if (vs < L) {
            const float r = rs[vs];
            float* vout = bs >= 0 ? p.out() + O_VS + ((size_t)(l * 8 + bs) * 64 + vs) * 512 + h * 128 + cg4 * 32 : nullptr;
#pragma unroll
            for (int i = 0; i < 4; ++i) { const u32x4 w = hv[i];
                const float e[8] = {bflo(w.x), bfhi(w.x), bflo(w.y), bfhi(w.y), bflo(w.z), bfhi(w.z), bflo(w.w), bfhi(w.w)};
                const float gz[8] = {vgv[2 * i].x, vgv[2 * i].y, vgv[2 * i].z, vgv[2 * i].w, vgv[2 * i + 1].x, vgv[2 * i + 1].y, vgv[2 * i + 1].z, vgv[2 * i + 1].w};
                float vv[8];
#pragma unroll
                for (int j = 0; j < 8; ++j) { vv[j] = e[j] * r * gz[j]; Vt[(cg4 * 32 + i * 8 + j) * LD + vs] = f2bf(vv[j]); }
                if (vout) { *(float4*)(vout + i * 8) = (float4){vv[0], vv[1], vv[2], vv[3]}; *(float4*)(vout + i * 8 + 4) = (float4){vv[4], vv[5], vv[6], vv[7]}; } }
        }
    }
    __syncthreads();
    if (wid * 16 < L) {
        const float* bsp = p.in(10) + (l * 4 + h) * 128;
        u16 uv[4][8]; float bias[4];
#pragma unroll
        for (int j = 0; j < 4; ++j) { const int t = wid * 16 + fq * 4 + j; bias[j] = bsp[t];
#pragma unroll
            for (int n = 0; n < 8; ++n) uv[j][n] = U[(size_t)(row0 + t) * 512 + h * 128 + n * 16 + fr]; }
        f32x4 acc[8];
#pragma unroll
        for (int n = 0; n < 8; ++n) acc[n] = (f32x4){0.f, 0.f, 0.f, 0.f};
        const int kmax = (wid * 16 + 15) / 32 + 1;
        for (int ks = 0; ks < kmax; ++ks) { const bf16x8 a = ldsfrag(Wl, wid * 16 + fr, LD, ks * 32 + fq * 8);
#pragma unroll
            for (int n = 0; n < 8; ++n) acc[n] = MFMA16(a, ldsfrag(Vt, n * 16 + fr, LD, ks * 32 + fq * 8), acc[n]); }
#pragma unroll
        for (int j = 0; j < 4; ++j) { const int t = wid * 16 + fq * 4 + j;
#pragma unroll
            for (int n = 0; n < 8; ++n) { const u16 ov = f2bf(bf2f(uv[j][n]) * (acc[n][j] + bias[j])); if (wrf) U[(size_t)(row0 + t) * 512 + h * 128 + n * 16 + fr] = ov; } }
    }
    __syncthreads();
}

__device__ __forceinline__ float hgrn_lb(const float* lbp, int l, int c) {
    const float x0 = lbp[c], x1 = lbp[512 + c], x2 = lbp[1024 + c], x3 = lbp[1536 + c];
    const float m = fmaxf(fmaxf(x0, x1), fmaxf(x2, x3));
    const float e0 = __expf(x0 - m), e1 = __expf(x1 - m), e2 = __expf(x2 - m), e3 = __expf(x3 - m);
    float num = 0.f; if (l >= 1) num += e1; if (l >= 2) num += e2; if (l >= 3) num += e3;
    return num / (e0 + e1 + e2 + e3);
}
__device__ __forceinline__ int chunk_row0(int cq) { return cq < 512 ? cq * 64 : MP + (cq - 512) * 64; }

struct HaIn { u16 z[16]; u32x4 v[2]; float lbx[4]; };
__device__ __forceinline__ void ha_load(const Ctx p, int unit, HaIn& L) {
    const int tid = otid();
    const int cq = unit >> 2, h = unit & 3, row0 = chunk_row0(cq);
    const u16* F = (const u16*)(p.ws() + RB + 4 * COLB); const u16* I = (const u16*)(p.ws() + RB + 5 * COLB);
    const int k = tid & 127, seg = tid >> 7;
    { const float* lbp = p.in(13) + h * 128 + k; L.lbx[0] = lbp[0]; L.lbx[1] = lbp[512]; L.lbx[2] = lbp[1024]; L.lbx[3] = lbp[1536]; }
#pragma unroll
    for (int i = 0; i < 16; ++i) L.z[i] = F[(size_t)(row0 + seg * 16 + i) * 512 + h * 128 + k];
    { const int s = tid & 63, cg = tid >> 6;
#pragma unroll
        for (int i = 0; i < 2; ++i) L.v[i] = *(const u32x4*)(I + (size_t)(row0 + s) * 512 + h * 128 + cg * 16 + i * 8); }
}
__device__ __forceinline__ void hgrn_a_unit(const Ctx p, LAS unsigned char* lds, int l, int unit, int next_unit, HaIn& L) {
    const int tid = otid(), wid = tid >> 6, lane = tid & 63, fr = lane & 15, fq = lane >> 4;
    u16* St = (u16*)(p.ws() + RA) + (size_t)unit * 16384; float* dcy = (float*)(p.ws() + RSM) + (size_t)unit * 128;
    LAS float* segtot = (LAS float*)lds; LAS u16* Kt = (LAS u16*)(lds + 4096); LAS u16* Vt = (LAS u16*)(lds + 22528);
    constexpr int LD = 72;
    const int k = tid & 127, seg = tid >> 7;
    float lb;
    { const float x0 = L.lbx[0], x1 = L.lbx[1], x2 = L.lbx[2], x3 = L.lbx[3]; const float m = fmaxf(fmaxf(x0, x1), fmaxf(x2, x3));
      const float e0 = __expf(x0 - m), e1 = __expf(x1 - m), e2 = __expf(x2 - m), e3 = __expf(x3 - m);
      float num = 0.f; if (l >= 1) num += e1; if (l >= 2) num += e2; if (l >= 3) num += e3; lb = num / (e0 + e1 + e2 + e3); }
    float lf[16], kk[16]; float run = 0.f;
#pragma unroll
    for (int i = 0; i < 16; ++i) { const float z = (float)__builtin_bit_cast(_Float16, L.z[i]);
        const float sg = fsig(z); const float f = lb + (1.0f - lb) * sg; kk[i] = 1.0f - f; run += __logf(fmaxf(f, 1e-30f)); lf[i] = run; }
    segtot[seg * 128 + k] = run;
    { const int s = tid & 63, cg = tid >> 6;
#pragma unroll
        for (int i = 0; i < 2; ++i) { const u32x4 w = L.v[i]; LAS u16* vp = Vt + (cg * 16 + i * 8) * LD + s;
            vp[0] = (u16)(w.x & 0xffff); vp[LD] = (u16)(w.x >> 16); vp[2 * LD] = (u16)(w.y & 0xffff); vp[3 * LD] = (u16)(w.y >> 16);
            vp[4 * LD] = (u16)(w.z & 0xffff); vp[5 * LD] = (u16)(w.z >> 16); vp[6 * LD] = (u16)(w.w & 0xffff); vp[7 * LD] = (u16)(w.w >> 16); } }
    if (next_unit < 2080) ha_load(p, next_unit, L);
    __syncthreads();
    { const float t0 = segtot[k], t1 = segtot[128 + k], t2 = segtot[256 + k], t3 = segtot[384 + k];
        const float off = seg == 0 ? 0.f : (seg == 1 ? t0 : (seg == 2 ? t0 + t1 : t0 + t1 + t2)); const float blast = t0 + t1 + t2 + t3;
#pragma unroll
        for (int i = 0; i < 16; ++i) Kt[k * LD + seg * 16 + i] = f2bf(kk[i] * __expf(blast - (off + lf[i])));
        if (seg == 0) dcy[k] = __expf(blast); }
    __syncthreads();
    { f32x4 acc[8];
#pragma unroll
        for (int n = 0; n < 8; ++n) acc[n] = (f32x4){0.f, 0.f, 0.f, 0.f};
#pragma unroll
        for (int ks = 0; ks < 2; ++ks) { const bf16x8 a = ldsfrag(Kt, wid * 16 + fr, LD, ks * 32 + fq * 8);
#pragma unroll
            for (int n = 0; n < 8; ++n) acc[n] = MFMA16(a, ldsfrag(Vt, n * 16 + fr, LD, ks * 32 + fq * 8), acc[n]); }
#pragma unroll
        for (int n = 0; n < 8; ++n) { u32x2 w; w.x = cvt_pk_bf16(acc[n][0], acc[n][1]); w.y = cvt_pk_bf16(acc[n][2], acc[n][3]);
            *(u32x2*)(St + (size_t)(n * 16 + fr) * 128 + wid * 16 + fq * 4) = w; } }
    __syncthreads();
}

__device__ __forceinline__ void hgrn_scan_phase(const Ctx p, int l, int wrf = 1) {
    u16* SR = (u16*)(p.ws() + RA); const float* dcy = (const float*)(p.ws() + RSM);
    const int gtid = obid() * 512 + otid(), gsz = ogdim() * 512;
    for (int e = gtid; e < 8 * 16384; e += gsz) {
        const int seq = e >> 14, el = e & 16383, b = seq >> 2, h = seq & 3, k = el & 127, v = el >> 7;
        u16* sp = SR + ((size_t)(b * 256) * 4 + h) * 16384 + el; const float* dp = dcy + ((size_t)(b * 256) * 4 + h) * 128 + k;
        float st = 0.f;
        for (int n0 = 0; n0 < 256; n0 += 16) {
            float uu[16], dd[16];
#pragma unroll
            for (int j = 0; j < 16; ++j) { uu[j] = bf2f(sp[(size_t)(n0 + j) * 65536]); dd[j] = dp[(size_t)(n0 + j) * 512]; }
#pragma unroll
            for (int j = 0; j < 16; ++j) { if (wrf) sp[(size_t)(n0 + j) * 65536] = f2bf(st); st = dd[j] * st + uu[j]; }
        }
        if (wrf) p.out()[O_HGP + ((size_t)(l * 2 + b) * 4 + h) * 16384 + k * 128 + v] = st;
    }
    for (int e = gtid; e < 32 * 16384; e += gsz) {
        const int bh = e >> 14, el = e & 16383, k = el & 127, v = el >> 7;
        u16* sp = SR + ((size_t)(512 * 4) + bh) * 16384 + el;
        const float s0 = p.in(3)[((size_t)l * 32 + bh) * 16384 + k * 128 + v];
        const float uu = bf2f(*sp), dd = dcy[((size_t)(512 * 4) + bh) * 128 + k];
        if (wrf) *sp = f2bf(s0);
        if (wrf) p.out()[O_HGS + ((size_t)l * 32 + bh) * 16384 + k * 128 + v] = dd * s0 + uu;
    }
}

struct HcIn { u16 z[16]; u32x4 v[2], st[4]; float lbx[4]; };
__device__ __forceinline__ void hc_load(const Ctx p, int l, int unit, HcIn& L) {
    const int tid = otid();
    const int cq = unit >> 2, h = unit & 3, row0 = chunk_row0(cq);
    const u16* F = (const u16*)(p.ws() + RB + 4 * COLB); const u16* I = (const u16*)(p.ws() + RB + 5 * COLB);
    const u16* St = (const u16*)(p.ws() + RA) + (size_t)unit * 16384;
    const int k = tid & 127, seg = tid >> 7;
    { const float* lbp = p.in(13) + h * 128 + k; L.lbx[0] = lbp[0]; L.lbx[1] = lbp[512]; L.lbx[2] = lbp[1024]; L.lbx[3] = lbp[1536]; }
#pragma unroll
    for (int i = 0; i < 16; ++i) L.z[i] = F[(size_t)(row0 + seg * 16 + i) * 512 + h * 128 + k];
    { const int s = tid & 63, cg = tid >> 6;
#pragma unroll
        for (int i = 0; i < 2; ++i) L.v[i] = *(const u32x4*)(I + (size_t)(row0 + s) * 512 + h * 128 + cg * 16 + i * 8); }
#pragma unroll
    for (int i = 0; i < 4; ++i) { const int c = tid + i * 512, r = c >> 4, cc = (c & 15) * 8; L.st[i] = *(const u32x4*)(St + r * 128 + cc); }
}
__device__ __forceinline__ void hgrn_c_unit(const Ctx p, LAS unsigned char* lds, int l, int unit, int next_unit, HcIn& L, int wrf = 1) {
    const int tid = otid(), wid = tid >> 6, lane = tid & 63, fr = lane & 15, fq = lane >> 4;
    const int cq = unit >> 2, h = unit & 3, row0 = chunk_row0(cq);
    u16* Q = (u16*)(p.ws() + RB + 3 * COLB); const u16* GG = (const u16*)(p.ws() + RB + 6 * COLB);
    u16 qv[16], gg[4][4]; float ogv[4];
#pragma unroll
    for (int i = 0; i < 16; ++i) qv[i] = Q[(size_t)(row0 + (tid >> 7) * 16 + i) * 512 + h * 128 + (tid & 127)];
    { const int tt = wid & 3, nh = wid >> 2; const float* og = p.in(14) + l * 128;
#pragma unroll
        for (int n = 0; n < 4; ++n) { const int v = (nh * 4 + n) * 16 + fr; ogv[n] = og[v];
#pragma unroll
            for (int j = 0; j < 4; ++j) gg[j][n] = GG[(size_t)(row0 + tt * 16 + fq * 4 + j) * 512 + h * 128 + v]; } }
    LAS float* segtot = (LAS float*)lds; LAS float* red = (LAS float*)(lds + 2560);
    LAS u16* Qi = (LAS u16*)(lds + 4096); LAS u16* Qh = (LAS u16*)(lds + 21504); LAS u16* Kh = (LAS u16*)(lds + 38912);
    LAS u16* Vt = (LAS u16*)(lds + 56320); LAS u16* Sl = (LAS u16*)(lds + 74752); LAS u16* P = (LAS u16*)(lds + 109568);
    constexpr int LDK = 136, LDS_ = 72;
    const int k = tid & 127, seg = tid >> 7;
    float lb;
    { const float x0 = L.lbx[0], x1 = L.lbx[1], x2 = L.lbx[2], x3 = L.lbx[3]; const float m = fmaxf(fmaxf(x0, x1), fmaxf(x2, x3));
      const float e0 = __expf(x0 - m), e1 = __expf(x1 - m), e2 = __expf(x2 - m), e3 = __expf(x3 - m);
      float num = 0.f; if (l >= 1) num += e1; if (l >= 2) num += e2; if (l >= 3) num += e3; lb = num / (e0 + e1 + e2 + e3); }
    float lf[16], kk[16]; float run = 0.f;
#pragma unroll
    for (int i = 0; i < 16; ++i) { const float z = (float)__builtin_bit_cast(_Float16, L.z[i]);
        const float sg = fsig(z); const float f = lb + (1.0f - lb) * sg; kk[i] = 1.0f - f; run += __logf(fmaxf(f, 1e-30f)); lf[i] = run; }
    segtot[seg * 128 + k] = run;
    { const int s = tid & 63, cg = tid >> 6;
#pragma unroll
        for (int i = 0; i < 2; ++i) { const u32x4 w = L.v[i]; LAS u16* vp = Vt + (cg * 16 + i * 8) * LDS_ + s;
            vp[0] = (u16)(w.x & 0xffff); vp[LDS_] = (u16)(w.x >> 16); vp[2 * LDS_] = (u16)(w.y & 0xffff); vp[3 * LDS_] = (u16)(w.y >> 16);
            vp[4 * LDS_] = (u16)(w.z & 0xffff); vp[5 * LDS_] = (u16)(w.z >> 16); vp[6 * LDS_] = (u16)(w.w & 0xffff); vp[7 * LDS_] = (u16)(w.w >> 16); } }
#pragma unroll
    for (int i = 0; i < 4; ++i) { const int c = tid + i * 512, r = c >> 4, cc = (c & 15) * 8; *(LAS u32x4*)(Sl + r * LDK + cc) = L.st[i]; }
    if (next_unit < 2080) hc_load(p, l, next_unit, L);
    __syncthreads();
    { const float t0 = segtot[k], t1 = segtot[128 + k], t2 = segtot[256 + k];
        const float off = seg == 0 ? 0.f : (seg == 1 ? t0 : (seg == 2 ? t0 + t1 : t0 + t1 + t2)); const float bref = t0 + t1;
#pragma unroll
        for (int i = 0; i < 16; ++i) { const int s = seg * 16 + i; const float b = off + lf[i]; const float q = bf2f(qv[i]);
            Qi[s * LDK + k] = f2bf(q * __expf(b)); Qh[s * LDK + k] = f2bf(q * __expf(b - bref)); Kh[s * LDK + k] = f2bf(kk[i] * __expf(bref - b)); } }
    __syncthreads();
    {
        const int tt = wid >> 1;
#pragma unroll
        for (int q2 = 0; q2 < 2; ++q2) { const int stl = (wid & 1) * 2 + q2; f32x4 acc = (f32x4){0.f, 0.f, 0.f, 0.f};
            if (stl <= tt) {
#pragma unroll
                for (int ks = 0; ks < 4; ++ks) acc = MFMA16(ldsfrag(Qh, tt * 16 + fr, LDK, ks * 32 + fq * 8), ldsfrag(Kh, stl * 16 + fr, LDK, ks * 32 + fq * 8), acc); }
#pragma unroll
            for (int j = 0; j < 4; ++j) { const int t = tt * 16 + fq * 4 + j, s = stl * 16 + fr; P[t * LDS_ + s] = (stl <= tt && s <= t) ? f2bf(acc[j]) : (u16)0; } }
    }
    __syncthreads();
    { const int tt = wid & 3, nh = wid >> 2; f32x4 acc[4];
#pragma unroll
        for (int n = 0; n < 4; ++n) acc[n] = (f32x4){0.f, 0.f, 0.f, 0.f};
#pragma unroll
        for (int ks = 0; ks < 4; ++ks) { const bf16x8 a = ldsfrag(Qi, tt * 16 + fr, LDK, ks * 32 + fq * 8);
#pragma unroll
            for (int n = 0; n < 4; ++n) acc[n] = MFMA16(a, ldsfrag(Sl, (nh * 4 + n) * 16 + fr, LDK, ks * 32 + fq * 8), acc[n]); }
#pragma unroll
        for (int ks = 0; ks < 2; ++ks) { const bf16x8 a = ldsfrag(P, tt * 16 + fr, LDS_, ks * 32 + fq * 8);
#pragma unroll
            for (int n = 0; n < 4; ++n) acc[n] = MFMA16(a, ldsfrag(Vt, (nh * 4 + n) * 16 + fr, LDS_, ks * 32 + fq * 8), acc[n]); }
        float ssq[4];
#pragma unroll
        for (int j = 0; j < 4; ++j) { float s = 0.f;
#pragma unroll
            for (int n = 0; n < 4; ++n) s += acc[n][j] * acc[n][j];
            s += __shfl_xor(s, 1); s += __shfl_xor(s, 2); s += __shfl_xor(s, 4); s += __shfl_xor(s, 8); ssq[j] = s; }
        if (fr == 0) {
#pragma unroll
            for (int j = 0; j < 4; ++j) red[nh * 64 + tt * 16 + fq * 4 + j] = ssq[j]; }
        __syncthreads();
#pragma unroll
        for (int j = 0; j < 4; ++j) { const int t = tt * 16 + fq * 4 + j; const float r = rsqrtf((red[t] + red[64 + t]) * (1.0f / 128.0f) + EPS);
#pragma unroll
            for (int n = 0; n < 4; ++n) { const int v = (nh * 4 + n) * 16 + fr; const size_t idx = (size_t)(row0 + t) * 512 + h * 128 + v;
                const u16 ov = f2bf(acc[n][j] * r * ogv[n] * bf2f(gg[j][n])); if (wrf) Q[idx] = ov; } }
    }
    __syncthreads();
}

template <int W> __device__ __forceinline__ void pool_rows(const u32x4 (&x)[31], int t0q, int nvalid, u16* ob) {
    float s[8];
#pragma unroll
    for (int e = 0; e < 8; ++e) s[e] = 0.f;
#pragma unroll
    for (int j = 16 - W; j < 15; ++j) { const u32x4 v = x[j]; s[0] += bflo(v.x); s[1] += bfhi(v.x); s[2] += bflo(v.y); s[3] += bfhi(v.y); s[4] += bflo(v.z); s[5] += bfhi(v.z); s[6] += bflo(v.w); s[7] += bfhi(v.w); }
#pragma unroll
    for (int i = 0; i < 16; ++i) { const u32x4 v = x[15 + i]; const float xv[8] = {bflo(v.x), bfhi(v.x), bflo(v.y), bfhi(v.y), bflo(v.z), bfhi(v.z), bflo(v.w), bfhi(v.w)};
        const int avail = t0q + i + 1 + nvalid; const float rc = 1.0f / (float)(avail < W ? avail : W);
        float o[8];
#pragma unroll
        for (int e = 0; e < 8; ++e) { s[e] += xv[e]; o[e] = s[e] * rc - xv[e]; }
        u32x4 w; w.x = cvt_pk_bf16(o[0], o[1]); w.y = cvt_pk_bf16(o[2], o[3]); w.z = cvt_pk_bf16(o[4], o[5]); w.w = cvt_pk_bf16(o[6], o[7]);
        *(u32x4*)(ob + (size_t)i * 512) = w;
        const u32x4 r = x[15 + i - (W - 1)];
        s[0] -= bflo(r.x); s[1] -= bfhi(r.x); s[2] -= bflo(r.y); s[3] -= bfhi(r.y); s[4] -= bflo(r.z); s[5] -= bfhi(r.z); s[6] -= bflo(r.w); s[7] -= bfhi(r.w); }
}
__device__ __forceinline__ void pool_pass(const Ctx p, int l) {
    const int tid = otid(), lane = tid & 63, cgp = lane & 15, rq = lane >> 4;
    const u16* XB = (const u16*)(p.ws() + RB + 2 * COLB); u16* OB = (u16*)(p.ws() + RB + COLB);
    const int u0 = obid() * 8 + (tid >> 6), ustride = ogdim() * 8;
    for (int unit = u0; unit < NCH64 * 4; unit += ustride) {
        const int cq = unit >> 2, g = unit & 3, row0 = chunk_row0(cq);
        const bool samp = cq >= 512; const int bs = cq - 512; const int t0 = samp ? 0 : (cq & 255) * 64;
        const int t0q = t0 + rq * 16;
        const int col = g * 128 + cgp * 8;
        u32x4 x[31];
#pragma unroll
        for (int j = 0; j < 31; ++j) { const int tk = t0q - 15 + j;
            if (tk >= 0) x[j] = *(const u32x4*)(XB + (size_t)(row0 + rq * 16 - 15 + j) * 512 + col);
            else if (samp) { const float* sp = p.in(2) + ((size_t)(l * 8 + bs) * 15 + (15 + tk)) * 512 + col; const float4 a = *(const float4*)sp, b = *(const float4*)(sp + 4);
                x[j].x = cvt_pk_bf16(a.x, a.y); x[j].y = cvt_pk_bf16(a.z, a.w); x[j].z = cvt_pk_bf16(b.x, b.y); x[j].w = cvt_pk_bf16(b.z, b.w); }
            else x[j] = (u32x4){0u, 0u, 0u, 0u}; }
        u16* ob = OB + (size_t)(row0 + rq * 16) * 512 + col; const int nvalid = samp ? 15 : 0;
        if (g == 0) pool_rows<2>(x, t0q, nvalid, ob); else if (g == 1) pool_rows<4>(x, t0q, nvalid, ob); else if (g == 2) pool_rows<8>(x, t0q, nvalid, ob); else pool_rows<16>(x, t0q, nvalid, ob);
        if ((samp || t0 == 16320) && rq == 3) { float* po = (samp ? p.out() + O_POOLS + ((size_t)(l * 8 + bs) * 15) * 512 : p.out() + O_POOLP + ((size_t)(l * 2 + (cq >> 8)) * 15) * 512) + col;
#pragma unroll
            for (int j = 0; j < 15; ++j) { const u32x4 v = x[16 + j]; float* q = po + (size_t)j * 512;
                *(float4*)q = (float4){bflo(v.x), bfhi(v.x), bflo(v.y), bfhi(v.y)}; *(float4*)(q + 4) = (float4){bflo(v.z), bfhi(v.z), bflo(v.w), bfhi(v.w)}; } }
    }
}

#define XB_TMO      128
#define XB_XCNT(j)  (256  + 64 * (j))
#define XB_XSUB(j)  (1280 + 64 * (j))
#define XB_XGEN(j)  (2304 + 64 * (j))
#define XB_TOP      3328
#define XB_TOPGEN   3392
#define XCD_BAR_WORDS 3456
#define XB_SPIN_CAP (1u << 20)
__device__ __forceinline__ unsigned xb_ld(unsigned* p)              { return __hip_atomic_load(p, __ATOMIC_RELAXED, __HIP_MEMORY_SCOPE_AGENT); }
__device__ __forceinline__ unsigned xb_add(unsigned* p, unsigned v) { return __hip_atomic_fetch_add(p, v, __ATOMIC_RELAXED, __HIP_MEMORY_SCOPE_AGENT); }
__device__ __forceinline__ unsigned xb_xcc_id() { return (unsigned)__builtin_amdgcn_s_getreg((3 << 11) | 20) & 0xFu; }
#define XB_SPIN(cond, bar) do { unsigned _sp = 0; while (cond) { __builtin_amdgcn_s_sleep(1); \
    if ((++_sp & 255u) == 0u) { if (xb_ld(&(bar)[XB_TMO])) break; if (_sp > XB_SPIN_CAP) { atomicAdd(&(bar)[XB_TMO], 1u); break; } } } } while (0)
__device__ __forceinline__ void xcd_barrier_complete(unsigned* bar, unsigned x, unsigned& nloc, unsigned& nx) {
    const unsigned G = gridDim.x;
    unsigned sum, cnt, mine, sp = 0u;
    for (;;) {
        sum = 0u; cnt = 0u; mine = 0u;
#pragma unroll
        for (unsigned j = 0; j < 16; ++j) { const unsigned c = xb_ld(&bar[XB_XCNT(j)]); sum += c; cnt += (c > 0u) ? 1u : 0u; mine = (j == x) ? c : mine; }
        if (sum == G) break;
        __builtin_amdgcn_s_sleep(1);
        if ((++sp & 255u) == 0u) { if (xb_ld(&bar[XB_TMO])) break; if (sp > XB_SPIN_CAP) { atomicAdd(&bar[XB_TMO], 1u); break; } }
    }
    nloc = mine > 0u ? mine : 1u; nx = cnt > 0u ? cnt : 1u;
}
__device__ __forceinline__ void xcd_barrier(unsigned* bar, volatile LAS unsigned* st) {
    asm volatile("s_waitcnt vmcnt(0)" ::: "memory");
    __syncthreads();
    if (threadIdx.x == 0) {
        const unsigned x = xb_xcc_id();
        __builtin_amdgcn_s_waitcnt(0);
        unsigned nloc = st[0], nx = st[1];
        if (nloc == 0u) { xcd_barrier_complete(bar, x, nloc, nx); st[0] = nloc; st[1] = nx; }
        const unsigned old = xb_add(&bar[XB_XSUB(x)], 1u);
        const unsigned gen = old / nloc;
        if (old + 1u == (gen + 1u) * nloc) {
            __builtin_amdgcn_fence(__ATOMIC_RELEASE, "agent");
            asm volatile("s_waitcnt vmcnt(0)" ::: "memory");
            const unsigned og = xb_add(&bar[XB_TOP], 1u);
            const unsigned tg = og / nx;
            if (og + 1u == (tg + 1u) * nx) xb_add(&bar[XB_TOPGEN], 1u);
            else XB_SPIN(xb_ld(&bar[XB_TOPGEN]) == tg, bar);
            __builtin_amdgcn_fence(__ATOMIC_ACQUIRE, "agent");
            xb_add(&bar[XB_XGEN(x)], 1u);
            asm volatile("s_waitcnt vmcnt(0)" ::: "memory");
        } else {
            XB_SPIN(xb_ld(&bar[XB_XGEN(x)]) == gen, bar);
            __builtin_amdgcn_fence(__ATOMIC_ACQUIRE, "agent");
            asm volatile("s_waitcnt vmcnt(0)" ::: "memory");
        }
    }
    __syncthreads();
}

__global__ void __launch_bounds__(512, 2) fwd_mega(Params kp) {
    extern __shared__ __attribute__((aligned(16))) unsigned char lds_raw[];
    LAS unsigned char* lds = (LAS unsigned char*)lds_raw;
    cg::grid_group grid = cg::this_grid();
    { LAS unsigned* pw = (LAS unsigned*)(lds + 131072); const unsigned* src = (const unsigned*)&kp; if (threadIdx.x < sizeof(Params) / 4) pw[threadIdx.x] = src[threadIdx.x];
      if (threadIdx.x >= 128 && threadIdx.x < 132) pw[threadIdx.x] = 0u; }
    __syncthreads();
    volatile LAS unsigned* bst = (volatile LAS unsigned*)(lds + 131072 + 512);
    if (threadIdx.x == 0) (void)xb_add(&((unsigned*)(kp.ws + RBAR))[XB_XCNT(xb_xcc_id())], 1u);
    Ctx p; p.pl = (LAS const unsigned*)(lds + 131072);
    const int ph_lo = __builtin_amdgcn_readfirstlane(p.pl[42]), ph_hi = __builtin_amdgcn_readfirstlane(p.pl[43]);
    unsigned long long tp_prev = 0, tp_acc = 0; int tp_sel = 0;
    for (int ph = ph_lo; ph < ph_hi; ++ph) {
        if (ph > ph_lo) { if (ph == ph_lo + 1) grid.sync(); else xcd_barrier((unsigned*)(p.ws() + RBAR), bst); }
        if (TPM) { const unsigned long long now = __builtin_amdgcn_s_memrealtime(); if (tp_sel) tp_acc += now - tp_prev; tp_prev = now; tp_sel = ph == 0 ? (TPM & 1) : ((TPM >> ((ph - 1) % 13 + 1)) & 1); }
        const int G = osgpr((int)gridDim.x), c = osgpr((int)blockIdx.x);
        if (ph == 0) {
            rownorm_phase(p, true, 0.f, nullptr, p.in(4), true, 0, true);
            convert_ffn(p, lds, c, G, p.in(5), p.in(6), RWF);
            convert_mix(p, lds, c, G, 0);
            continue;
        }
        const int l = (ph - 1) / 13, s = (ph - 1) % 13 + 1;
        unsigned char* ws = p.ws_flat();
        switch (s) {
        case 1: case 11: if (PHM & 1) {
            const size_t wf = s == 1 ? RWF : RWF2;
            pg8::SchedPlain S; S.o.init(MROWS / 256, NGU / 256, G, c); S.A = (const char*)(ws + RA); S.B = (const char*)(ws + wf); S.at = (size_t)256 * 1024 * 2; S.bt = (size_t)256 * 1024 * 2; S.nt = 16; S.ns = 0; S.nseg = 0; S.Asplit = nullptr;
            pg8::EpiGU E{(u16*)(ws + RB)};
            REP(0) pg8::gemm_phase(lds, 1024, 1024, 1024, S, E);
            const int extra = S.o.nwg % G;
            if (c >= extra) {
                if (s == 1) convert_ffn(p, lds, c - extra, G - extra, p.in(17) + (size_t)l * 1024 * NGU, p.in(18) + (size_t)l * DFF * 1024, RWF2);
                else if (l < DEPTH - 1) convert_mix(p, lds, c - extra, G - extra, l + 1);
            }
        } break;
        case 2: case 12: if (PHM & 2) {
            pg8::SchedPlain S; S.o.init(MP / 256, 4, G, c); S.A = (const char*)(ws + RB); S.B = (const char*)(ws + (s == 2 ? RWF : RWF2) + (RWF_DN - RWF)); S.at = (size_t)256 * DFF * 2; S.bt = (size_t)256 * DFF * 2; S.nt = DFF / 64; S.ns = 11; S.nseg = 0; S.Asplit = nullptr;
            pg8::EpiF32 E{(u16*)(ws + RC), 1024, (float*)(ws + RYP)};
            REP(1) pg8::gemm_phase(lds, DFF, DFF, DFF, S, E);
        } break;
        case 3: if (PHM & 4) { const float* gains = p.in(4) + (size_t)l * 6 * 1024; rownorm_phase(p, false, 0.5f, gains + 1024, gains + 2048, true, 11, l == 0); } break;
        case 4: if (PHM & 8) {
            pg8::SchedPlain S; S.o.init(MROWS / 256, NIN / 256, G, c); S.A = (const char*)(ws + RA); S.B = (const char*)(ws + RWM); S.at = (size_t)256 * 1024 * 2; S.bt = (size_t)256 * 1024 * 2; S.nt = 16; S.ns = 0; S.nseg = 0; S.Asplit = nullptr;
            pg8::EpiIN E{(u16*)(ws + RB), (u16*)(ws + RC)};
            REP(2) pg8::gemm_phase(lds, 1024, 1024, 1024, S, E);
            const int extra = S.o.nwg % G;
            if (c >= extra && l < DEPTH - 1) convert_ffn(p, lds, c - extra, G - extra, p.in(5) + (size_t)(l + 1) * 1024 * NGU, p.in(6) + (size_t)(l + 1) * DFF * 1024, RWF);
        } break;
        case 5: { int it = c;
                    for (; it < 1056; it += G) { if (PHM & 16) REP(8) gmlp_unit(p, lds, l, it, osgpr(rep_ == 0 ? 1 : 0)); }
                    if (PHM & 32) { HaIn A; ha_load(p, it - 1056 < 2080 ? it - 1056 : 0, A);
                        for (; it < 1056 + 2080; it += G) hgrn_a_unit(p, lds, l, it - 1056, it + G - 1056, A); } } break;
        case 6: if (PHM & 64) REP(9) hgrn_scan_phase(p, l, osgpr(rep_ == 0 ? 1 : 0)); break;
        case 7: if (PHM & 128) { int it = c; HcIn A; hc_load(p, l, it < 2080 ? it : 0, A);
                    for (; it < 2080; it += G) hgrn_c_unit(p, lds, l, it, it + G, A, 1); }
                if (PHM & 256) REP(6) pool_pass(p, l); break;
        case 8: if (PHM & 512) {
            pg8::SchedPlain S; S.o.init(MP / 256, 4, G, c); S.A = (const char*)(ws + RB); S.B = (const char*)(ws + RWM_BR); S.at = (size_t)256 * 512 * 2; S.bt = (size_t)256 * 1536 * 2; S.nt = 24; S.ns = 0; S.nseg = 3; S.Asplit = nullptr;
            pg8::EpiBranch E{(const u16*)(ws + RC), (u16*)(ws + RA), (float*)(ws + RB + 2 * COLB)};
            REP(3) pg8::gemm_phase(lds, 1536, 512, 1536, S, E);
        } break;
        case 9: if (PHM & 1024) {
            if (c < 32) {
                const int tile = c >> 2, j = c & 3, pms = tile >> 2; const int tid = otid();
                const float* Pp = (const float*)(ws + RB + 2 * COLB); u16* blk = (u16*)(ws + RB + 4 * COLB + (size_t)c * (512 * 1024));
#pragma unroll 4
                for (int e = tid; e < 8192; e += 512) { const int r = e >> 5, col = j * 256 + (e & 31) * 8; const float* sp = Pp + (size_t)(pms * 256 + r) * 1024 + col;
                    float4 a = *(const float4*)sp, b = *(const float4*)(sp + 4);
#pragma unroll
                    for (int q = 1; q < 3; ++q) { const float4 a2 = *(const float4*)(sp + (size_t)q * 512 * 1024), b2 = *(const float4*)(sp + (size_t)q * 512 * 1024 + 4);
                        a.x += a2.x; a.y += a2.y; a.z += a2.z; a.w += a2.w; b.x += b2.x; b.y += b2.y; b.z += b2.z; b.w += b2.w; }
                    u32x4 w; w.x = cvt_pk_bf16(a.x, a.y); w.y = cvt_pk_bf16(a.z, a.w); w.z = cvt_pk_bf16(b.x, b.y); w.w = cvt_pk_bf16(b.z, b.w);
                    *(u32x4*)(blk + (size_t)r * 1024 + col) = w; }
                asm volatile("s_waitcnt vmcnt(0)" ::: "memory");
            }
            __syncthreads();
            pg8::SchedPlain S; S.o.init(MP / 256, 4, G, c); S.A = (const char*)(ws + RA); S.B = (const char*)(ws + RWM_OUT); S.at = (size_t)256 * 1024 * 2; S.bt = (size_t)256 * 1024 * 2; S.nt = 16; S.ns = 4; S.nseg = 0; S.Asplit = (const char*)(ws + RB + 4 * COLB);
            pg8::EpiF32 E{(u16*)(ws + RC), 1024, (float*)(ws + RYP)};
            REP(4) pg8::gemm_phase(lds, 1024, 1024, 1024, S, E);
        } break;
        case 10: { const float* gains = p.in(4) + (size_t)l * 6 * 1024; REP(11) rownorm_phase(p, false, rep_ ? 0.f : 1.0f, gains + 3 * 1024, gains + 4 * 1024, true, 4); } break;
        case 13: { const float* gains = p.in(4) + (size_t)l * 6 * 1024; REP(11) rownorm_phase(p, false, rep_ ? 0.f : 0.5f, gains + 5 * 1024, gains + (l < DEPTH - 1 ? 6 * 1024 : 0), l < DEPTH - 1, 11); } break;
        }
    }
    if (TPM) { unsigned long long now = __builtin_amdgcn_s_memrealtime(); if (tp_sel) tp_acc += now - tp_prev;
        if (blockIdx.x == 0 && threadIdx.x == 0) { const unsigned long long t0 = now; while (__builtin_amdgcn_s_memrealtime() - t0 < TMULT * tp_acc) __builtin_amdgcn_s_sleep(8); } }
}

constexpr int N_PHASES = 1 + 13 * DEPTH;

extern "C" void kernel_launch(void* const* d_in, const int* in_sizes, int n_in, void* d_out, int out_size, void* d_ws, size_t ws_size, hipStream_t stream) {
    static int grid = 0;
    if (grid == 0) {
        if (n_in != 19 || ws_size < WS_END) { fprintf(stderr, "kernel_launch: need 19 inputs and %zu bytes of workspace (got %d, %zu)\n", (size_t)WS_END, n_in, ws_size); grid = -1; return; }
        int dev = 0, cus = 0, per_cu = 0;
        hipGetDevice(&dev); hipDeviceGetAttribute(&cus, hipDeviceAttributeMultiprocessorCount, dev);
        hipFuncSetAttribute((const void*)fwd_mega, hipFuncAttributeMaxDynamicSharedMemorySize, LDS_BYTES);
        hipOccupancyMaxActiveBlocksPerMultiprocessor(&per_cu, (const void*)fwd_mega, 512, LDS_BYTES);
        if (per_cu < 1) { fprintf(stderr, "kernel_launch: occupancy query says %d blocks per CU\n", per_cu); per_cu = 1; }
        (void)hipGetLastError();
        grid = cus * per_cu;
    }
    if (grid < 0) return;
    Params p{};
    for (int i = 0; i < 19; ++i) p.in[i] = (const float*)d_in[i];
    p.out = (float*)d_out; p.ws = (unsigned char*)d_ws;
    (void)hipMemsetAsync((unsigned char*)d_ws + RBAR, 0, 3456 * 4, stream);
#if MULTI_LAUNCH
    for (int ph = 0; ph < N_PHASES; ++ph) { p.ph_lo = ph; p.ph_hi = ph + 1; hipLaunchKernelGGL(fwd_mega, dim3(grid), dim3(512), LDS_BYTES, stream, p); }
#else
    p.ph_lo = 0; p.ph_hi = N_PHASES;
    void* args[] = {&p};
    hipError_t e = hipLaunchCooperativeKernel((const void*)fwd_mega, dim3(grid), dim3(512), args, LDS_BYTES, stream);
    if (e != hipSuccess) fprintf(stderr, "cooperative launch failed: %s (grid %d)\n", hipGetErrorString(e), grid);
#endif
}
```

```cpp
#include <hip/hip_runtime.h>
#include <hip/hip_cooperative_groups.h>
#include <cstdio>
namespace cg = cooperative_groups;

#define LAS __attribute__((address_space(3)))
typedef unsigned short u16;
typedef short bf16x8 __attribute__((ext_vector_type(8)));
typedef float f32x4 __attribute__((ext_vector_type(4)));
typedef unsigned u32x4 __attribute__((ext_vector_type(4)));
typedef unsigned u32x2 __attribute__((ext_vector_type(2)));
typedef _Float16 h16x2 __attribute__((ext_vector_type(2)));

#ifndef PHM
#define PHM 0xffff
#endif
#ifndef DUP
#define DUP 0x0
#endif
#define REP(bit) for (int rep_ = 0; rep_ <= ((DUP >> (bit)) & 1); ++rep_)
#ifndef TPM
#define TPM 0
#endif
#define TMULT 4
#ifndef SPLITK
#define SPLITK 1
#endif
#ifndef USE_SP2
#define USE_SP2 1
#endif
#ifndef USE_ALIGN
#define USE_ALIGN 1
#endif
#ifndef MULTI_LAUNCH
#define MULTI_LAUNCH 0
#endif

constexpr int MROWS = 33280, MP = 32768, DM = 1024, DFF = 2816, NGU = 5632, NIN = 6656, DEPTH = 4;
constexpr int NCH64 = MROWS / 64;
constexpr float EPS = 1e-6f;
constexpr size_t O_POOLP = 34078720, O_POOLS = 34140160, O_HGP = 34385920, O_HGS = 34910208, O_VS = 37007360;
constexpr size_t COLB = (size_t)MROWS * 512 * 2;
constexpr size_t RA = 0;
constexpr size_t RB = RA + (size_t)MROWS * 1024 * 2;
constexpr size_t RC = RB + 7 * COLB;
constexpr size_t RYP = RC + (size_t)MROWS * 1024 * 4;
constexpr size_t RWF = RC + (size_t)MROWS * 3072 * 2;
constexpr size_t RWF_DN = RWF + (size_t)NGU * 1024 * 2;
constexpr size_t RWM = RWF_DN + (size_t)1024 * DFF * 2;
constexpr size_t RWM_BR = RWM + (size_t)NIN * 1024 * 2;
constexpr size_t RWM_OUT = RWM_BR + (size_t)1024 * 1536 * 2;
constexpr size_t RWM_POOL = RWM_OUT + (size_t)1024 * 1024 * 2;
constexpr size_t RSM = RWM_POOL + (size_t)4 * 128 * 128 * 2;
constexpr size_t RBAR = RSM + (size_t)NCH64 * 4 * 128 * 4;
constexpr size_t RWF2 = RBAR + 3456 * 4 + 256;
constexpr size_t WS_END = RWF2 + (RWF_DN - RWF) + (size_t)1024 * DFF * 2;
constexpr int LDS_BYTES = 131072 + 2048;

struct Params { const float* in[19]; float* out; unsigned char* ws; int ph_lo, ph_hi; };
struct Ctx {
    LAS const unsigned* pl;
    __device__ __forceinline__ unsigned long long q(int k) const { const unsigned lo = __builtin_amdgcn_readfirstlane(pl[2 * k]), hi = __builtin_amdgcn_readfirstlane(pl[2 * k + 1]); return ((unsigned long long)hi << 32) | lo; }
    __device__ __forceinline__ const float* in(int k) const { return (const float*)(const __attribute__((address_space(1))) float*)q(k); }
    __device__ __forceinline__ float* out() const { return (float*)(__attribute__((address_space(1))) float*)q(19); }
    __device__ __forceinline__ unsigned char* ws() const { return (unsigned char*)(__attribute__((address_space(1))) unsigned char*)q(20); }
    __device__ __forceinline__ unsigned char* ws_flat() const { return (unsigned char*)q(20); }
};

__device__ __forceinline__ float bf2f(unsigned b) { return __uint_as_float(b << 16); }
__device__ __forceinline__ float bflo(unsigned w) { return __uint_as_float(w << 16); }
__device__ __forceinline__ float bfhi(unsigned w) { return __uint_as_float(w & 0xffff0000u); }
__device__ __forceinline__ u16 f2bf(float f) { unsigned u = __float_as_uint(f); u += 0x7FFFu + ((u >> 16) & 1u); return (u16)(u >> 16); }
typedef __bf16 bf16x2_t __attribute__((ext_vector_type(2)));
typedef float f32x2_t __attribute__((ext_vector_type(2)));
__device__ __forceinline__ unsigned cvt_pk_bf16(float lo, float hi) { const f32x2_t v = {lo, hi}; const bf16x2_t r = __builtin_convertvector(v, bf16x2_t); return __builtin_bit_cast(unsigned, r); }
__device__ __forceinline__ float fsig(float x) { return __builtin_amdgcn_rcpf(1.0f + __expf(-x)); }
__device__ __forceinline__ float fsilu(float x) { return x * fsig(x); }
__device__ __forceinline__ float fgelu(float x) { return x * fsig(1.5957691216f * (x + 0.044715f * x * x * x)); }
__device__ __forceinline__ float wave_sum(float v) {
#pragma unroll
    for (int o = 32; o >= 1; o >>= 1) v += __shfl_xor(v, o);
    return v;
}

__device__ __forceinline__ int otid() { int t = threadIdx.x; asm volatile("" : "+v"(t)); return t; }
template <class T> __device__ __forceinline__ T osgpr(T x) { asm volatile("" : "+s"(x)); return x; }
__device__ __forceinline__ int obid() { return osgpr((int)blockIdx.x); }
__device__ __forceinline__ int ogdim() { return osgpr((int)gridDim.x); }

namespace pg8 {
constexpr int BM = 256, BK = 64, HALF = 128, HTB = HALF * BK * 2, STAGE_BYTES = 8 * HTB, NXCD = 8, WGM = 8;
__device__ __forceinline__ int lds_byte(int r, int c) { const int st = (r >> 4) * 2 + (c >> 5), rr = r & 15, cc = c & 31, ob = rr * 64 + cc * 2; return st * 1024 + (ob ^ (((ob >> 9) & 1) << 5)); }
__device__ __forceinline__ void stage_rc(int b, int& R, int& C) { const int st = b / 1024, sb = b % 1024, swz = sb ^ (((sb >> 9) & 1) << 5); R = (st >> 1) * 16 + swz / 64; C = (st & 1) * 32 + (swz % 64) / 2; }
__device__ __forceinline__ int perm32(int rho) { const int n = rho >> 4, i = rho & 15; return 8 * (i >> 2) + 4 * n + (i & 3); }

struct Unit { const char* a; const char* b; int pm, pn, aux, nt; };

struct TileOrder {
    int nM, nN, nwg, G, c;
    __device__ void init(int nM_, int nN_, int G_, int c_) { nM = nM_; nN = nN_; nwg = nM * nN; G = G_; c = c_; }
    __device__ bool tile(int i, int& pm, int& pn) const {
        const long L = (long)i * G + c; if (L >= nwg) return false;
        int wgid = (int)L; { const int q = nwg / NXCD, r = nwg % NXCD, xcd = wgid % NXCD, off = wgid / NXCD; wgid = (xcd < r ? xcd * (q + 1) : r * (q + 1) + (xcd - r) * q) + off; }
        const int nig = WGM * nN, gid = wgid / nig, fm = gid * WGM, gsz = (nM - fm) < WGM ? (nM - fm) : WGM;
        pm = fm + ((wgid % nig) % gsz); pn = (wgid % nig) / gsz; return true;
    }
};
struct SchedPlain {
    TileOrder o; const char* A; const char* B; size_t at, bt;
    int nt;
    int ns;
    int nseg;
    const char* Asplit;
    __device__ bool next(int i, Unit& u) const {
        int pm, pn;
        if (o.tile(i, pm, pn)) { u.a = A + (size_t)pm * at; u.b = B + (size_t)pn * bt; u.pm = pm; u.pn = pn; u.aux = 0; u.nt = nt; return true; }
        const int nfull = (o.nwg - o.c + o.G - 1) / o.G;
        if (i != nfull) return false;
        if (nseg) { if (o.c >= 24) return false;
            const int tile = o.c / 3, sg = o.c - tile * 3, pms = tile >> 2; pn = tile & 3;
            u.a = A + (sg == 0 ? (size_t)0 : (sg == 1 ? COLB : 3 * COLB)) + (size_t)(128 + pms) * at; u.b = B + (size_t)pn * bt + (size_t)sg * 1024; u.pm = pms; u.pn = pn; u.aux = sg + 1; u.nt = 8; return true; }
        if (ns == 0 || o.c >= 8 * ns) return false;
        const int tile = o.c / ns, j = o.c - tile * ns, pms = tile >> 2; pn = tile & 3;
        u.a = (Asplit ? Asplit + (size_t)o.c * (512 * 1024) : A + (size_t)(128 + pms) * at) + (size_t)j * 512; u.b = B + (size_t)pn * bt + (size_t)j * 512; u.pm = pms; u.pn = pn; u.aux = j + 1; u.nt = 4; return true;
    }
};

template <class Epi, class Sched>
__device__ __forceinline__ void gemm_phase(LAS unsigned char* lds, const int K, const int lda, const int ldb, const Sched& S, const Epi& E) {
    const int tid = otid(), wid = __builtin_amdgcn_readfirstlane(tid >> 6), lane = tid & 63, wr = wid >> 2, wc = wid & 3, fr = lane & 15, fq = lane >> 4;
    unsigned voffA[2], voffB[2];
#pragma unroll
    for (int i = 0; i < 2; ++i) { int R, C; stage_rc(tid * 16 + i * 8192, R, C); const int Rb = Epi::PERM ? ((R & ~31) + perm32(R & 31)) : R;
        voffA[i] = (unsigned)(R * lda + C) * 2u; voffB[i] = (unsigned)(Rb * ldb + C) * 2u; }
    const size_t kstep = (size_t)(BK * 2);
    const size_t hstepA = (size_t)HALF * lda * 2, hstepB = (size_t)HALF * ldb * 2;
    const unsigned ldsw = (unsigned)wid * 1024u;
    const int aoff = lds_byte(wr * 64 + fr, fq * 8), boff = lds_byte(wc * 32 + fr, fq * 8);
#define PG8_SA(b, h) (((b) * 2 + (h)) * HTB)
#define PG8_SB(b, h) ((4 + (b) * 2 + (h)) * HTB)
#define PG8_STAGE(bufoff, gbase, voff) do { _Pragma("unroll") for (int _i = 0; _i < 2; ++_i) \
        __builtin_amdgcn_global_load_lds((const unsigned*)((const char*)(gbase) + (voff)[_i]), (LAS unsigned*)(lds + (bufoff) + ldsw + _i * 8192), 16, 0, 0); } while (0)
#define PG8_LDA(dst, b, h) do { _Pragma("unroll") for (int m = 0; m < 4; ++m) _Pragma("unroll") for (int k = 0; k < 2; ++k) dst[m][k] = *(const LAS bf16x8*)(lds + PG8_SA(b, h) + aoff + m * 2048 + k * 1024); } while (0)
#define PG8_LDB(dst, b, h) do { _Pragma("unroll") for (int n = 0; n < 2; ++n) _Pragma("unroll") for (int k = 0; k < 2; ++k) dst[n][k] = *(const LAS bf16x8*)(lds + PG8_SB(b, h) + boff + n * 2048 + k * 1024); } while (0)
#define PG8_MMA(ai, bj, At, Bt) do { __builtin_amdgcn_s_setprio(1); _Pragma("unroll") for (int m = 0; m < 4; ++m) _Pragma("unroll") for (int n = 0; n < 2; ++n) _Pragma("unroll") for (int k = 0; k < 2; ++k) \
        acc[ai][bj][m][n] = __builtin_amdgcn_mfma_f32_16x16x32_bf16(Bt[n][k], At[m][k], acc[ai][bj][m][n], 0, 0, 0); __builtin_amdgcn_s_setprio(0); } while (0)
#define PG8_WAIT_V(n) asm volatile("s_waitcnt vmcnt(" #n ")" ::: "memory")
#define PG8_WAIT_L(n) asm volatile("s_waitcnt lgkmcnt(" #n ")" ::: "memory")
#define PG8_BAR __builtin_amdgcn_s_barrier()
#define PG8_SCHED __builtin_amdgcn_sched_barrier(0)
    Unit cur, nxt; int ui = 0;
    if (!S.next(0, cur)) return;
    f32x4 acc[2][2][4][2];
#pragma unroll
    for (int a = 0; a < 2; ++a)
#pragma unroll
        for (int b = 0; b < 2; ++b)
#pragma unroll
            for (int m = 0; m < 4; ++m)
#pragma unroll
                for (int n = 0; n < 2; ++n) acc[a][b][m][n] = (f32x4){0.f, 0.f, 0.f, 0.f};
    bf16x8 At[4][2], B0[2][2], B1[2][2];
    const char* cA = cur.a; const char* cB = cur.b;
    if constexpr (USE_SP2) {
        PG8_STAGE(PG8_SB(0, 0), cB, voffB); PG8_STAGE(PG8_SB(0, 1), cB + hstepB, voffB); PG8_STAGE(PG8_SA(0, 0), cA, voffA); PG8_STAGE(PG8_SA(0, 1), cA + hstepA, voffA);
        if (wr == 1) PG8_BAR;
        PG8_WAIT_V(2); PG8_BAR;
        PG8_STAGE(PG8_SB(1, 0), cB + kstep, voffB); PG8_STAGE(PG8_SA(1, 0), cA + kstep, voffA); PG8_STAGE(PG8_SB(1, 1), cB + hstepB + kstep, voffB);
        PG8_WAIT_V(6); PG8_BAR;
    } else {
    PG8_STAGE(PG8_SB(0, 0), cB, voffB); PG8_STAGE(PG8_SA(0, 0), cA, voffA); PG8_STAGE(PG8_SB(0, 1), cB + hstepB, voffB); PG8_STAGE(PG8_SA(0, 1), cA + hstepA, voffA);
    if (wr == 1) PG8_BAR;
    PG8_WAIT_V(4); PG8_BAR;
    PG8_STAGE(PG8_SB(1, 0), cB + kstep, voffB); PG8_STAGE(PG8_SA(1, 0), cA + kstep, voffA); PG8_STAGE(PG8_SB(1, 1), cB + hstepB + kstep, voffB);
    PG8_WAIT_V(6); PG8_BAR;
    }
    for (;;) {
        const bool has_next = S.next(ui + 1, nxt);
        const char* nA = has_next ? nxt.a : cA; const char* nB = has_next ? nxt.b : cB;
        const int nt = cur.nt;
        for (int t = 0; t < nt; t += 2) {
            const bool last = (t == nt - 2);
            if constexpr (Epi::SEG) { if (t == 8 || t == 16) E.rescale(acc, cur, t >> 3, wr, wc, fr, fq); }
            const char* a1 = cA + (size_t)(t + 1) * kstep + (Epi::SEG ? Epi::segoff(t >> 3) : (size_t)0);
            const char* a2 = last ? nA : cA + (size_t)(t + 2) * kstep + (Epi::SEG ? Epi::segoff((t + 2) >> 3) : (size_t)0); const char* b2 = last ? nB : cB + (size_t)(t + 2) * kstep;
            const char* a3 = a2 + kstep; const char* b3 = b2 + kstep;
            if constexpr (USE_SP2) {
            PG8_LDB(B0, 0, 0); PG8_LDB(B1, 0, 1); PG8_SCHED; PG8_LDA(At, 0, 0); PG8_STAGE(PG8_SA(1, 1), a1 + hstepA, voffA);
            PG8_WAIT_V(8); PG8_WAIT_L(0); PG8_BAR; PG8_MMA(0, 0, At, B0); PG8_MMA(0, 1, At, B1); PG8_BAR; PG8_SCHED;
            PG8_LDA(At, 0, 1); PG8_STAGE(PG8_SB(0, 0), b2, voffB); PG8_STAGE(PG8_SB(0, 1), b2 + hstepB, voffB); PG8_STAGE(PG8_SA(0, 0), a2, voffA);
            PG8_WAIT_V(8); PG8_WAIT_L(0); PG8_BAR; PG8_MMA(1, 0, At, B0); PG8_MMA(1, 1, At, B1); PG8_BAR; PG8_SCHED;
            PG8_LDB(B0, 1, 0); PG8_LDB(B1, 1, 1); PG8_SCHED; PG8_LDA(At, 1, 0); PG8_STAGE(PG8_SA(0, 1), a2 + hstepA, voffA);
            PG8_WAIT_V(8); PG8_WAIT_L(0); PG8_BAR; PG8_MMA(0, 0, At, B0); PG8_MMA(0, 1, At, B1); PG8_BAR; PG8_SCHED;
            PG8_LDA(At, 1, 1); PG8_STAGE(PG8_SB(1, 0), b3, voffB); PG8_STAGE(PG8_SB(1, 1), b3 + hstepB, voffB); PG8_STAGE(PG8_SA(1, 0), a3, voffA);
            PG8_WAIT_V(8); PG8_WAIT_L(0); PG8_BAR; PG8_MMA(1, 0, At, B0); PG8_MMA(1, 1, At, B1); PG8_BAR; PG8_SCHED;
            } else {
            PG8_LDB(B0, 0, 0); PG8_SCHED; PG8_LDA(At, 0, 0); PG8_STAGE(PG8_SA(1, 1), a1 + hstepA, voffA);
            PG8_WAIT_L(8); PG8_BAR; PG8_WAIT_L(0); PG8_MMA(0, 0, At, B0); PG8_BAR; PG8_SCHED;
            PG8_LDB(B1, 0, 1); PG8_STAGE(PG8_SB(0, 0), b2, voffB);
            PG8_BAR; PG8_WAIT_L(0); PG8_MMA(0, 1, At, B1); PG8_BAR;
            PG8_LDA(At, 0, 1); PG8_STAGE(PG8_SA(0, 0), a2, voffA);
            PG8_BAR; PG8_WAIT_L(0); PG8_MMA(1, 0, At, B0); PG8_BAR; PG8_SCHED;
            PG8_STAGE(PG8_SB(0, 1), b2 + hstepB, voffB);
            PG8_WAIT_V(6); PG8_BAR; PG8_MMA(1, 1, At, B1); PG8_BAR;
            PG8_LDB(B0, 1, 0); PG8_SCHED; PG8_LDA(At, 1, 0); PG8_STAGE(PG8_SA(0, 1), a2 + hstepA, voffA);
            PG8_WAIT_L(8); PG8_BAR; PG8_WAIT_L(0); PG8_MMA(0, 0, At, B0); PG8_BAR; PG8_SCHED;
            PG8_LDB(B1, 1, 1); PG8_STAGE(PG8_SB(1, 0), b3, voffB);
            PG8_BAR; PG8_WAIT_L(0); PG8_MMA(0, 1, At, B1); PG8_BAR;
            PG8_LDA(At, 1, 1); PG8_STAGE(PG8_SA(1, 0), a3, voffA);
            PG8_BAR; PG8_WAIT_L(0); PG8_MMA(1, 0, At, B0); PG8_BAR; PG8_SCHED;
            PG8_STAGE(PG8_SB(1, 1), b3 + hstepB, voffB);
            PG8_WAIT_V(6); PG8_BAR; PG8_MMA(1, 1, At, B1); PG8_BAR;
            }
        }
        if constexpr (USE_ALIGN) { if (wr == 0) PG8_BAR; }
        E(acc, cur, wr, wc, fr, fq);
        if (!has_next) break;
#pragma unroll
        for (int a = 0; a < 2; ++a)
#pragma unroll
            for (int b = 0; b < 2; ++b)
#pragma unroll
                for (int m = 0; m < 4; ++m)
#pragma unroll
                    for (int n = 0; n < 2; ++n) acc[a][b][m][n] = (f32x4){0.f, 0.f, 0.f, 0.f};
        cur = nxt; cA = nA; cB = nB; ++ui;
        if constexpr (USE_ALIGN) { if (wr == 1) PG8_BAR; }
    }
    PG8_WAIT_V(0);
    if constexpr (!USE_ALIGN) { if (wr == 0) PG8_BAR; }
    PG8_BAR;
    asm volatile("" ::: "memory");
#undef PG8_SA
#undef PG8_SB
#undef PG8_STAGE
#undef PG8_LDA
#undef PG8_LDB
#undef PG8_MMA
#undef PG8_WAIT_V
#undef PG8_WAIT_L
#undef PG8_BAR
#undef PG8_SCHED
}

struct EpiF32 {
    static constexpr bool PERM = true;
    static constexpr bool SEG = false; static __device__ __forceinline__ size_t segoff(int) { return 0; }
    u16* C; int ldc; float* P;
    __device__ __forceinline__ void operator()(const f32x4 (&acc)[2][2][4][2], const Unit& u, int wr, int wc, int fr, int fq) const {
        const int row0 = u.pm * BM + wr * 64 + fr, col0 = u.pn * BM + wc * 32 + 8 * fq;
        if (u.aux == 0) {
            const unsigned o0 = (unsigned)(row0 * ldc + col0) * 2u;
#pragma unroll
            for (int ai = 0; ai < 2; ++ai)
#pragma unroll
                for (int m = 0; m < 4; ++m) { const unsigned ro = o0 + (unsigned)((ai * HALF + m * 16) * ldc) * 2u;
#pragma unroll
                    for (int bj = 0; bj < 2; ++bj) { const f32x4 v0 = acc[ai][bj][m][0], v1 = acc[ai][bj][m][1]; u32x4 w;
                        w.x = cvt_pk_bf16(v0[0], v0[1]); w.y = cvt_pk_bf16(v0[2], v0[3]); w.z = cvt_pk_bf16(v1[0], v1[1]); w.w = cvt_pk_bf16(v1[2], v1[3]);
                        *(u32x4*)((char*)C + (ro + (unsigned)(bj * HALF) * 2u)) = w; } }
        } else {
            char* Cb = (char*)(P + (size_t)(u.aux - 1) * ((size_t)512 * 1024)); const unsigned o0 = (unsigned)(row0 * ldc + col0) * 4u;
#pragma unroll
            for (int ai = 0; ai < 2; ++ai)
#pragma unroll
                for (int m = 0; m < 4; ++m) { const unsigned ro = o0 + (unsigned)((ai * HALF + m * 16) * ldc) * 4u;
#pragma unroll
                    for (int bj = 0; bj < 2; ++bj)
#pragma unroll
                        for (int n = 0; n < 2; ++n) *(f32x4*)(Cb + (ro + (unsigned)(bj * HALF + n * 4) * 4u)) = acc[ai][bj][m][n]; }
        }
    }
};
struct EpiGU {
    static constexpr bool SEG = false; static __device__ __forceinline__ size_t segoff(int) { return 0; }
    static constexpr bool PERM = true;
    u16* H;
    __device__ __forceinline__ void operator()(const f32x4 (&acc)[2][2][4][2], const Unit& u, int wr, int wc, int fr, int fq) const {
        const int row0 = u.pm * BM + wr * 64 + fr, col0 = u.pn * 128 + wc * 32 + 8 * fq;
#pragma unroll
        for (int ai = 0; ai < 2; ++ai)
#pragma unroll
            for (int m = 0; m < 4; ++m) { u16* rowp = (u16*)((char*)H + (unsigned)((row0 + ai * HALF + m * 16) * DFF + col0) * 2u);
                const f32x4 g0 = acc[ai][0][m][0], g1 = acc[ai][0][m][1], u0 = acc[ai][1][m][0], u1 = acc[ai][1][m][1];
                u32x4 w; w.x = cvt_pk_bf16(fsilu(g0[0]) * u0[0], fsilu(g0[1]) * u0[1]); w.y = cvt_pk_bf16(fsilu(g0[2]) * u0[2], fsilu(g0[3]) * u0[3]);
                w.z = cvt_pk_bf16(fsilu(g1[0]) * u1[0], fsilu(g1[1]) * u1[1]); w.w = cvt_pk_bf16(fsilu(g1[2]) * u1[2], fsilu(g1[3]) * u1[3]);
                *(u32x4*)rowp = w; }
    }
};
struct EpiIN {
    static constexpr bool PERM = true;
    static constexpr bool SEG = false; static __device__ __forceinline__ size_t segoff(int) { return 0; }
    u16* cols; u16* G;
    static __device__ __forceinline__ float act(float x, float k1, float k3, float px, float p1) {
        const float e = __builtin_amdgcn_exp2f(x * (k3 * (x * x) + k1));
        return (px * x + p1) * __builtin_amdgcn_rcpf(1.0f + e);
    }
    __device__ __forceinline__ void operator()(const f32x4 (&acc)[2][2][4][2], const Unit& u, int wr, int wc, int fr, int fq) const {
        const int pn = u.pn; const int mode = pn < 14 ? (pn >> 1) : 7;
        u16* base = pn < 14 ? cols + (size_t)(pn >> 1) * ((size_t)MROWS * 512) : G;
        const int ldc = pn < 14 ? 512 : 3072; const int colt = pn < 14 ? (pn & 1) * 256 : (pn - 14) * 256;
        const int row0 = u.pm * BM + wr * 64 + fr, col0 = colt + wc * 32 + 8 * fq;
        const bool isg = mode <= 1, ident = (mode == 2 || mode == 4 || mode == 5);
        const float L2E = 1.4426950408889634f;
        const float k1 = ident ? 0.f : (isg ? -1.5957691216f * L2E : -L2E), k3 = isg ? -1.5957691216f * 0.044715f * L2E : 0.f;
        const float px = ident ? 2.0f : (mode == 3 ? 0.08838834764831845f : (mode == 7 ? 0.f : 1.0f)), p1 = mode == 7 ? 1.0f : 0.f;
#pragma unroll
        for (int ai = 0; ai < 2; ++ai)
#pragma unroll
            for (int m = 0; m < 4; ++m) { u16* rowp = (u16*)((char*)base + (unsigned)((row0 + ai * HALF + m * 16) * ldc + col0) * 2u);
#pragma unroll
                for (int bj = 0; bj < 2; ++bj) { const f32x4 v0 = acc[ai][bj][m][0], v1 = acc[ai][bj][m][1]; u32x4 w;
                    if (mode == 4) {
                        w.x = __builtin_bit_cast(unsigned, (h16x2){(_Float16)v0[0], (_Float16)v0[1]}); w.y = __builtin_bit_cast(unsigned, (h16x2){(_Float16)v0[2], (_Float16)v0[3]});
                        w.z = __builtin_bit_cast(unsigned, (h16x2){(_Float16)v1[0], (_Float16)v1[1]}); w.w = __builtin_bit_cast(unsigned, (h16x2){(_Float16)v1[2], (_Float16)v1[3]});
                    } else {
                        w.x = cvt_pk_bf16(act(v0[0], k1, k3, px, p1), act(v0[1], k1, k3, px, p1)); w.y = cvt_pk_bf16(act(v0[2], k1, k3, px, p1), act(v0[3], k1, k3, px, p1));
                        w.z = cvt_pk_bf16(act(v1[0], k1, k3, px, p1), act(v1[1], k1, k3, px, p1)); w.w = cvt_pk_bf16(act(v1[2], k1, k3, px, p1), act(v1[3], k1, k3, px, p1));
                    }
                    *(u32x4*)(rowp + bj * HALF) = w; } }
    }
};
struct EpiBranch {
    static constexpr bool PERM = true, SEG = true;
    const u16* G; u16* O; float* P;
    static __device__ __forceinline__ size_t segoff(int sgi) { return sgi == 0 ? (size_t)0 : (sgi == 1 ? COLB - 1024 : 3 * COLB - 2048); }
    __device__ __forceinline__ void rescale(f32x4 (&acc)[2][2][4][2], const Unit& u, int j, int wr, int wc, int fr, int fq) const {
        const int row0 = u.pm * BM + wr * 64 + fr, col0 = u.pn * BM + wc * 32 + 8 * fq;
        const char* Gb = (const char*)G; const unsigned goff = (unsigned)((row0 * 3072 + (j - 1) * 1024 + col0) * 2);
#pragma unroll
        for (int am = 0; am < 4; ++am) { const int ai = am >> 1, m0 = (am & 1) * 2;
            u32x4 na[2][2], nb[2][2];
#pragma unroll
            for (int m = 0; m < 2; ++m)
#pragma unroll
                for (int bj = 0; bj < 2; ++bj) { const unsigned go = goff + (unsigned)(((ai * HALF + (m0 + m) * 16) * 3072 + bj * HALF) * 2);
                    na[m][bj] = *(const u32x4*)(Gb + go); nb[m][bj] = *(const u32x4*)(Gb + go + 2048u); }
#pragma unroll
            for (int m = 0; m < 2; ++m)
#pragma unroll
                for (int bj = 0; bj < 2; ++bj) { const u32x4 a = na[m][bj], b = nb[m][bj]; f32x4& v0 = acc[ai][bj][m0 + m][0]; f32x4& v1 = acc[ai][bj][m0 + m][1];
                    v0[0] *= bflo(a.x) * __builtin_amdgcn_rcpf(bflo(b.x)); v0[1] *= bfhi(a.x) * __builtin_amdgcn_rcpf(bfhi(b.x));
                    v0[2] *= bflo(a.y) * __builtin_amdgcn_rcpf(bflo(b.y)); v0[3] *= bfhi(a.y) * __builtin_amdgcn_rcpf(bfhi(b.y));
                    v1[0] *= bflo(a.z) * __builtin_amdgcn_rcpf(bflo(b.z)); v1[1] *= bfhi(a.z) * __builtin_amdgcn_rcpf(bfhi(b.z));
                    v1[2] *= bflo(a.w) * __builtin_amdgcn_rcpf(bflo(b.w)); v1[3] *= bfhi(a.w) * __builtin_amdgcn_rcpf(bfhi(b.w)); }
            asm volatile("" ::: "memory");
        }
    }
    __device__ __forceinline__ void operator()(const f32x4 (&acc)[2][2][4][2], const Unit& u, int wr, int wc, int fr, int fq) const {
        if (u.aux > 0) {
            const int sg = u.aux - 1; const int rrel = u.pm * BM + wr * 64 + fr, col0 = u.pn * BM + wc * 32 + 8 * fq;
            const unsigned g0 = (unsigned)(((MP + rrel) * 3072 + sg * 1024 + col0) * 2), p0 = (unsigned)((sg * 512 * 1024 + rrel * 1024 + col0) * 4);
#pragma unroll
            for (int ai = 0; ai < 2; ++ai) {
                u32x4 gw[4][2];
#pragma unroll
                for (int m = 0; m < 4; ++m)
#pragma unroll
                    for (int bj = 0; bj < 2; ++bj) gw[m][bj] = *(const u32x4*)((const char*)G + (g0 + (unsigned)(((ai * HALF + m * 16) * 3072 + bj * HALF) * 2)));
#pragma unroll
                for (int m = 0; m < 4; ++m)
#pragma unroll
                    for (int bj = 0; bj < 2; ++bj) { const u32x4 g = gw[m][bj]; const f32x4 v0 = acc[ai][bj][m][0], v1 = acc[ai][bj][m][1];
                        char* pp = (char*)P + (p0 + (unsigned)(((ai * HALF + m * 16) * 1024 + bj * HALF) * 4));
                        *(f32x4*)pp = (f32x4){v0[0] * bflo(g.x), v0[1] * bfhi(g.x), v0[2] * bflo(g.y), v0[3] * bfhi(g.y)};
                        *(f32x4*)(pp + 16) = (f32x4){v1[0] * bflo(g.z), v1[1] * bfhi(g.z), v1[2] * bflo(g.w), v1[3] * bfhi(g.w)}; }
            }
            return;
        }
        const int row0 = u.pm * BM + wr * 64 + fr, col0 = u.pn * BM + wc * 32 + 8 * fq;
#pragma unroll
        for (int ai = 0; ai < 2; ++ai) {
            u32x4 gw[4][2];
#pragma unroll
            for (int m = 0; m < 4; ++m)
#pragma unroll
                for (int bj = 0; bj < 2; ++bj) gw[m][bj] = *(const u32x4*)((const char*)G + (unsigned)((row0 + ai * HALF + m * 16) * 3072 + 2048 + col0 + bj * HALF) * 2u);
#pragma unroll
            for (int m = 0; m < 4; ++m)
#pragma unroll
                for (int bj = 0; bj < 2; ++bj) { const u32x4 g = gw[m][bj]; const f32x4 v0 = acc[ai][bj][m][0], v1 = acc[ai][bj][m][1]; u32x4 w;
                    w.x = cvt_pk_bf16(v0[0] * bflo(g.x), v0[1] * bfhi(g.x)); w.y = cvt_pk_bf16(v0[2] * bflo(g.y), v0[3] * bfhi(g.y));
                    w.z = cvt_pk_bf16(v1[0] * bflo(g.z), v1[1] * bfhi(g.z)); w.w = cvt_pk_bf16(v1[2] * bflo(g.w), v1[3] * bfhi(g.w));
                    *(u32x4*)((char*)O + (unsigned)((row0 + ai * HALF + m * 16) * 1024 + col0 + bj * HALF) * 2u) = w; }
        }
    }
};
}

__device__ __forceinline__ void rn_load(const Ctx p, bool first, bool xin, int row, int lane, int ns, float4 (&x)[4], float4 (&y)[4]) {
    const float* src = xin ? (row < MP ? p.in(0) + (size_t)row * DM : p.in(1) + (size_t)(row - MP) * DM) : p.out() + (size_t)row * DM;
#pragma unroll
    for (int j = 0; j < 4; ++j) { const f32x4 t = __builtin_nontemporal_load((const f32x4*)(src + lane * 4 + 256 * j)); x[j] = make_float4(t[0], t[1], t[2], t[3]); }
    if (!first) {
#pragma unroll
        for (int j = 0; j < 4; ++j) {
            if (row < MP) { const u32x2 yw = __builtin_nontemporal_load((const u32x2*)((const u16*)(p.ws() + RC) + (size_t)row * DM + lane * 4 + 256 * j)); y[j].x = bflo(yw.x); y[j].y = bfhi(yw.x); y[j].z = bflo(yw.y); y[j].w = bfhi(yw.y); }
            else { const float* yp = (const float*)(p.ws() + RYP) + (size_t)(row - MP) * DM + lane * 4 + 256 * j; y[j] = *(const float4*)yp;
                for (int q = 1; q < ns; ++q) { const float4 t = *(const float4*)(yp + (size_t)q * 512 * 1024); y[j].x += t.x; y[j].y += t.y; y[j].z += t.z; y[j].w += t.w; } } }
    }
}
__device__ __forceinline__ void rownorm_phase(const Ctx p, bool first, float coef, const float* gpost, const float* gpre, bool write_xn, int ns, bool xin = false) {
    float* X = p.out(); u16* XN = (u16*)(p.ws() + RA);
    const int tid_ = otid(); const int lane = tid_ & 63, wid = tid_ >> 6;
    float4 gp[4], gq[4];
#pragma unroll
    for (int j = 0; j < 4; ++j) { gq[j] = *(const float4*)(gpre + lane * 4 + 256 * j); gp[j] = first ? gq[j] : *(const float4*)(gpost + lane * 4 + 256 * j); }
    const int stride = ogdim() * 8;
    int row = obid() * 8 + wid;
    float4 x[4], y[4];
    if (row < MROWS) rn_load(p, first, xin, row, lane, ns, x, y);
    for (; row < MROWS; row += stride) {
        float4 xn[4], yn[4];
        if (row + stride < MROWS) rn_load(p, first, xin, row + stride, lane, ns, xn, yn);
        if (!first) {
            float ss = 0.f;
#pragma unroll
            for (int j = 0; j < 4; ++j) ss += y[j].x * y[j].x + y[j].y * y[j].y + y[j].z * y[j].z + y[j].w * y[j].w;
            ss = wave_sum(ss);
            const float r = coef * rsqrtf(ss * (1.0f / DM) + EPS);
#pragma unroll
            for (int j = 0; j < 4; ++j) { x[j].x += r * y[j].x * gp[j].x; x[j].y += r * y[j].y * gp[j].y; x[j].z += r * y[j].z * gp[j].z; x[j].w += r * y[j].w * gp[j].w; }
        }
        if (!first) {
#pragma unroll
            for (int j = 0; j < 4; ++j) __builtin_nontemporal_store((f32x4){x[j].x, x[j].y, x[j].z, x[j].w}, (f32x4*)(X + (size_t)row * DM + lane * 4 + 256 * j)); }
        if (write_xn) {
            float ss = 0.f;
#pragma unroll
            for (int j = 0; j < 4; ++j) ss += x[j].x * x[j].x + x[j].y * x[j].y + x[j].z * x[j].z + x[j].w * x[j].w;
            ss = wave_sum(ss);
            const float r = rsqrtf(ss * (1.0f / DM) + EPS);
#pragma unroll
            for (int j = 0; j < 4; ++j) { u32x2 w; w.x = cvt_pk_bf16(x[j].x * r * gq[j].x, x[j].y * r * gq[j].y); w.y = cvt_pk_bf16(x[j].z * r * gq[j].z, x[j].w * r * gq[j].w);
                *(u32x2*)(XN + (size_t)row * DM + lane * 4 + 256 * j) = w; }
        }
#pragma unroll
        for (int j = 0; j < 4; ++j) { x[j] = xn[j]; y[j] = yn[j]; }
    }
}

#define MFMA16(a, b, c) __builtin_amdgcn_mfma_f32_16x16x32_bf16((a), (b), (c), 0, 0, 0)
__device__ __forceinline__ bf16x8 ldsfrag(const LAS u16* base, int row, int ld, int k) { return *(const LAS bf16x8*)(base + row * ld + k); }

__device__ __forceinline__ void convert_mat(LAS unsigned char* lds, int rank, int nwork, const float* src, int ld, u16* dst, int K, int N, bool gu_map, int dld = 0) {
    if (dld == 0) dld = K;
    LAS float* tile = (LAS float*)lds;
    const int tid = otid(), nkt = K >> 6, ntiles = nkt * (N >> 6);
    const int kk = tid >> 4, c4 = (tid & 15) * 4, n = tid >> 3, ks = (tid & 7) * 8;
    float4 v0, v1;
    auto tile_src = [&](int t) -> const float* { const int kt = t % nkt, nd0 = (t / nkt) * 64; int sc0 = nd0;
        if (gu_map) { const int pb = nd0 >> 8, h = (nd0 >> 7) & 1, j = nd0 & 127; sc0 = h * DFF + 128 * pb + j; }
        return src + (size_t)(kt * 64 + kk) * ld + sc0 + c4; };
    int t = rank, it = 0;
    if (t < ntiles) { const float* sp = tile_src(t); v0 = *(const float4*)sp; v1 = *(const float4*)(sp + (size_t)32 * ld); }
    for (; t < ntiles; t += nwork, ++it) {
        LAS float* tb = tile + (it & 1) * 4160;
        { LAS float* tp = tb + kk * 65 + c4; tp[0] = v0.x; tp[1] = v0.y; tp[2] = v0.z; tp[3] = v0.w; tp += 32 * 65; tp[0] = v1.x; tp[1] = v1.y; tp[2] = v1.z; tp[3] = v1.w; }
        if (t + nwork < ntiles) { const float* sp = tile_src(t + nwork); v0 = *(const float4*)sp; v1 = *(const float4*)(sp + (size_t)32 * ld); }
        __syncthreads();
        const int kt = t % nkt, nd0 = (t / nkt) * 64;
        float e[8];
#pragma unroll
        for (int i = 0; i < 8; ++i) e[i] = tb[(ks + i) * 65 + n];
        u32x4 w; w.x = cvt_pk_bf16(e[0], e[1]); w.y = cvt_pk_bf16(e[2], e[3]); w.z = cvt_pk_bf16(e[4], e[5]); w.w = cvt_pk_bf16(e[6], e[7]);
        *(u32x4*)(dst + (size_t)(nd0 + n) * dld + kt * 64 + ks) = w;
    }
    __syncthreads();
}
__device__ __forceinline__ void convert_ffn(const Ctx p, LAS unsigned char* lds, int rank, int nwork, const float* wgu, const float* wdn, size_t dstoff) {
    convert_mat(lds, rank, nwork, wgu, NGU, (u16*)(p.ws() + dstoff), 1024, NGU, true);
    convert_mat(lds, rank, nwork, wdn, 1024, (u16*)(p.ws() + dstoff + (RWF_DN - RWF)), DFF, 1024, false);
}
__device__ __forceinline__ void fuse_pool_unit(const Ctx p, LAS unsigned char* lds, int l, int unit) {
    const int tid = otid(), wid = tid >> 6, lane = tid & 63, fr = lane & 15, fq = lane >> 4;
    const int g = unit >> 3, nb = unit & 7;
    LAS u16* Xt = (LAS u16*)lds; LAS u16* Yl = (LAS u16*)(lds + 34816);
    constexpr int LD = 136;
    const float* wb = p.in(15) + (size_t)l * 1536 * 1024 + (size_t)(512 + g * 128) * 1024 + nb * 128;
    const float* pw = p.in(11) + ((size_t)l * 4 + g) * 16384;
    const float* sc = p.in(12) + l * 512 + g * 128;
#pragma unroll
    for (int i = 0; i < 8; ++i) { const int e = tid + i * 512, d = e >> 5, n4 = (e & 31) * 4; const float4 v = *(const float4*)(wb + (size_t)d * 1024 + n4);
        Xt[(n4 + 0) * LD + d] = f2bf(v.x); Xt[(n4 + 1) * LD + d] = f2bf(v.y); Xt[(n4 + 2) * LD + d] = f2bf(v.z); Xt[(n4 + 3) * LD + d] = f2bf(v.w); }
#pragma unroll
    for (int i = 0; i < 8; ++i) { const int e = tid + i * 512, c = e >> 5, d4 = (e & 31) * 4; const float4 v = *(const float4*)(pw + c * 128 + d4); const float4 s4 = *(const float4*)(sc + d4);
        u32x2 w; w.x = cvt_pk_bf16(v.x * s4.x, v.y * s4.y); w.y = cvt_pk_bf16(v.z * s4.z, v.w * s4.w); *(LAS u32x2*)(Yl + c * LD + d4) = w; }
    __syncthreads();
    f32x4 acc[8];
#pragma unroll
    for (int n = 0; n < 8; ++n) acc[n] = (f32x4){0.f, 0.f, 0.f, 0.f};
#pragma unroll
    for (int ks = 0; ks < 4; ++ks) { const bf16x8 a = ldsfrag(Xt, wid * 16 + fr, LD, ks * 32 + fq * 8);
#pragma unroll
        for (int n = 0; n < 8; ++n) acc[n] = MFMA16(a, ldsfrag(Yl, n * 16 + fr, LD, ks * 32 + fq * 8), acc[n]); }
    u16* dst = (u16*)(p.ws() + RWM_BR);
#pragma unroll
    for (int j = 0; j < 4; ++j) { const int n = nb * 128 + wid * 16 + fq * 4 + j;
#pragma unroll
        for (int c8 = 0; c8 < 8; ++c8) dst[(size_t)n * 1536 + 512 + g * 128 + c8 * 16 + fr] = f2bf(acc[c8][j]); }
    __syncthreads();
}
__device__ __forceinline__ void convert_mix(const Ctx p, LAS unsigned char* lds, int rank, int nwork, int l) {
    convert_mat(lds, rank, nwork, p.in(7) + (size_t)l * 1024 * NIN, NIN, (u16*)(p.ws() + RWM), 1024, NIN, false);
    convert_mat(lds, rank, nwork, p.in(15) + (size_t)l * 1536 * 1024, 1024, (u16*)(p.ws() + RWM_BR), 512, 1024, false, 1536);
    convert_mat(lds, rank, nwork, p.in(15) + (size_t)l * 1536 * 1024 + (size_t)1024 * 1024, 1024, (u16*)(p.ws() + RWM_BR) + 1024, 512, 1024, false, 1536);
    convert_mat(lds, rank, nwork, p.in(16) + (size_t)l * 1024 * 1024, 1024, (u16*)(p.ws() + RWM_OUT), 1024, 1024, false);
    { const int c2 = nwork - 1 - rank; if (c2 < 32) fuse_pool_unit(p, lds, l, c2); }
}


__device__ __forceinline__ void gmlp_unit(const Ctx p, LAS unsigned char* lds, int l, int unit, int wrf = 1) {
    const int tid = otid(), wid = tid >> 6, lane = tid & 63, fr = lane & 15, fq = lane >> 4;
    int row0, L, h, bs = -1;
    if (unit < 1024) { row0 = (unit >> 2) * 128; h = unit & 3; L = 128; } else { const int s = unit - 1024; bs = s >> 2; h = s & 3; row0 = MP + bs * 64; L = 64; }
    u16* U = (u16*)(p.ws() + RB); const u16* V = (const u16*)(p.ws() + RB + COLB);
    LAS float* rs = (LAS float*)lds; LAS u16* Vt = (LAS u16*)(lds + 1024); LAS u16* Wl = (LAS u16*)(lds + 35840);
    constexpr int LD = 136;
    const int srow = tid >> 2, part = tid & 3;
    u32x4 sv[16];
    if (srow < L) {
#pragma unroll
        for (int i = 0; i < 16; ++i) sv[i] = *(const u32x4*)(V + (size_t)(row0 + srow) * 512 + part * 128 + i * 8);
    }
    const int vs = tid & 127, cg4 = tid >> 7;
    u32x4 hv[4]; float4 vgv[8];
    if (vs < L) {
#pragma unroll
        for (int i = 0; i < 4; ++i) hv[i] = *(const u32x4*)(V + (size_t)(row0 + vs) * 512 + h * 128 + cg4 * 32 + i * 8);
    }
    { const float* vg = p.in(8) + l * 512 + h * 128 + cg4 * 32;
#pragma unroll
        for (int i = 0; i < 8; ++i) vgv[i] = *(const float4*)(vg + i * 4); }
    const int wt = tid >> 2, sq = (tid & 3) * 32;
    float4 wv[8];
    if (wt < L) { const float* wp = p.in(9) + ((size_t)(l * 4 + h) * 128 + wt) * 128 + sq;
#pragma unroll
        for (int i = 0; i < 8; ++i) wv[i] = *(const float4*)(wp + i * 4); }
    {
        float ss = 0.f;
        if (srow < L) {
#pragma unroll
            for (int i = 0; i < 16; ++i) { const u32x4 w = sv[i];
                float a; a = bflo(w.x); ss += a * a; a = bfhi(w.x); ss += a * a; a = bflo(w.y); ss += a * a; a = bfhi(w.y); ss += a * a;
                a = bflo(w.z); ss += a * a; a = bfhi(w.z); ss += a * a; a = bflo(w.w); ss += a * a; a = bfhi(w.w); ss += a * a; }
        }
        ss += __shfl_xor(ss, 1); ss += __shfl_xor(ss, 2);
        if (part == 0 && srow < L) rs[srow] = rsqrtf(ss * (1.0f / 512.0f) + EPS);
    }
    {
        if (wt < L) {
#pragma unroll
            for (int i = 0; i < 4; ++i) { const float4 a = wv[2 * i], b = wv[2 * i + 1]; const int s0 = sq + i * 8, t = wt;
                u32x4 w; w.x = cvt_pk_bf16(s0 + 0 <= t ? a.x : 0.f, s0 + 1 <= t ? a.y : 0.f); w.y = cvt_pk_bf16(s0 + 2 <= t ? a.z : 0.f, s0 + 3 <= t ? a.w : 0.f);
                w.z = cvt_pk_bf16(s0 + 4 <= t ? b.x : 0.f, s0 + 5 <= t ? b.y : 0.f); w.w = cvt_pk_bf16(s0 + 6 <= t ? b.z : 0.f, s0 + 7 <= t ? b.w : 0.f);
                *(LAS u32x4*)(Wl + t * LD + s0) = w; } }
    }
    __syncthreads();
    {
        if (vs < L) {
            const float r = rs[vs];
            float* vout = bs >= 0 ? p.out() + O_VS + ((size_t)(l * 8 + bs) * 64 + vs) * 512 + h * 128 + cg4 * 32 : nullptr;
#pragma unroll
            for (int i = 0; i < 4; ++i) { const u32x4 w = hv[i];
                const float e[8] = {bflo(w.x), bfhi(w.x), bflo(w.y), bfhi(w.y), bflo(w.z), bfhi(w.z), bflo(w.w), bfhi(w.w)};
                const float gz[8] = {vgv[2 * i].x, vgv[2 * i].y, vgv[2 * i].z, vgv[2 * i].w, vgv[2 * i + 1].x, vgv[2 * i + 1].y, vgv[2 * i + 1].z, vgv[2 * i + 1].w};
                float vv[8];
#pragma unroll
                for (int j = 0; j < 8; ++j) { vv[j] = e[j] * r * gz[j]; Vt[(cg4 * 32 + i * 8 + j) * LD + vs] = f2bf(vv[j]); }
                if (vout) { *(float4*)(vout + i * 8) = (float4){vv[0], vv[1], vv[2], vv[3]}; *(float4*)(vout + i * 8 + 4) = (float4){vv[4], vv[5], vv[6], vv[7]}; } }
        }
    }
    __syncthreads();
    if (wid * 16 < L) {
        const float* bsp = p.in(10) + (l * 4 + h) * 128;
        u16 uv[4][8]; float bias[4];
#pragma unroll
        for (int j = 0; j < 4; ++j) { const int t = wid * 16 + fq * 4 + j; bias[j] = bsp[t];
#pragma unroll
            for (int n = 0; n < 8; ++n) uv[j][n] = U[(size_t)(row0 + t) * 512 + h * 128 + n * 16 + fr]; }
        f32x4 acc[8];
#pragma unroll
        for (int n = 0; n < 8; ++n) acc[n] = (f32x4){0.f, 0.f, 0.f, 0.f};
        const int kmax = (wid * 16 + 15) / 32 + 1;
        for (int ks = 0; ks < kmax; ++ks) { const bf16x8 a = ldsfrag(Wl, wid * 16 + fr, LD, ks * 32 + fq * 8);
#pragma unroll
            for (int n = 0; n < 8; ++n) acc[n] = MFMA16(a, ldsfrag(Vt, n * 16 + fr, LD, ks * 32 + fq * 8), acc[n]); }
#pragma unroll
        for (int j = 0; j < 4; ++j) { const int t = wid * 16 + fq * 4 + j;
#pragma unroll
            for (int n = 0; n < 8; ++n) { const u16 ov = f2bf(bf2f(uv[j][n]) * (acc[n][j] + bias[j])); if (wrf) U[(size_t)(row0 + t) * 512 + h * 128 + n * 16 + fr] = ov; } }
    }
    __syncthreads();
}

__device__ __forceinline__ float hgrn_lb(const float* lbp, int l, int c) {
    const float x0 = lbp[c], x1 = lbp[512 + c], x2 = lbp[1024 + c], x3 = lbp[1536 + c];
    const float m = fmaxf(fmaxf(x0, x1), fmaxf(x2, x3));
    const float e0 = __expf(x0 - m), e1 = __expf(x1 - m), e2 = __expf(x2 - m), e3 = __expf(x3 - m);
    float num = 0.f; if (l >= 1) num += e1; if (l >= 2) num += e2; if (l >= 3) num += e3;
    return num / (e0 + e1 + e2 + e3);
}
__device__ __forceinline__ int chunk_row0(int cq) { return cq < 512 ? cq * 64 : MP + (cq - 512) * 64; }

struct HaIn { u16 z[16]; u32x4 v[2]; float lbx[4]; };
__device__ __forceinline__ void ha_load(const Ctx p, int unit, HaIn& L) {
    const int tid = otid();
    const int cq = unit >> 2, h = unit & 3, row0 = chunk_row0(cq);
    const u16* F = (const u16*)(p.ws() + RB + 4 * COLB); const u16* I = (const u16*)(p.ws() + RB + 5 * COLB);
    const int k = tid & 127, seg = tid >> 7;
    { const float* lbp = p.in(13) + h * 128 + k; L.lbx[0] = lbp[0]; L.lbx[1] = lbp[512]; L.lbx[2] = lbp[1024]; L.lbx[3] = lbp[1536]; }
#pragma unroll
    for (int i = 0; i < 16; ++i) L.z[i] = F[(size_t)(row0 + seg * 16 + i) * 512 + h * 128 + k];
    { const int s = tid & 63, cg = tid >> 6;
#pragma unroll
        for (int i = 0; i < 2; ++i) L.v[i] = *(const u32x4*)(I + (size_t)(row0 + s) * 512 + h * 128 + cg * 16 + i * 8); }
}
__device__ __forceinline__ void hgrn_a_unit(const Ctx p, LAS unsigned char* lds, int l, int unit, int next_unit, HaIn& L) {
    const int tid = otid(), wid = tid >> 6, lane = tid & 63, fr = lane & 15, fq = lane >> 4;
    u16* St = (u16*)(p.ws() + RA) + (size_t)unit * 16384; float* dcy = (float*)(p.ws() + RSM) + (size_t)unit * 128;
    LAS float* segtot = (LAS float*)lds; LAS u16* Kt = (LAS u16*)(lds + 4096); LAS u16* Vt = (LAS u16*)(lds + 22528);
    constexpr int LD = 72;
    const int k = tid & 127, seg = tid >> 7;
    float lb;
    { const float x0 = L.lbx[0], x1 = L.lbx[1], x2 = L.lbx[2], x3 = L.lbx[3]; const float m = fmaxf(fmaxf(x0, x1), fmaxf(x2, x3));
      const float e0 = __expf(x0 - m), e1 = __expf(x1 - m), e2 = __expf(x2 - m), e3 = __expf(x3 - m);
      float num = 0.f; if (l >= 1) num += e1; if (l >= 2) num += e2; if (l >= 3) num += e3; lb = num / (e0 + e1 + e2 + e3); }
    float lf[16], kk[16]; float run = 0.f;
#pragma unroll
    for (int i = 0; i < 16; ++i) { const float z = (float)__builtin_bit_cast(_Float16, L.z[i]);
        const float sg = fsig(z); const float f = lb + (1.0f - lb) * sg; kk[i] = 1.0f - f; run += __logf(fmaxf(f, 1e-30f)); lf[i] = run; }
    segtot[seg * 128 + k] = run;
    { const int s = tid & 63, cg = tid >> 6;
#pragma unroll
        for (int i = 0; i < 2; ++i) { const u32x4 w = L.v[i]; LAS u16* vp = Vt + (cg * 16 + i * 8) * LD + s;
            vp[0] = (u16)(w.x & 0xffff); vp[LD] = (u16)(w.x >> 16); vp[2 * LD] = (u16)(w.y & 0xffff); vp[3 * LD] = (u16)(w.y >> 16);
            vp[4 * LD] = (u16)(w.z & 0xffff); vp[5 * LD] = (u16)(w.z >> 16); vp[6 * LD] = (u16)(w.w & 0xffff); vp[7 * LD] = (u16)(w.w >> 16); } }
    if (next_unit < 2080) ha_load(p, next_unit, L);
    __syncthreads();
    { const float t0 = segtot[k], t1 = segtot[128 + k], t2 = segtot[256 + k], t3 = segtot[384 + k];
        const float off = seg == 0 ? 0.f : (seg == 1 ? t0 : (seg == 2 ? t0 + t1 : t0 + t1 + t2)); const float blast = t0 + t1 + t2 + t3;
#pragma unroll
        for (int i = 0; i < 16; ++i) Kt[k * LD + seg * 16 + i] = f2bf(kk[i] * __expf(blast - (off + lf[i])));
        if (seg == 0) dcy[k] = __expf(blast); }
    __syncthreads();
    { f32x4 acc[8];
#pragma unroll
        for (int n = 0; n < 8; ++n) acc[n] = (f32x4){0.f, 0.f, 0.f, 0.f};
#pragma unroll
        for (int ks = 0; ks < 2; ++ks) { const bf16x8 a = ldsfrag(Kt, wid * 16 + fr, LD, ks * 32 + fq * 8);
#pragma unroll
            for (int n = 0; n < 8; ++n) acc[n] = MFMA16(a, ldsfrag(Vt, n * 16 + fr, LD, ks * 32 + fq * 8), acc[n]); }
#pragma unroll
        for (int n = 0; n < 8; ++n) { u32x2 w; w.x = cvt_pk_bf16(acc[n][0], acc[n][1]); w.y = cvt_pk_bf16(acc[n][2], acc[n][3]);
            *(u32x2*)(St + (size_t)(n * 16 + fr) * 128 + wid * 16 + fq * 4) = w; } }
    __syncthreads();
}

__device__ __forceinline__ void hgrn_scan_phase(const Ctx p, int l, int wrf = 1) {
    u16* SR = (u16*)(p.ws() + RA); const float* dcy = (const float*)(p.ws() + RSM);
    const int gtid = obid() * 512 + otid(), gsz = ogdim() * 512;
    for (int e = gtid; e < 8 * 16384; e += gsz) {
        const int seq = e >> 14, el = e & 16383, b = seq >> 2, h = seq & 3, k = el & 127, v = el >> 7;
        u16* sp = SR + ((size_t)(b * 256) * 4 + h) * 16384 + el; const float* dp = dcy + ((size_t)(b * 256) * 4 + h) * 128 + k;
        float st = 0.f;
        for (int n0 = 0; n0 < 256; n0 += 16) {
            float uu[16], dd[16];
#pragma unroll
            for (int j = 0; j < 16; ++j) { uu[j] = bf2f(sp[(size_t)(n0 + j) * 65536]); dd[j] = dp[(size_t)(n0 + j) * 512]; }
#pragma unroll
            for (int j = 0; j < 16; ++j) { if (wrf) sp[(size_t)(n0 + j) * 65536] = f2bf(st); st = dd[j] * st + uu[j]; }
        }
        if (wrf) p.out()[O_HGP + ((size_t)(l * 2 + b) * 4 + h) * 16384 + k * 128 + v] = st;
    }
    for (int e = gtid; e < 32 * 16384; e += gsz) {
        const int bh = e >> 14, el = e & 16383, k = el & 127, v = el >> 7;
        u16* sp = SR + ((size_t)(512 * 4) + bh) * 16384 + el;
        const float s0 = p.in(3)[((size_t)l * 32 + bh) * 16384 + k * 128 + v];
        const float uu = bf2f(*sp), dd = dcy[((size_t)(512 * 4) + bh) * 128 + k];
        if (wrf) *sp = f2bf(s0);
        if (wrf) p.out()[O_HGS + ((size_t)l * 32 + bh) * 16384 + k * 128 + v] = dd * s0 + uu;
    }
}

struct HcIn { u16 z[16]; u32x4 v[2], st[4]; float lbx[4]; };
__device__ __forceinline__ void hc_load(const Ctx p, int l, int unit, HcIn& L) {
    const int tid = otid();
    const int cq = unit >> 2, h = unit & 3, row0 = chunk_row0(cq);
    const u16* F = (const u16*)(p.ws() + RB + 4 * COLB); const u16* I = (const u16*)(p.ws() + RB + 5 * COLB);
    const u16* St = (const u16*)(p.ws() + RA) + (size_t)unit * 16384;
    const int k = tid & 127, seg = tid >> 7;
    { const float* lbp = p.in(13) + h * 128 + k; L.lbx[0] = lbp[0]; L.lbx[1] = lbp[512]; L.lbx[2] = lbp[1024]; L.lbx[3] = lbp[1536]; }
#pragma unroll
    for (int i = 0; i < 16; ++i) L.z[i] = F[(size_t)(row0 + seg * 16 + i) * 512 + h * 128 + k];
    { const int s = tid & 63, cg = tid >> 6;
#pragma unroll
        for (int i = 0; i < 2; ++i) L.v[i] = *(const u32x4*)(I + (size_t)(row0 + s) * 512 + h * 128 + cg * 16 + i * 8); }
#pragma unroll
    for (int i = 0; i < 4; ++i) { const int c = tid + i * 512, r = c >> 4, cc = (c & 15) * 8; L.st[i] = *(const u32x4*)(St + r * 128 + cc); }
}
__device__ __forceinline__ void hgrn_c_unit(const Ctx p, LAS unsigned char* lds, int l, int unit, int next_unit, HcIn& L, int wrf = 1) {
    const int tid = otid(), wid = tid >> 6, lane = tid & 63, fr = lane & 15, fq = lane >> 4;
    const int cq = unit >> 2, h = unit & 3, row0 = chunk_row0(cq);
    u16* Q = (u16*)(p.ws() + RB + 3 * COLB); const u16* GG = (const u16*)(p.ws() + RB + 6 * COLB);
    u16 qv[16], gg[4][4]; float ogv[4];
#pragma unroll
    for (int i = 0; i < 16; ++i) qv[i] = Q[(size_t)(row0 + (tid >> 7) * 16 + i) * 512 + h * 128 + (tid & 127)];
    { const int tt = wid & 3, nh = wid >> 2; const float* og = p.in(14) + l * 128;
#pragma unroll
        for (int n = 0; n < 4; ++n) { const int v = (nh * 4 + n) * 16 + fr; ogv[n] = og[v];
#pragma unroll
            for (int j = 0; j < 4; ++j) gg[j][n] = GG[(size_t)(row0 + tt * 16 + fq * 4 + j) * 512 + h * 128 + v]; } }
    LAS float* segtot = (LAS float*)lds; LAS float* red = (LAS float*)(lds + 2560);
    LAS u16* Qi = (LAS u16*)(lds + 4096); LAS u16* Qh = (LAS u16*)(lds + 21504); LAS u16* Kh = (LAS u16*)(lds + 38912);
    LAS u16* Vt = (LAS u16*)(lds + 56320); LAS u16* Sl = (LAS u16*)(lds + 74752); LAS u16* P = (LAS u16*)(lds + 109568);
    constexpr int LDK = 136, LDS_ = 72;
    const int k = tid & 127, seg = tid >> 7;
    float lb;
    { const float x0 = L.lbx[0], x1 = L.lbx[1], x2 = L.lbx[2], x3 = L.lbx[3]; const float m = fmaxf(fmaxf(x0, x1), fmaxf(x2, x3));
      const float e0 = __expf(x0 - m), e1 = __expf(x1 - m), e2 = __expf(x2 - m), e3 = __expf(x3 - m);
      float num = 0.f; if (l >= 1) num += e1; if (l >= 2) num += e2; if (l >= 3) num += e3; lb = num / (e0 + e1 + e2 + e3); }
    float lf[16], kk[16]; float run = 0.f;
#pragma unroll
    for (int i = 0; i < 16; ++i) { const float z = (float)__builtin_bit_cast(_Float16, L.z[i]);
        const float sg = fsig(z); const float f = lb + (1.0f - lb) * sg; kk[i] = 1.0f - f; run += __logf(fmaxf(f, 1e-30f)); lf[i] = run; }
    segtot[seg * 128 + k] = run;
    { const int s = tid & 63, cg = tid >> 6;
#pragma unroll
        for (int i = 0; i < 2; ++i) { const u32x4 w = L.v[i]; LAS u16* vp = Vt + (cg * 16 + i * 8) * LDS_ + s;
            vp[0] = (u16)(w.x & 0xffff); vp[LDS_] = (u16)(w.x >> 16); vp[2 * LDS_] = (u16)(w.y & 0xffff); vp[3 * LDS_] = (u16)(w.y >> 16);
            vp[4 * LDS_] = (u16)(w.z & 0xffff); vp[5 * LDS_] = (u16)(w.z >> 16); vp[6 * LDS_] = (u16)(w.w & 0xffff); vp[7 * LDS_] = (u16)(w.w >> 16); } }
#pragma unroll
    for (int i = 0; i < 4; ++i) { const int c = tid + i * 512, r = c >> 4, cc = (c & 15) * 8; *(LAS u32x4*)(Sl + r * LDK + cc) = L.st[i]; }
    if (next_unit < 2080) hc_load(p, l, next_unit, L);
    __syncthreads();
    { const float t0 = segtot[k], t1 = segtot[128 + k], t2 = segtot[256 + k];
        const float off = seg == 0 ? 0.f : (seg == 1 ? t0 : (seg == 2 ? t0 + t1 : t0 + t1 + t2)); const float bref = t0 + t1;
#pragma unroll
        for (int i = 0; i < 16; ++i) { const int s = seg * 16 + i; const float b = off + lf[i]; const float q = bf2f(qv[i]);
            Qi[s * LDK + k] = f2bf(q * __expf(b)); Qh[s * LDK + k] = f2bf(q * __expf(b - bref)); Kh[s * LDK + k] = f2bf(kk[i] * __expf(bref - b)); } }
    __syncthreads();
    {
        const int tt = wid >> 1;
#pragma unroll
        for (int q2 = 0; q2 < 2; ++q2) { const int stl = (wid & 1) * 2 + q2; f32x4 acc = (f32x4){0.f, 0.f, 0.f, 0.f};
            if (stl <= tt) {
#pragma unroll
                for (int ks = 0; ks < 4; ++ks) acc = MFMA16(ldsfrag(Qh, tt * 16 + fr, LDK, ks * 32 + fq * 8), ldsfrag(Kh, stl * 16 + fr, LDK, ks * 32 + fq * 8), acc); }
#pragma unroll
            for (int j = 0; j < 4; ++j) { const int t = tt * 16 + fq * 4 + j, s = stl * 16 + fr; P[t * LDS_ + s] = (stl <= tt && s <= t) ? f2bf(acc[j]) : (u16)0; } }
    }
    __syncthreads();
    { const int tt = wid & 3, nh = wid >> 2; f32x4 acc[4];
#pragma unroll
        for (int n = 0; n < 4; ++n) acc[n] = (f32x4){0.f, 0.f, 0.f, 0.f};
#pragma unroll
        for (int ks = 0; ks < 4; ++ks) { const bf16x8 a = ldsfrag(Qi, tt * 16 + fr, LDK, ks * 32 + fq * 8);
#pragma unroll
            for (int n = 0; n < 4; ++n) acc[n] = MFMA16(a, ldsfrag(Sl, (nh * 4 + n) * 16 + fr, LDK, ks * 32 + fq * 8), acc[n]); }
#pragma unroll
        for (int ks = 0; ks < 2; ++ks) { const bf16x8 a = ldsfrag(P, tt * 16 + fr, LDS_, ks * 32 + fq * 8);
#pragma unroll
            for (int n = 0; n < 4; ++n) acc[n] = MFMA16(a, ldsfrag(Vt, (nh * 4 + n) * 16 + fr, LDS_, ks * 32 + fq * 8), acc[n]); }
        float ssq[4];
#pragma unroll
        for (int j = 0; j < 4; ++j) { float s = 0.f;
#pragma unroll
            for (int n = 0; n < 4; ++n) s += acc[n][j] * acc[n][j];
            s += __shfl_xor(s, 1); s += __shfl_xor(s, 2); s += __shfl_xor(s, 4); s += __shfl_xor(s, 8); ssq[j] = s; }
        if (fr == 0) {
#pragma unroll
            for (int j = 0; j < 4; ++j) red[nh * 64 + tt * 16 + fq * 4 + j] = ssq[j]; }
        __syncthreads();
#pragma unroll
        for (int j = 0; j < 4; ++j) { const int t = tt * 16 + fq * 4 + j; const float r = rsqrtf((red[t] + red[64 + t]) * (1.0f / 128.0f) + EPS);
#pragma unroll
            for (int n = 0; n < 4; ++n) { const int v = (nh * 4 + n) * 16 + fr; const size_t idx = (size_t)(row0 + t) * 512 + h * 128 + v;
                const u16 ov = f2bf(acc[n][j] * r * ogv[n] * bf2f(gg[j][n])); if (wrf) Q[idx] = ov; } }
    }
    __syncthreads();
}

template <int W> __device__ __forceinline__ void pool_rows(const u32x4 (&x)[31], int t0q, int nvalid, u16* ob) {
    float s[8];
#pragma unroll
    for (int e = 0; e < 8; ++e) s[e] = 0.f;
#pragma unroll
    for (int j = 16 - W; j < 15; ++j) { const u32x4 v = x[j]; s[0] += bflo(v.x); s[1] += bfhi(v.x); s[2] += bflo(v.y); s[3] += bfhi(v.y); s[4] += bflo(v.z); s[5] += bfhi(v.z); s[6] += bflo(v.w); s[7] += bfhi(v.w); }
#pragma unroll
    for (int i = 0; i < 16; ++i) { const u32x4 v = x[15 + i]; const float xv[8] = {bflo(v.x), bfhi(v.x), bflo(v.y), bfhi(v.y), bflo(v.z), bfhi(v.z), bflo(v.w), bfhi(v.w)};
        const int avail = t0q + i + 1 + nvalid; const float rc = 1.0f / (float)(avail < W ? avail : W);
        float o[8];
#pragma unroll
        for (int e = 0; e < 8; ++e) { s[e] += xv[e]; o[e] = s[e] * rc - xv[e]; }
        u32x4 w; w.x = cvt_pk_bf16(o[0], o[1]); w.y = cvt_pk_bf16(o[2], o[3]); w.z = cvt_pk_bf16(o[4], o[5]); w.w = cvt_pk_bf16(o[6], o[7]);
        *(u32x4*)(ob + (size_t)i * 512) = w;
        const u32x4 r = x[15 + i - (W - 1)];
        s[0] -= bflo(r.x); s[1] -= bfhi(r.x); s[2] -= bflo(r.y); s[3] -= bfhi(r.y); s[4] -= bflo(r.z); s[5] -= bfhi(r.z); s[6] -= bflo(r.w); s[7] -= bfhi(r.w); }
}
__device__ __forceinline__ void pool_pass(const Ctx p, int l) {
    const int tid = otid(), lane = tid & 63, cgp = lane & 15, rq = lane >> 4;
    const u16* XB = (const u16*)(p.ws() + RB + 2 * COLB); u16* OB = (u16*)(p.ws() + RB + COLB);
    const int u0 = obid() * 8 + (tid >> 6), ustride = ogdim() * 8;
    for (int unit = u0; unit < NCH64 * 4; unit += ustride) {
        const int cq = unit >> 2, g = unit & 3, row0 = chunk_row0(cq);
        const bool samp = cq >= 512; const int bs = cq - 512; const int t0 = samp ? 0 : (cq & 255) * 64;
        const int t0q = t0 + rq * 16;
        const int col = g * 128 + cgp * 8;
        u32x4 x[31];
#pragma unroll
        for (int j = 0; j < 31; ++j) { const int tk = t0q - 15 + j;
            if (tk >= 0) x[j] = *(const u32x4*)(XB + (size_t)(row0 + rq * 16 - 15 + j) * 512 + col);
            else if (samp) { const float* sp = p.in(2) + ((size_t)(l * 8 + bs) * 15 + (15 + tk)) * 512 + col; const float4 a = *(const float4*)sp, b = *(const float4*)(sp + 4);
                x[j].x = cvt_pk_bf16(a.x, a.y); x[j].y = cvt_pk_bf16(a.z, a.w); x[j].z = cvt_pk_bf16(b.x, b.y); x[j].w = cvt_pk_bf16(b.z, b.w); }
            else x[j] = (u32x4){0u, 0u, 0u, 0u}; }
        u16* ob = OB + (size_t)(row0 + rq * 16) * 512 + col; const int nvalid = samp ? 15 : 0;
        if (g == 0) pool_rows<2>(x, t0q, nvalid, ob); else if (g == 1) pool_rows<4>(x, t0q, nvalid, ob); else if (g == 2) pool_rows<8>(x, t0q, nvalid, ob); else pool_rows<16>(x, t0q, nvalid, ob);
        if ((samp || t0 == 16320) && rq == 3) { float* po = (samp ? p.out() + O_POOLS + ((size_t)(l * 8 + bs) * 15) * 512 : p.out() + O_POOLP + ((size_t)(l * 2 + (cq >> 8)) * 15) * 512) + col;
#pragma unroll
            for (int j = 0; j < 15; ++j) { const u32x4 v = x[16 + j]; float* q = po + (size_t)j * 512;
                *(float4*)q = (float4){bflo(v.x), bfhi(v.x), bflo(v.y), bfhi(v.y)}; *(float4*)(q + 4) = (float4){bflo(v.z), bfhi(v.z), bflo(v.w), bfhi(v.w)}; } }
    }
}

#define XB_TMO      128
#define XB_XCNT(j)  (256  + 64 * (j))
#define XB_XSUB(j)  (1280 + 64 * (j))
#define XB_XGEN(j)  (2304 + 64 * (j))
#define XB_TOP      3328
#define XB_TOPGEN   3392
#define XCD_BAR_WORDS 3456
#define XB_SPIN_CAP (1u << 20)
__device__ __forceinline__ unsigned xb_ld(unsigned* p)              { return __hip_atomic_load(p, __ATOMIC_RELAXED, __HIP_MEMORY_SCOPE_AGENT); }
__device__ __forceinline__ unsigned xb_add(unsigned* p, unsigned v) { return __hip_atomic_fetch_add(p, v, __ATOMIC_RELAXED, __HIP_MEMORY_SCOPE_AGENT); }
__device__ __forceinline__ unsigned xb_xcc_id() { return (unsigned)__builtin_amdgcn_s_getreg((3 << 11) | 20) & 0xFu; }
#define XB_SPIN(cond, bar) do { unsigned _sp = 0; while (cond) { __builtin_amdgcn_s_sleep(1); \
    if ((++_sp & 255u) == 0u) { if (xb_ld(&(bar)[XB_TMO])) break; if (_sp > XB_SPIN_CAP) { atomicAdd(&(bar)[XB_TMO], 1u); break; } } } } while (0)
__device__ __forceinline__ void xcd_barrier_complete(unsigned* bar, unsigned x, unsigned& nloc, unsigned& nx) {
    const unsigned G = gridDim.x;
    unsigned sum, cnt, mine, sp = 0u;
    for (;;) {
        sum = 0u; cnt = 0u; mine = 0u;
#pragma unroll
        for (unsigned j = 0; j < 16; ++j) { const unsigned c = xb_ld(&bar[XB_XCNT(j)]); sum += c; cnt += (c > 0u) ? 1u : 0u; mine = (j == x) ? c : mine; }
        if (sum == G) break;
        __builtin_amdgcn_s_sleep(1);
        if ((++sp & 255u) == 0u) { if (xb_ld(&bar[XB_TMO])) break; if (sp > XB_SPIN_CAP) { atomicAdd(&bar[XB_TMO], 1u); break; } }
    }
    nloc = mine > 0u ? mine : 1u; nx = cnt > 0u ? cnt : 1u;
}
__device__ __forceinline__ void xcd_barrier(unsigned* bar, volatile LAS unsigned* st) {
    asm volatile("s_waitcnt vmcnt(0)" ::: "memory");
    __syncthreads();
    if (threadIdx.x == 0) {
        const unsigned x = xb_xcc_id();
        __builtin_amdgcn_s_waitcnt(0);
        unsigned nloc = st[0], nx = st[1];
        if (nloc == 0u) { xcd_barrier_complete(bar, x, nloc, nx); st[0] = nloc; st[1] = nx; }
        const unsigned old = xb_add(&bar[XB_XSUB(x)], 1u);
        const unsigned gen = old / nloc;
        if (old + 1u == (gen + 1u) * nloc) {
            __builtin_amdgcn_fence(__ATOMIC_RELEASE, "agent");
            asm volatile("s_waitcnt vmcnt(0)" ::: "memory");
            const unsigned og = xb_add(&bar[XB_TOP], 1u);
            const unsigned tg = og / nx;
            if (og + 1u == (tg + 1u) * nx) xb_add(&bar[XB_TOPGEN], 1u);
            else XB_SPIN(xb_ld(&bar[XB_TOPGEN]) == tg, bar);
            __builtin_amdgcn_fence(__ATOMIC_ACQUIRE, "agent");
            xb_add(&bar[XB_XGEN(x)], 1u);
            asm volatile("s_waitcnt vmcnt(0)" ::: "memory");
        } else {
            XB_SPIN(xb_ld(&bar[XB_XGEN(x)]) == gen, bar);
            __builtin_amdgcn_fence(__ATOMIC_ACQUIRE, "agent");
            asm volatile("s_waitcnt vmcnt(0)" ::: "memory");
        }
    }
    __syncthreads();
}

__global__ void __launch_bounds__(512, 2) fwd_mega(Params kp) {
    extern __shared__ __attribute__((aligned(16))) unsigned char lds_raw[];
    LAS unsigned char* lds = (LAS unsigned char*)lds_raw;
    cg::grid_group grid = cg::this_grid();
    { LAS unsigned* pw = (LAS unsigned*)(lds + 131072); const unsigned* src = (const unsigned*)&kp; if (threadIdx.x < sizeof(Params) / 4) pw[threadIdx.x] = src[threadIdx.x];
      if (threadIdx.x >= 128 && threadIdx.x < 132) pw[threadIdx.x] = 0u; }
    __syncthreads();
    volatile LAS unsigned* bst = (volatile LAS unsigned*)(lds + 131072 + 512);
    if (threadIdx.x == 0) (void)xb_add(&((unsigned*)(kp.ws + RBAR))[XB_XCNT(xb_xcc_id())], 1u);
    Ctx p; p.pl = (LAS const unsigned*)(lds + 131072);
    const int ph_lo = __builtin_amdgcn_readfirstlane(p.pl[42]), ph_hi = __builtin_amdgcn_readfirstlane(p.pl[43]);
    unsigned long long tp_prev = 0, tp_acc = 0; int tp_sel = 0;
    for (int ph = ph_lo; ph < ph_hi; ++ph) {
        if (ph > ph_lo) { if (ph == ph_lo + 1) grid.sync(); else xcd_barrier((unsigned*)(p.ws() + RBAR), bst); }
        if (TPM) { const unsigned long long now = __builtin_amdgcn_s_memrealtime(); if (tp_sel) tp_acc += now - tp_prev; tp_prev = now; tp_sel = ph == 0 ? (TPM & 1) : ((TPM >> ((ph - 1) % 13 + 1)) & 1); }
        const int G = osgpr((int)gridDim.x), c = osgpr((int)blockIdx.x);
        if (ph == 0) {
            rownorm_phase(p, true, 0.f, nullptr, p.in(4), true, 0, true);
            convert_ffn(p, lds, c, G, p.in(5), p.in(6), RWF);
            convert_mix(p, lds, c, G, 0);
            continue;
        }
        const int l = (ph - 1) / 13, s = (ph - 1) % 13 + 1;
        unsigned char* ws = p.ws_flat();
        switch (s) {
        case 1: case 11: if (PHM & 1) {
            const size_t wf = s == 1 ? RWF : RWF2;
            pg8::SchedPlain S; S.o.init(MROWS / 256, NGU / 256, G, c); S.A = (const char*)(ws + RA); S.B = (const char*)(ws + wf); S.at = (size_t)256 * 1024 * 2; S.bt = (size_t)256 * 1024 * 2; S.nt = 16; S.ns = 0; S.nseg = 0; S.Asplit = nullptr;
            pg8::EpiGU E{(u16*)(ws + RB)};
            REP(0) pg8::gemm_phase(lds, 1024, 1024, 1024, S, E);
            const int extra = S.o.nwg % G;
            if (c >= extra) {
                if (s == 1) convert_ffn(p, lds, c - extra, G - extra, p.in(17) + (size_t)l * 1024 * NGU, p.in(18) + (size_t)l * DFF * 1024, RWF2);
                else if (l < DEPTH - 1) convert_mix(p, lds, c - extra, G - extra, l + 1);
            }
        } break;
        case 2: case 12: if (PHM & 2) {
            pg8::SchedPlain S; S.o.init(MP / 256, 4, G, c); S.A = (const char*)(ws + RB); S.B = (const char*)(ws + (s == 2 ? RWF : RWF2) + (RWF_DN - RWF)); S.at = (size_t)256 * DFF * 2; S.bt = (size_t)256 * DFF * 2; S.nt = DFF / 64; S.ns = 11; S.nseg = 0; S.Asplit = nullptr;
            pg8::EpiF32 E{(u16*)(ws + RC), 1024, (float*)(ws + RYP)};
            REP(1) pg8::gemm_phase(lds, DFF, DFF, DFF, S, E);
        } break;
        case 3: if (PHM & 4) { const float* gains = p.in(4) + (size_t)l * 6 * 1024; rownorm_phase(p, false, 0.5f, gains + 1024, gains + 2048, true, 11, l == 0); } break;
        case 4: if (PHM & 8) {
            pg8::SchedPlain S; S.o.init(MROWS / 256, NIN / 256, G, c); S.A = (const char*)(ws + RA); S.B = (const char*)(ws + RWM); S.at = (size_t)256 * 1024 * 2; S.bt = (size_t)256 * 1024 * 2; S.nt = 16; S.ns = 0; S.nseg = 0; S.Asplit = nullptr;
            pg8::EpiIN E{(u16*)(ws + RB), (u16*)(ws + RC)};
            REP(2) pg8::gemm_phase(lds, 1024, 1024, 1024, S, E);
            const int extra = S.o.nwg % G;
            if (c >= extra && l < DEPTH - 1) convert_ffn(p, lds, c - extra, G - extra, p.in(5) + (size_t)(l + 1) * 1024 * NGU, p.in(6) + (size_t)(l + 1) * DFF * 1024, RWF);
        } break;
        case 5: { int it = c;
                    for (; it < 1056; it += G) { if (PHM & 16) REP(8) gmlp_unit(p, lds, l, it, osgpr(rep_ == 0 ? 1 : 0)); }
                    if (PHM & 32) { HaIn A; ha_load(p, it - 1056 < 2080 ? it - 1056 : 0, A);
                        for (; it < 1056 + 2080; it += G) hgrn_a_unit(p, lds, l, it - 1056, it + G - 1056, A); } } break;
        case 6: if (PHM & 64) REP(9) hgrn_scan_phase(p, l, osgpr(rep_ == 0 ? 1 : 0)); break;
        case 7: if (PHM & 128) { int it = c; HcIn A; hc_load(p, l, it < 2080 ? it : 0, A);
                    for (; it < 2080; it += G) hgrn_c_unit(p, lds, l, it, it + G, A, 1); }
                if (PHM & 256) REP(6) pool_pass(p, l); break;
        case 8: if (PHM & 512) {
            pg8::SchedPlain S; S.o.init(MP / 256, 4, G, c); S.A = (const char*)(ws + RB); S.B = (const char*)(ws + RWM_BR); S.at = (size_t)256 * 512 * 2; S.bt = (size_t)256 * 1536 * 2; S.nt = 24; S.ns = 0; S.nseg = 3; S.Asplit = nullptr;
            pg8::EpiBranch E{(const u16*)(ws + RC), (u16*)(ws + RA), (float*)(ws + RB + 2 * COLB)};
            REP(3) pg8::gemm_phase(lds, 1536, 512, 1536, S, E);
        } break;
        case 9: if (PHM & 1024) {
            if (c < 32) {
                const int tile = c >> 2, j = c & 3, pms = tile >> 2; const int tid = otid();
                const float* Pp = (const float*)(ws + RB + 2 * COLB); u16* blk = (u16*)(ws + RB + 4 * COLB + (size_t)c * (512 * 1024));
#pragma unroll 4
                for (int e = tid; e < 8192; e += 512) { const int r = e >> 5, col = j * 256 + (e & 31) * 8; const float* sp = Pp + (size_t)(pms * 256 + r) * 1024 + col;
                    float4 a = *(const float4*)sp, b = *(const float4*)(sp + 4);
#pragma unroll
                    for (int q = 1; q < 3; ++q) { const float4 a2 = *(const float4*)(sp + (size_t)q * 512 * 1024), b2 = *(const float4*)(sp + (size_t)q * 512 * 1024 + 4);
                        a.x += a2.x; a.y += a2.y; a.z += a2.z; a.w += a2.w; b.x += b2.x; b.y += b2.y; b.z += b2.z; b.w += b2.w; }
                    u32x4 w; w.x = cvt_pk_bf16(a.x, a.y); w.y = cvt_pk_bf16(a.z, a.w); w.z = cvt_pk_bf16(b.x, b.y); w.w = cvt_pk_bf16(b.z, b.w);
                    *(u32x4*)(blk + (size_t)r * 1024 + col) = w; }
                asm volatile("s_waitcnt vmcnt(0)" ::: "memory");
            }
            __syncthreads();
            pg8::SchedPlain S; S.o.init(MP / 256, 4, G, c); S.A = (const char*)(ws + RA); S.B = (const char*)(ws + RWM_OUT); S.at = (size_t)256 * 1024 * 2; S.bt = (size_t)256 * 1024 * 2; S.nt = 16; S.ns = 4; S.nseg = 0; S.Asplit = (const char*)(ws + RB + 4 * COLB);
            pg8::EpiF32 E{(u16*)(ws + RC), 1024, (float*)(ws + RYP)};
            REP(4) pg8::gemm_phase(lds, 1024, 1024, 1024, S, E);
        } break;
        case 10: { const float* gains = p.in(4) + (size_t)l * 6 * 1024; REP(11) rownorm_phase(p, false, rep_ ? 0.f : 1.0f, gains + 3 * 1024, gains + 4 * 1024, true, 4); } break;
        case 13: { const float* gains = p.in(4) + (size_t)l * 6 * 1024; REP(11) rownorm_phase(p, false, rep_ ? 0.f : 0.5f, gains + 5 * 1024, gains + (l < DEPTH - 1 ? 6 * 1024 : 0), l < DEPTH - 1, 11); } break;
        }
    }
    if (TPM) { unsigned long long now = __builtin_amdgcn_s_memrealtime(); if (tp_sel) tp_acc += now - tp_prev;
        if (blockIdx.x == 0 && threadIdx.x == 0) { const unsigned long long t0 = now; while (__builtin_amdgcn_s_memrealtime() - t0 < TMULT * tp_acc) __builtin_amdgcn_s_sleep(8); } }
}

constexpr int N_PHASES = 1 + 13 * DEPTH;

extern "C" void kernel_launch(void* const* d_in, const int* in_sizes, int n_in, void* d_out, int out_size, void* d_ws, size_t ws_size, hipStream_t stream) {
    static int grid = 0;
    if (grid == 0) {
        if (n_in != 19 || ws_size < WS_END) { fprintf(stderr, "kernel_launch: need 19 inputs and %zu bytes of workspace (got %d, %zu)\n", (size_t)WS_END, n_in, ws_size); grid = -1; return; }
        int dev = 0, cus = 0, per_cu = 0;
        hipGetDevice(&dev); hipDeviceGetAttribute(&cus, hipDeviceAttributeMultiprocessorCount, dev);
        hipFuncSetAttribute((const void*)fwd_mega, hipFuncAttributeMaxDynamicSharedMemorySize, LDS_BYTES);
        hipOccupancyMaxActiveBlocksPerMultiprocessor(&per_cu, (const void*)fwd_mega, 512, LDS_BYTES);
        if (per_cu < 1) { fprintf(stderr, "kernel_launch: occupancy query says %d blocks per CU\n", per_cu); per_cu = 1; }
        (void)hipGetLastError();
        grid = cus * per_cu;
    }
    if (grid < 0) return;
    Params p{};
    for (int i = 0; i < 19; ++i) p.in[i] = (const float*)d_in[i];
    p.out = (float*)d_out; p.ws = (unsigned char*)d_ws;
    (void)hipMemsetAsync((unsigned char*)d_ws + RBAR, 0, 3456 * 4, stream);
#if MULTI_LAUNCH
    for (int ph = 0; ph < N_PHASES; ++ph) { p.ph_lo = ph; p.ph_hi = ph + 1; hipLaunchKernelGGL(fwd_mega, dim3(grid), dim3(512), LDS_BYTES, stream, p); }
#else
    p.ph_lo = 0; p.ph_hi = N_PHASES;
    void* args[] = {&p};
    hipError_t e = hipLaunchCooperativeKernel((const void*)fwd_mega, dim3(grid), dim3(512), args, LDS_BYTES, stream);
    if (e != hipSuccess) fprintf(stderr, "cooperative launch failed: %s (grid %d)\n", hipGetErrorString(e), grid);
#endif
}
```
